# Optimizing an MI355X kernel written in HIP

```python
import jax
import jax.numpy as jnp
from jax import lax
import numpy as np

D_MODEL = 1024
BATCH = 4
SEQ = 4096
DEPTH = 4

GRID_W = 64
CTX_LEN = 256

NA_HEAD_DIM = 64
NA_WIDTH = D_MODEL // 2
NA_HEADS = NA_WIDTH // NA_HEAD_DIM
NA_KH = 8
NA_KW = 16
HG_KEY_DIM = 128
HG_WIDTH = D_MODEL // 2
HG_HEADS = HG_WIDTH // HG_KEY_DIM
HG_CHUNK = 16
EVEN_SPLITS = (NA_WIDTH, NA_WIDTH, NA_WIDTH, HG_WIDTH, HG_WIDTH, HG_WIDTH, HG_WIDTH, HG_WIDTH)
EVEN_CUTS = tuple(sum(EVEN_SPLITS[:i + 1]) for i in range(len(EVEN_SPLITS) - 1))
EVEN_IN = sum(EVEN_SPLITS)
EVEN_MIX = NA_WIDTH + HG_WIDTH
RET_QK_DIM = 256
RET_HEADS = D_MODEL // RET_QK_DIM
RET_V_DIM = 2 * RET_QK_DIM
RET_QK_W = RET_HEADS * RET_QK_DIM
RET_V_W = RET_HEADS * RET_V_DIM
RET_CHUNK = 128
ODD_CUTS = (RET_QK_W, 2 * RET_QK_W, 2 * RET_QK_W + RET_V_W)
ODD_IN = 2 * RET_QK_W + 2 * RET_V_W
FFN_DIM = 2816
N_EXPERTS = 8
TOP_K = 2
EXPERT_DIM = 3584
ROPE_BASE = 10000.0
LN_EPS = 1e-5
NORM_EPS = 1e-6
N_EVEN = (DEPTH + 1) // 2
N_ODD = DEPTH // 2
ALPHA = (2 * DEPTH) ** 0.25
BETA = (8 * DEPTH) ** -0.25
F32 = jnp.float32

kernel_name = 'hybrid_natten_hgrn2_retention_moe_dit'


def layer_norm(x, g, b):
    xf = x.astype(F32)
    mu = jnp.mean(xf, -1, keepdims=True)
    var = jnp.mean(jnp.square(xf - mu), -1, keepdims=True)
    return ((xf - mu) * lax.rsqrt(var + LN_EPS) * g + b).astype(x.dtype)


def group_norm(x):
    xf = x.astype(F32)
    mu = jnp.mean(xf, -1, keepdims=True)
    var = jnp.mean(jnp.square(xf - mu), -1, keepdims=True)
    return ((xf - mu) * lax.rsqrt(var + LN_EPS)).astype(x.dtype)


def rms_norm(x, g):
    xf = x.astype(F32)
    return (xf * lax.rsqrt(jnp.mean(jnp.square(xf), -1, keepdims=True) + NORM_EPS) * g).astype(x.dtype)


def modulate(x, shift, scale):
    return x * (1.0 + scale) + shift


def heads(x, n):
    b, t, w = x.shape
    return x.reshape(b, t, n, w // n).transpose(0, 2, 1, 3)


def merge(x):
    b, n, t, d = x.shape
    return x.transpose(0, 2, 1, 3).reshape(b, t, n * d)


def rope_1d(x, pos):
    half = x.shape[-1] // 2
    inv = ROPE_BASE ** (-jnp.arange(half, dtype=F32) / half)
    ang = pos.astype(F32)[:, None] * inv
    cos, sin = jnp.cos(ang), jnp.sin(ang)
    x1, x2 = x[..., :half], x[..., half:]
    return jnp.concatenate([x1 * cos - x2 * sin, x2 * cos + x1 * sin], -1).astype(x.dtype)


def rope_2d(x, rows, cols):
    h = x.shape[-1] // 2
    return jnp.concatenate([rope_1d(x[..., :h], rows), rope_1d(x[..., h:], cols)], -1)


def swiglu(h, w1, w3, w2):
    return (jax.nn.silu(h @ w1) * (h @ w3)) @ w2


def moe_swiglu(h, rw, rb, w1, w3, w2):
    logits = (h @ rw + rb).astype(F32)
    top_val, top_idx = lax.top_k(logits, TOP_K)
    gate = jax.nn.softmax(top_val, axis=-1)
    combine = jnp.sum(jax.nn.one_hot(top_idx, N_EXPERTS, dtype=F32) * gate[..., None], axis=-2)
    out = jnp.zeros_like(h)
    for e in range(N_EXPERTS):
        out = out + combine[..., e:e + 1].astype(h.dtype) * swiglu(h, w1[e], w3[e], w2[e])
    return out


def full_attention(q, k, v):
    s = jnp.einsum('bhqd,bhkd->bhqk', q, k).astype(F32) * q.shape[-1] ** -0.5
    p = jax.nn.softmax(s, axis=-1)
    return jnp.einsum('bhqk,bhkd->bhqd', p, v).astype(q.dtype)


def neighbourhood_attention(q, k, v, kc, vc, rpb):
    b, h, n, dh = q.shape
    rows = n // GRID_W
    kh = min(NA_KH, rows)
    grid = lambda a: a.reshape(b, h, rows, GRID_W, dh)
    qg, kg, vg = grid(q) * dh ** -0.5, grid(k), grid(v)
    r = jnp.arange(rows)
    band = jnp.clip(r - kh // 2, 0, rows - kh)[:, None] + jnp.arange(kh)[None, :]
    k_band = kg[:, :, band]
    v_band = vg[:, :, band]
    col = jnp.arange(GRID_W)
    c_start = jnp.clip(col - NA_KW // 2, 0, GRID_W - NA_KW)
    col_in = (col[None, :] >= c_start[:, None]) & (col[None, :] < c_start[:, None] + NA_KW)
    dr = band - r[:, None] + NA_KH - 1
    dc = jnp.clip(col[None, :] - col[:, None], 1 - NA_KW, NA_KW - 1) + NA_KW - 1
    bias = rpb[:, dr[:, None, :, None], dc[None, :, None, :]]
    s_band = jnp.einsum('bhrcd,bhrkmd->bhrckm', qg, k_band).astype(F32) + bias.astype(F32)
    s_band = jnp.where(col_in[:, None, :], s_band, -jnp.inf)
    s_ctx = jnp.einsum('bhrcd,bhjd->bhrcj', qg, kc).astype(F32)
    nb = kh * GRID_W
    p = jax.nn.softmax(jnp.concatenate([s_band.reshape(b, h, rows, GRID_W, nb), s_ctx], -1), axis=-1)
    o = (jnp.einsum('bhrckm,bhrkmd->bhrcd', p[..., :nb].reshape(b, h, rows, GRID_W, kh, GRID_W), v_band)
         + jnp.einsum('bhrcj,bhjd->bhrcd', p[..., nb:], vc))
    return o.reshape(b, h, n, dh).astype(q.dtype)


def chunk_recurrence(q, k, v, log_f, s0, chunk, per_dim):
    b, h, t, dk = q.shape
    n = t // chunk
    blk = lambda a: a.reshape(b, h, n, chunk, a.shape[-1])
    qb, kb, vb = blk(q), blk(k), blk(v)
    cum = jnp.cumsum(blk(log_f.astype(F32)), axis=-2)
    cum_last = cum[..., -1:, :]
    lower = jnp.tril(jnp.ones((chunk, chunk), bool))
    diff = cum[..., :, None, :] - cum[..., None, :, :]
    if per_dim:
        dec = jnp.exp(jnp.where(lower[..., None], diff, -jnp.inf))
        att = jnp.einsum('bhntd,bhnsd,bhntsd->bhnts', qb, kb, dec)
    else:
        dec = jnp.exp(jnp.where(lower, diff[..., 0], -jnp.inf))
        att = jnp.einsum('bhntd,bhnsd->bhnts', qb, kb) * dec
    o_intra = jnp.einsum('bhnts,bhnsv->bhntv', att, vb)
    q_in = jnp.moveaxis(qb * jnp.exp(cum), 2, 0)
    u = jnp.einsum('bhncd,bhncv->nbhdv', kb * jnp.exp(cum_last - cum), vb)
    g = jnp.moveaxis(jnp.exp(cum_last[..., 0, :]), 2, 0)

    def step(s, inp):
        qi, gi, ui = inp
        return gi[..., None] * s + ui, jnp.einsum('bhcd,bhdv->bhcv', qi, s)

    s_final, o_inter = lax.scan(step, s0.astype(F32), (q_in, g, u))
    o = o_intra + jnp.moveaxis(o_inter, 0, 2)
    return o.reshape(b, h, t, v.shape[-1]).astype(v.dtype), s_final


def final_state(k, v, log_f):
    cum = jnp.cumsum(log_f.astype(F32), axis=-2)
    return jnp.einsum('bhtd,bhtv->bhdv', k * jnp.exp(cum[..., -1:, :] - cum), v)


def bidirectional_recurrence(q_x, v_x, k_x, lf_x, q_c, v_c, k_c, lf_c, chunk, per_dim, ctx_out):
    b, h, _, dk = k_c[0].shape
    dv = v_c.shape[-1]
    outs_x, outs_c = [], []
    for d in range(2):
        rev = (lambda a: jnp.flip(a, axis=2)) if d else (lambda a: a)
        if ctx_out:
            o_c, s_c = chunk_recurrence(rev(q_c), rev(k_c[d]), rev(v_c), rev(lf_c[d]),
                                        jnp.zeros((b, h, dk, dv), F32), chunk, per_dim)
            outs_c.append(rev(o_c))
        else:
            s_c = final_state(rev(k_c[d]), rev(v_c), rev(lf_c[d]))
        o_x, _ = chunk_recurrence(rev(q_x), rev(k_x[d]), rev(v_x), rev(lf_x[d]), s_c, chunk, per_dim)
        outs_x.append(rev(o_x))
    return outs_x[0] + outs_x[1], (outs_c[0] + outs_c[1] if ctx_out else None)


def hgrn_log_forget(z, lb):
    lb = lb.astype(F32)
    return jnp.logaddexp(jnp.log(lb), jnp.log1p(-lb) + jax.nn.log_sigmoid(z.astype(F32)))


def hgrn2_inputs(p, lb):
    q = heads(jax.nn.silu(p[0]), HG_HEADS)
    lf = [hgrn_log_forget(heads(p[1 + d], HG_HEADS), lb[d].reshape(HG_HEADS, 1, HG_KEY_DIM)) for d in range(2)]
    k = [-jnp.expm1(f) for f in lf]
    return q, heads(p[3], HG_HEADS), k, lf


def even_mixer(hx, hc, w_in, w_out, rpb, lb, norm_g, ctx_out):
    px = jnp.split(hx @ w_in, EVEN_CUTS, axis=-1)
    pc = jnp.split(hc @ w_in, EVEN_CUTS, axis=-1)
    na_q, na_k, na_v = (heads(p, NA_HEADS) for p in px[:3])
    nc_q, nc_k, nc_v = (heads(p, NA_HEADS) for p in pc[:3])
    a_x = neighbourhood_attention(na_q, na_k, na_v, nc_k, nc_v, rpb)
    qx, vx, kx, lfx = hgrn2_inputs(px[3:7], lb)
    qc, vc, kc, lfc = hgrn2_inputs(pc[3:7], lb)
    ox, oc = bidirectional_recurrence(qx, vx, kx, lfx, qc, vc, kc, lfc, HG_CHUNK, True, ctx_out)
    g_x = merge(rms_norm(ox, norm_g) * jax.nn.silu(heads(px[7], HG_HEADS)))
    yx = jnp.concatenate([merge(a_x), g_x], -1) @ w_out
    if not ctx_out:
        return yx, None
    a_c = full_attention(nc_q, nc_k, nc_v)
    g_c = merge(rms_norm(oc, norm_g) * jax.nn.silu(heads(pc[7], HG_HEADS)))
    return yx, jnp.concatenate([merge(a_c), g_c], -1) @ w_out


def odd_mixer(hx, hc, w_in, w_out, log_decay, ctx_out):
    b, n, _ = hx.shape
    l = hc.shape[1]
    qx, kx, vx, gx = jnp.split(hx @ w_in, ODD_CUTS, axis=-1)
    t = jnp.arange(n)
    rows, cols = t // GRID_W, t % GRID_W
    qx = rope_2d(heads(qx, RET_HEADS), rows, cols)
    kx = rope_2d(heads(kx, RET_HEADS), rows, cols) * RET_QK_DIM ** -0.5
    vx = heads(vx, RET_HEADS)
    if ctx_out:
        qc, kc, vc, gc = jnp.split(hc @ w_in, ODD_CUTS, axis=-1)
        qc = heads(qc, RET_HEADS)
    else:
        kc, vc = jnp.split(hc @ w_in[:, ODD_CUTS[0]:ODD_CUTS[2]], [RET_QK_W], axis=-1)
        qc = None
    kc = heads(kc, RET_HEADS) * RET_QK_DIM ** -0.5
    vc = heads(vc, RET_HEADS)
    decay = lambda tl: [jnp.broadcast_to(log_decay[d].astype(F32)[None, :, None, None], (b, RET_HEADS, tl, 1))
                        for d in range(2)]
    ox, oc = bidirectional_recurrence(qx, vx, [kx, kx], decay(n), qc, vc, [kc, kc], decay(l),
                                      RET_CHUNK, False, ctx_out)
    yx = (merge(group_norm(ox)) * jax.nn.silu(gx)) @ w_out
    if not ctx_out:
        return yx, None
    return yx, (merge(group_norm(oc)) * jax.nn.silu(gc)) @ w_out


def setup_inputs(seed: int = 0) -> dict:
    key = jax.random.key(seed)
    keys = iter(jax.random.split(key, 32))

    def nrm(shape, scale):
        return jax.random.normal(next(keys), shape, F32) * scale

    d = D_MODEL
    decay0 = jnp.log1p(-jnp.exp2(-5.0 - jnp.arange(RET_HEADS, dtype=F32)))
    return {
        'x': nrm((BATCH, SEQ, d), 1.0),
        'c': nrm((BATCH, d), 1.0),
        'ctx': nrm((BATCH, CTX_LEN, d), 1.0),
        'c_ctx': nrm((d,), 1.0),
        'ada_w': nrm((DEPTH, d, 6 * d), 0.5 * d ** -0.5),
        'ada_b': nrm((DEPTH, 6 * d), 0.02),
        'ln_g': 1.0 + nrm((DEPTH, 2, d), 0.02),
        'ln_b': nrm((DEPTH, 2, d), 0.02),
        'e_w_in': nrm((N_EVEN, d, EVEN_IN), d ** -0.5),
        'e_w_out': nrm((N_EVEN, EVEN_MIX, d), BETA * EVEN_MIX ** -0.5),
        'na_rpb': nrm((N_EVEN, NA_HEADS, 2 * NA_KH - 1, 2 * NA_KW - 1), 0.05),
        'hg_lb_logits': nrm((2, N_EVEN, HG_WIDTH), 0.5),
        'hg_norm_g': 1.0 + nrm((N_EVEN, HG_KEY_DIM), 0.02),
        'ffn_w1': nrm((N_EVEN, d, FFN_DIM), d ** -0.5),
        'ffn_w3': nrm((N_EVEN, d, FFN_DIM), d ** -0.5),
        'ffn_w2': nrm((N_EVEN, FFN_DIM, d), BETA * FFN_DIM ** -0.5),
        'o_w_in': nrm((N_ODD, d, ODD_IN), d ** -0.5),
        'o_w_out': nrm((N_ODD, RET_V_W, d), BETA * RET_V_W ** -0.5),
        'ret_log_decay': decay0 * jax.random.uniform(next(keys), (N_ODD, 2, RET_HEADS), F32, 0.9, 1.1),
        'router_w': nrm((N_ODD, d, N_EXPERTS), d ** -0.5),
        'router_b': nrm((N_ODD, N_EXPERTS), 0.01),
        'moe_w1': nrm((N_ODD, N_EXPERTS, d, EXPERT_DIM), d ** -0.5),
        'moe_w3': nrm((N_ODD, N_EXPERTS, d, EXPERT_DIM), d ** -0.5),
        'moe_w2': nrm((N_ODD, N_EXPERTS, EXPERT_DIM, d), BETA * EXPERT_DIM ** -0.5),
    }


def reference(x, c, ctx, c_ctx, ada_w, ada_b, ln_g, ln_b, e_w_in, e_w_out, na_rpb, hg_lb_logits, hg_norm_g,
              ffn_w1, ffn_w3, ffn_w2, o_w_in, o_w_out, ret_log_decay, router_w, router_b, moe_w1, moe_w3, moe_w2):
    lb_cum = jnp.cumsum(jax.nn.softmax(hg_lb_logits.astype(F32), axis=1), axis=1)
    lower_bounds = lb_cum - lb_cum[:, :1]
    s_x = jax.nn.silu(c)
    s_c = jax.nn.silu(c_ctx)
    for layer in range(DEPTH):
        j = layer // 2
        last = layer == DEPTH - 1
        mx = [m[:, None, :] for m in jnp.split(s_x @ ada_w[layer] + ada_b[layer], 6, axis=-1)]
        mc = jnp.split(s_c @ ada_w[layer] + ada_b[layer], 6, axis=-1)
        hx = modulate(x, mx[0], mx[1])
        hc = modulate(ctx, mc[0], mc[1])
        if layer % 2 == 0:
            yx, yc = even_mixer(hx, hc, e_w_in[j], e_w_out[j], na_rpb[j], lower_bounds[:, j], hg_norm_g[j], not last)
            ffn = lambda h: swiglu(h, ffn_w1[j], ffn_w3[j], ffn_w2[j])
        else:
            yx, yc = odd_mixer(hx, hc, o_w_in[j], o_w_out[j], ret_log_decay[j], not last)
            ffn = lambda h: moe_swiglu(h, router_w[j], router_b[j], moe_w1[j], moe_w3[j], moe_w2[j])
        x = layer_norm(ALPHA * x + mx[2] * yx, ln_g[layer, 0], ln_b[layer, 0])
        x = layer_norm(ALPHA * x + mx[5] * ffn(modulate(x, mx[3], mx[4])), ln_g[layer, 1], ln_b[layer, 1])
        if not last:
            ctx = layer_norm(ALPHA * ctx + mc[2] * yc, ln_g[layer, 0], ln_b[layer, 0])
            ctx = layer_norm(ALPHA * ctx + mc[5] * ffn(modulate(ctx, mc[3], mc[4])), ln_g[layer, 1], ln_b[layer, 1])
    return x
```

```cpp
#include <hip/hip_runtime.h>
#include <cstdio>
#include <cstdint>

#define LAS __attribute__((address_space(3)))
typedef _Float16 f16;
typedef f16 f16x8 __attribute__((ext_vector_type(8)));
typedef f16 f16x4 __attribute__((ext_vector_type(4)));
typedef f16 f16x2 __attribute__((ext_vector_type(2)));
typedef float f32x4 __attribute__((ext_vector_type(4)));
typedef float f32x2 __attribute__((ext_vector_type(2)));
typedef unsigned u32x4 __attribute__((ext_vector_type(4)));
typedef unsigned u32x2 __attribute__((ext_vector_type(2)));
typedef short s16x4 __attribute__((ext_vector_type(4)));
typedef __bf16 bf16x8 __attribute__((ext_vector_type(8)));
typedef __bf16 bf16x2 __attribute__((ext_vector_type(2)));

constexpr int D = 1024, NB = 4, SEQ = 4096, TX = NB * SEQ, CL = 256, TC = NB * CL, M = TX + TC;
constexpr int DEPTH = 4, GW = 64;
constexpr int EVEN_IN = 4096, ODD_IN = 6144, FFN = 2816, NE = 8, EDIM = 3584;
constexpr float ALPHA = 1.681792830507429f;
constexpr float LN_EPS = 1e-5f, NORM_EPS = 1e-6f;
constexpr int NTHREADS = 512, NWAVES = 8;
constexpr int MOE_ROWS = 36864, MOE_TILES = MOE_ROWS / 256;

constexpr size_t MiB = 1u << 20;
constexpr size_t WS_CTL = 0, CTL_BYTES = 32768;
constexpr size_t WS_MOD = 1 * MiB;
constexpr size_t WS_ROUTE = 2 * MiB;
constexpr size_t WS_TILEX = 3 * MiB;
constexpr size_t WS_ROPET = 3 * MiB + 65536;
constexpr size_t WS_EWIN = 4 * MiB;
constexpr size_t WS_EWOUT = WS_EWIN + 16 * MiB;
constexpr size_t WS_FW13 = WS_EWOUT + 4 * MiB;
constexpr size_t WS_FW2 = WS_FW13 + 22 * MiB;
constexpr size_t WS_OWIN = WS_FW2 + 11 * MiB;
constexpr size_t WS_OWOUT = WS_OWIN + 24 * MiB;
constexpr size_t WS_MW13 = WS_OWOUT + 8 * MiB;
constexpr size_t WS_MW2 = WS_MW13 + 112 * MiB;
constexpr size_t WS_X = WS_MW2 + 56 * MiB;
constexpr size_t WS_V = WS_X + 68 * MiB;
constexpr size_t WS_H = WS_V + 68 * MiB;
constexpr size_t WS_BIG = WS_H + 34 * MiB;
constexpr size_t WS_P = WS_BIG;
constexpr size_t WS_MIX = WS_BIG + 204 * MiB;
constexpr size_t WS_OD = WS_BIG + 272 * MiB;
constexpr size_t WS_G = WS_BIG;
constexpr size_t WS_XP = WS_BIG;
constexpr size_t WS_GP = WS_BIG + 72 * MiB;
constexpr size_t WS_Y2P = WS_BIG + 324 * MiB;
constexpr size_t WS_HST = WS_BIG + 136 * MiB;
constexpr size_t WS_HGT = WS_BIG + 154 * MiB;
constexpr size_t WS_HQD = WS_BIG + 340 * MiB;
constexpr size_t WS_HUT = WS_BIG + 374 * MiB;
constexpr size_t WS_PM = WS_BIG + 408 * MiB;
constexpr size_t WS_MW13B = WS_BIG + 424 * MiB;
constexpr size_t WS_END = WS_BIG + 536 * MiB;

constexpr int CW_CNT = 1024;
constexpr int CW_BAR = 4096;

struct Params {
    const float *x, *c, *ctx, *c_ctx, *ada_w, *ada_b, *ln_g, *ln_b, *e_w_in, *e_w_out, *na_rpb, *hg_lb, *hg_norm_g,
        *ffn_w1, *ffn_w3, *ffn_w2, *o_w_in, *o_w_out, *ret_ld, *router_w, *router_b, *moe_w1, *moe_w3, *moe_w2;
    float* out;
    unsigned char* ws;
};

#define LDS_BARRIER() do { asm volatile("s_waitcnt lgkmcnt(0)" ::: "memory"); __builtin_amdgcn_s_barrier(); asm volatile("" ::: "memory"); } while (0)
__device__ __forceinline__ int tid_fresh() { int t = threadIdx.x; asm volatile("" : "+v"(t)); return t; }
__device__ __forceinline__ float silu_f(float v) { return v * __builtin_amdgcn_rcpf(1.0f + __expf(-v)); }
__device__ __forceinline__ int row_vec(int row) { return row < TX ? (row >> 12) : 4; }
__device__ __forceinline__ float wave_sum(float v) {
#pragma unroll
    for (int o = 1; o < 64; o <<= 1) v += __shfl_xor(v, o);
    return v;
}

namespace pg8 {
constexpr int BM = 256, BK = 64, HALF = 128, HTB = HALF * BK * 2, STAGE_BYTES = 8 * HTB, NXCD = 8, WGM = 8;
__host__ __device__ __forceinline__ int lds_byte(int r, int c) { const int st = (r >> 4) * 2 + (c >> 5), rr = r & 15, cc = c & 31, ob = rr * 64 + cc * 2; return st * 1024 + (ob ^ (((ob >> 9) & 1) << 5)); }
__host__ __device__ __forceinline__ void stage_rc(int b, int& R, int& C) { const int st = b / 1024, sb = b % 1024, swz = sb ^ (((sb >> 9) & 1) << 5); R = (st >> 1) * 16 + swz / 64; C = (st & 1) * 32 + (swz % 64) / 2; }
__host__ __device__ __forceinline__ int perm32(int rho) { const int n = rho >> 4, i = rho & 15; return 8 * (i >> 2) + 4 * n + (i & 3); }

struct Unit { int pm, pn; };
struct Gemm { const f16* A; const f16* Bt; int M, N, K; };

struct StaticOrder {
    int nM, nN, nwg, G, c;
    __host__ __device__ void init(int M_, int N_, int G_, int c_) { nM = M_ / BM; nN = N_ / BM; nwg = nM * nN; G = G_; c = c_; }
    __host__ __device__ bool next(int i, Unit& u) const {
        const long L = (long)i * G + c; if (L >= nwg) return false;
        int wgid = (int)L; { const int q = nwg / NXCD, r = nwg % NXCD, xcd = wgid % NXCD, off = wgid / NXCD; wgid = (xcd < r ? xcd * (q + 1) : r * (q + 1) + (xcd - r) * q) + off; }
        const int nig = WGM * nN, gid = wgid / nig, fm = gid * WGM, gsz = (nM - fm) < WGM ? (nM - fm) : WGM;
        u.pm = fm + ((wgid % nig) % gsz); u.pn = (wgid % nig) / gsz; return true;
    }
    __device__ __forceinline__ void a_ready(const Unit&) const {}
    __device__ __forceinline__ void done(const Unit&) const {}
};
struct GroupedOrder {
    const int* tile_expert; int ntiles, nN, G, c;
    __device__ bool next(int i, Unit& u) const {
        const long L = (long)i * G + c; if (L >= (long)ntiles * nN) return false;
        const int pm = (int)(L / nN), pl = (int)(L % nN);
        u.pm = pm; u.pn = __builtin_amdgcn_readfirstlane(__hip_atomic_load(tile_expert + pm, __ATOMIC_RELAXED, __HIP_MEMORY_SCOPE_AGENT)) * nN + pl; return true;
    }
    __device__ __forceinline__ void a_ready(const Unit&) const {}
    __device__ __forceinline__ void done(const Unit&) const {}
};

template <class Epi, class Sched, bool ALIGN_EPI = false, bool SP2 = false>
__device__ __forceinline__ void gemm_phase(LAS unsigned char* lds, const Gemm g, const Sched& S, const Epi& E) {
    const int tid = tid_fresh(), wid = __builtin_amdgcn_readfirstlane(tid >> 6), lane = tid & 63, wr = wid >> 2, wc = wid & 3, fr = lane & 15, fq = lane >> 4;
    const int K = g.K, nt = K / BK;
    unsigned voffA[2], voffB[2];
#pragma unroll
    for (int i = 0; i < 2; ++i) { int R, C; stage_rc(tid * 16 + i * 8192, R, C); const int Rb = Epi::PERM ? ((R & ~31) + perm32(R & 31)) : R;
        voffA[i] = (unsigned)(R * K + C) * 2u; voffB[i] = (unsigned)(Rb * K + C) * 2u; }
    const size_t kstep = (size_t)(BK * 2);
    const size_t hstep = (size_t)HALF * K * 2;
    const size_t tstep = 2 * hstep;
    const unsigned ldsw = (unsigned)wid * 1024u;
    const int aoff = lds_byte(wr * 64 + fr, fq * 8), boff = lds_byte(wc * 32 + fr, fq * 8);
#define PG8_SA(b, h) (((b) * 2 + (h)) * HTB)
#define PG8_SB(b, h) ((4 + (b) * 2 + (h)) * HTB)
#define PG8_STAGE(bufoff, gbase, voff) do { _Pragma("unroll") for (int _i = 0; _i < 2; ++_i) \
        __builtin_amdgcn_global_load_lds((const unsigned*)((const char*)(gbase) + (voff)[_i]), (LAS unsigned*)(lds + (bufoff) + ldsw + _i * 8192), 16, 0, 0); } while (0)
#define PG8_LDA(dst, b, h) do { _Pragma("unroll") for (int m = 0; m < 4; ++m) _Pragma("unroll") for (int k = 0; k < 2; ++k) dst[m][k] = *(const LAS f16x8*)(lds + PG8_SA(b, h) + aoff + m * 2048 + k * 1024); } while (0)
#define PG8_LDB(dst, b, h) do { _Pragma("unroll") for (int n = 0; n < 2; ++n) _Pragma("unroll") for (int k = 0; k < 2; ++k) dst[n][k] = *(const LAS f16x8*)(lds + PG8_SB(b, h) + boff + n * 2048 + k * 1024); } while (0)
#define PG8_MMA(ai, bj, At, Bt) do { __builtin_amdgcn_s_setprio(1); _Pragma("unroll") for (int m = 0; m < 4; ++m) _Pragma("unroll") for (int n = 0; n < 2; ++n) _Pragma("unroll") for (int k = 0; k < 2; ++k) \
        acc[ai][bj][m][n] = __builtin_amdgcn_mfma_f32_16x16x32_f16(Bt[n][k], At[m][k], acc[ai][bj][m][n], 0, 0, 0); __builtin_amdgcn_s_setprio(0); } while (0)
#define PG8_WAIT_V(n) asm volatile("s_waitcnt vmcnt(" #n ")" ::: "memory")
#define PG8_WAIT_L(n) asm volatile("s_waitcnt lgkmcnt(" #n ")" ::: "memory")
#define PG8_BAR __builtin_amdgcn_s_barrier()
#define PG8_SCHED __builtin_amdgcn_sched_barrier(0)
    Unit cur, nxt; int ui = 0;
    if (!S.next(0, cur)) return;
    f32x4 acc[2][2][4][2];
#pragma unroll
    for (int a = 0; a < 2; ++a)
#pragma unroll
        for (int b = 0; b < 2; ++b)
#pragma unroll
            for (int m = 0; m < 4; ++m)
#pragma unroll
                for (int n = 0; n < 2; ++n) acc[a][b][m][n] = (f32x4){0.f, 0.f, 0.f, 0.f};
    f16x8 At[4][2], B0[2][2], B1[2][2];
    const char* cA = (const char*)g.A + (size_t)cur.pm * tstep; const char* cB = (const char*)g.Bt + (size_t)cur.pn * tstep;
    S.a_ready(cur);
    if constexpr (SP2) {
        PG8_STAGE(PG8_SB(0, 0), cB, voffB); PG8_STAGE(PG8_SB(0, 1), cB + hstep, voffB); PG8_STAGE(PG8_SA(0, 0), cA, voffA); PG8_STAGE(PG8_SA(0, 1), cA + hstep, voffA);
        if (wr == 1) PG8_BAR;
        PG8_WAIT_V(2); PG8_BAR;
        PG8_STAGE(PG8_SB(1, 0), cB + kstep, voffB); PG8_STAGE(PG8_SA(1, 0), cA + kstep, voffA); PG8_STAGE(PG8_SB(1, 1), cB + hstep + kstep, voffB);
        PG8_WAIT_V(6); PG8_BAR;
    } else {
        PG8_STAGE(PG8_SB(0, 0), cB, voffB); PG8_STAGE(PG8_SA(0, 0), cA, voffA); PG8_STAGE(PG8_SB(0, 1), cB + hstep, voffB); PG8_STAGE(PG8_SA(0, 1), cA + hstep, voffA);
        if (wr == 1) PG8_BAR;
        PG8_WAIT_V(4); PG8_BAR;
        PG8_STAGE(PG8_SB(1, 0), cB + kstep, voffB); PG8_STAGE(PG8_SA(1, 0), cA + kstep, voffA); PG8_STAGE(PG8_SB(1, 1), cB + hstep + kstep, voffB);
        PG8_WAIT_V(6); PG8_BAR;
    }
    for (;;) {
        const bool has_next = S.next(ui + 1, nxt);
        const char* nA = has_next ? (const char*)g.A + (size_t)nxt.pm * tstep : cA; const char* nB = has_next ? (const char*)g.Bt + (size_t)nxt.pn * tstep : cB;
        for (int t = 0; t < nt; t += 2) {
            const bool last = (t == nt - 2);
            const char* a1 = cA + (size_t)(t + 1) * kstep;
            const char* a2 = last ? nA : cA + (size_t)(t + 2) * kstep; const char* b2 = last ? nB : cB + (size_t)(t + 2) * kstep;
            const char* a3 = a2 + kstep; const char* b3 = b2 + kstep;
            if (last && has_next) S.a_ready(nxt);
            if constexpr (SP2) {
            PG8_LDB(B0, 0, 0); PG8_LDB(B1, 0, 1); PG8_SCHED; PG8_LDA(At, 0, 0); PG8_STAGE(PG8_SA(1, 1), a1 + hstep, voffA);
            PG8_WAIT_V(8); PG8_WAIT_L(0); PG8_BAR; PG8_MMA(0, 0, At, B0); PG8_MMA(0, 1, At, B1); PG8_BAR; PG8_SCHED;
            PG8_LDA(At, 0, 1); PG8_STAGE(PG8_SB(0, 0), b2, voffB); PG8_STAGE(PG8_SB(0, 1), b2 + hstep, voffB); PG8_STAGE(PG8_SA(0, 0), a2, voffA);
            PG8_WAIT_V(8); PG8_WAIT_L(0); PG8_BAR; PG8_MMA(1, 0, At, B0); PG8_MMA(1, 1, At, B1); PG8_BAR; PG8_SCHED;
            PG8_LDB(B0, 1, 0); PG8_LDB(B1, 1, 1); PG8_SCHED; PG8_LDA(At, 1, 0); PG8_STAGE(PG8_SA(0, 1), a2 + hstep, voffA);
            PG8_WAIT_V(8); PG8_WAIT_L(0); PG8_BAR; PG8_MMA(0, 0, At, B0); PG8_MMA(0, 1, At, B1); PG8_BAR; PG8_SCHED;
            PG8_LDA(At, 1, 1); PG8_STAGE(PG8_SB(1, 0), b3, voffB); PG8_STAGE(PG8_SB(1, 1), b3 + hstep, voffB); PG8_STAGE(PG8_SA(1, 0), a3, voffA);
            PG8_WAIT_V(8); PG8_WAIT_L(0); PG8_BAR; PG8_MMA(1, 0, At, B0); PG8_MMA(1, 1, At, B1); PG8_BAR; PG8_SCHED;
            } else {
            PG8_LDB(B0, 0, 0); PG8_SCHED; PG8_LDA(At, 0, 0); PG8_STAGE(PG8_SA(1, 1), a1 + hstep, voffA);
            PG8_WAIT_L(8); PG8_BAR; PG8_WAIT_L(0); PG8_MMA(0, 0, At, B0); PG8_BAR; PG8_SCHED;
            PG8_LDB(B1, 0, 1); PG8_STAGE(PG8_SB(0, 0), b2, voffB);
            PG8_BAR; PG8_WAIT_L(0); PG8_MMA(0, 1, At, B1); PG8_BAR;
            PG8_LDA(At, 0, 1); PG8_STAGE(PG8_SA(0, 0), a2, voffA);
            PG8_BAR; PG8_WAIT_L(0); PG8_MMA(1, 0, At, B0); PG8_BAR; PG8_SCHED;
            PG8_STAGE(PG8_SB(0, 1), b2 + hstep, voffB);
            PG8_WAIT_V(6); PG8_BAR; PG8_MMA(1, 1, At, B1); PG8_BAR;
            PG8_LDB(B0, 1, 0); PG8_SCHED; PG8_LDA(At, 1, 0); PG8_STAGE(PG8_SA(0, 1), a2 + hstep, voffA);
            PG8_WAIT_L(8); PG8_BAR; PG8_WAIT_L(0); PG8_MMA(0, 0, At, B0); PG8_BAR; PG8_SCHED;
            PG8_LDB(B1, 1, 1); PG8_STAGE(PG8_SB(1, 0), b3, voffB);
            PG8_BAR; PG8_WAIT_L(0); PG8_MMA(0, 1, At, B1); PG8_BAR;
            PG8_LDA(At, 1, 1); PG8_STAGE(PG8_SA(1, 0), a3, voffA);
            PG8_BAR; PG8_WAIT_L(0); PG8_MMA(1, 0, At, B0); PG8_BAR; PG8_SCHED;
            PG8_STAGE(PG8_SB(1, 1), b3 + hstep, voffB);
            PG8_WAIT_V(6); PG8_BAR; PG8_MMA(1, 1, At, B1); PG8_BAR;
            }
        }
        if constexpr (ALIGN_EPI) { if (wr == 0) PG8_BAR; }
        E(acc, cur, wr, wc, fr, fq); S.done(cur);
        if (!has_next) break;
#pragma unroll
        for (int a = 0; a < 2; ++a)
#pragma unroll
            for (int b = 0; b < 2; ++b)
#pragma unroll
                for (int m = 0; m < 4; ++m)
#pragma unroll
                    for (int n = 0; n < 2; ++n) acc[a][b][m][n] = (f32x4){0.f, 0.f, 0.f, 0.f};
        cur = nxt; cA = nA; cB = nB; ++ui;
        if constexpr (ALIGN_EPI) { if (wr == 1) PG8_BAR; }
    }
    PG8_WAIT_V(0);
    if constexpr (!ALIGN_EPI) { if (wr == 0) PG8_BAR; }
    PG8_BAR;
#undef PG8_SA
#undef PG8_SB
#undef PG8_STAGE
#undef PG8_LDA
#undef PG8_LDB
#undef PG8_MMA
#undef PG8_WAIT_V
#undef PG8_WAIT_L
#undef PG8_BAR
#undef PG8_SCHED
}

__device__ __forceinline__ u32x4 pack8(const f32x4 a, const f32x4 b) {
    f16x8 h; h[0] = (f16)a[0]; h[1] = (f16)a[1]; h[2] = (f16)a[2]; h[3] = (f16)a[3]; h[4] = (f16)b[0]; h[5] = (f16)b[1]; h[6] = (f16)b[2]; h[7] = (f16)b[3];
    return __builtin_bit_cast(u32x4, h);
}
struct EpiF16 {
    static constexpr bool PERM = true;
    f16* O; int ldc; int nN_local;
    __device__ __forceinline__ void operator()(const f32x4 (&acc)[2][2][4][2], const Unit& u, int wr, int wc, int fr, int fq) const {
        const int row0 = u.pm * BM + wr * 64 + fr; const int col0 = (u.pn % nN_local) * BM + wc * 32 + 8 * fq;
#pragma unroll
        for (int ai = 0; ai < 2; ++ai)
#pragma unroll
            for (int m = 0; m < 4; ++m) { f16* rowp = O + (size_t)(row0 + ai * HALF + m * 16) * ldc + col0;
#pragma unroll
                for (int bj = 0; bj < 2; ++bj) *(u32x4*)(rowp + bj * HALF) = pack8(acc[ai][bj][m][0], acc[ai][bj][m][1]); }
    }
};
struct EpiRope {
    static constexpr bool PERM = true;
    f16* O; const float* T;
    __device__ __forceinline__ void operator()(const f32x4 (&acc)[2][2][4][2], const Unit& u, int wr, int wc, int fr, int fq) const {
        const int row0 = u.pm * BM + wr * 64 + fr; const int col0 = u.pn * BM + wc * 32 + 8 * fq;
        const bool isq = u.pn < 4, isk = u.pn >= 4 && u.pn < 8, latent = u.pm < TX / BM;
#pragma unroll
        for (int ai = 0; ai < 2; ++ai)
#pragma unroll
            for (int m = 0; m < 4; ++m) { const int row = row0 + ai * HALF + m * 16; f16* rowp = O + (size_t)row * ODD_IN + col0; const int n = row & (SEQ - 1);
#pragma unroll
                for (int bj = 0; bj < 2; ++bj) { f32x4 v0 = acc[ai][bj][m][0], v1 = acc[ai][bj][m][1];
                    if (isq || isk) {
                        if (latent) { const int c = col0 + bj * HALF; const int pos = ((c >> 7) & 1) ? (n & 63) : (n >> 6); const float* tp = T + ((size_t)pos * 64 + ((c & 127) >> 1)) * 2;
                            const f32x4 t0 = *(const f32x4*)tp, t1 = *(const f32x4*)(tp + 4);
                            const f32x4 a = v0, b2 = v1;
                            v0[0] = a[0] * t0[0] - a[1] * t0[1]; v0[1] = a[1] * t0[0] + a[0] * t0[1]; v0[2] = a[2] * t0[2] - a[3] * t0[3]; v0[3] = a[3] * t0[2] + a[2] * t0[3];
                            v1[0] = b2[0] * t1[0] - b2[1] * t1[1]; v1[1] = b2[1] * t1[0] + b2[0] * t1[1]; v1[2] = b2[2] * t1[2] - b2[3] * t1[3]; v1[3] = b2[3] * t1[2] + b2[2] * t1[3]; }
                        if (isk) { v0 = v0 * 0.0625f; v1 = v1 * 0.0625f; }
                    }
                    *(u32x4*)(rowp + bj * HALF) = pack8(v0, v1); } }
    }
};
struct EpiSwiglu {
    static constexpr bool PERM = true;
    f16* O; int ldc; int nN_local;
    __device__ __forceinline__ void operator()(const f32x4 (&acc)[2][2][4][2], const Unit& u, int wr, int wc, int fr, int fq) const {
        const int row0 = u.pm * BM + wr * 64 + fr; const int col0 = (u.pn % nN_local) * HALF + wc * 32 + 8 * fq;
#pragma unroll
        for (int ai = 0; ai < 2; ++ai)
#pragma unroll
            for (int m = 0; m < 4; ++m) { f16* rowp = O + (size_t)(row0 + ai * HALF + m * 16) * ldc + col0;
                f32x4 r0, r1;
#pragma unroll
                for (int j = 0; j < 4; ++j) { r0[j] = silu_f(acc[ai][0][m][0][j]) * acc[ai][1][m][0][j]; r1[j] = silu_f(acc[ai][0][m][1][j]) * acc[ai][1][m][1][j]; }
                *(u32x4*)rowp = pack8(r0, r1); }
    }
};
struct EpiResid {
    static constexpr bool PERM = false;
    const f16* X; f16* V; const float* modl; int gate;
    __device__ __forceinline__ void operator()(const f32x4 (&acc)[2][2][4][2], const Unit& u, int wr, int wc, int fr, int fq) const {
        const int row0 = u.pm * BM + wr * 64 + fr, col0 = u.pn * BM + wc * 32 + 4 * fq;
#pragma unroll
        for (int ai = 0; ai < 2; ++ai)
#pragma unroll
            for (int m = 0; m < 4; ++m) { const int row = row0 + ai * HALF + m * 16; const size_t off = (size_t)row * D + col0;
                const float* mrow = modl + row_vec(row) * 6144 + gate + col0;
#pragma unroll
                for (int bj = 0; bj < 2; ++bj)
#pragma unroll
                    for (int n = 0; n < 2; ++n) { const f16x4 xh = *(const f16x4*)(X + off + bj * HALF + n * 16); const f32x4 xs = (f32x4){(float)xh[0], (float)xh[1], (float)xh[2], (float)xh[3]}; const f32x4 mg = *(const f32x4*)(mrow + bj * HALF + n * 16);
                        const f32x4 vv = xs * ALPHA + mg * acc[ai][bj][m][n]; f16x4 hv; hv[0] = (f16)vv[0]; hv[1] = (f16)vv[1]; hv[2] = (f16)vv[2]; hv[3] = (f16)vv[3];
                        *(f16x4*)(V + off + bj * HALF + n * 16) = hv; } }
    }
};
}

constexpr int CG_P = 144;
__device__ __forceinline__ void gemm_ctx64(LAS unsigned char* lds, const f16* A, const f16* Bt, int K, const f16* X, f16* V, const float* modctx_gate, int bid, int nblk) {
    const int tid = tid_fresh(); const int wave = __builtin_amdgcn_readfirstlane(tid >> 6), lane = tid & 63, li = lane & 15, g = lane >> 4;
    const int wm = wave & 3, wn = wave >> 2, pr = tid >> 3, pc = tid & 7, nk = K / 64;
    for (int tile = bid; tile < 256; tile += nblk) {
        const int row0 = TX + 64 * (tile >> 4), col0 = 64 * (tile & 15);
        const f16* ap = A + (size_t)(row0 + pr) * K + pc * 8; const f16* bp = Bt + (size_t)(col0 + pr) * K + pc * 8;
        f32x4 acc[2]; acc[0] = (f32x4){0.f, 0.f, 0.f, 0.f}; acc[1] = (f32x4){0.f, 0.f, 0.f, 0.f};
        u32x4 ra = *(const u32x4*)ap, rb = *(const u32x4*)bp;
        __syncthreads();
        *(LAS u32x4*)(lds + pr * CG_P + pc * 16) = ra; *(LAS u32x4*)(lds + 2 * 64 * CG_P + pr * CG_P + pc * 16) = rb;
        __syncthreads();
        for (int ks = 0; ks < nk; ++ks) {
            const int cur = ks & 1;
            if (ks + 1 < nk) { ra = *(const u32x4*)(ap + 64 * (ks + 1)); rb = *(const u32x4*)(bp + 64 * (ks + 1)); }
            LAS unsigned char* As = lds + cur * 64 * CG_P; LAS unsigned char* Bs = lds + (2 + cur) * 64 * CG_P;
            f16x8 af[2], bf[2][2];
#pragma unroll
            for (int kk = 0; kk < 2; ++kk) { af[kk] = *(LAS f16x8*)(As + (16 * wm + li) * CG_P + (32 * kk + 8 * g) * 2);
#pragma unroll
                for (int nb = 0; nb < 2; ++nb) bf[nb][kk] = *(LAS f16x8*)(Bs + (32 * wn + 16 * nb + li) * CG_P + (32 * kk + 8 * g) * 2); }
#pragma unroll
            for (int kk = 0; kk < 2; ++kk)
#pragma unroll
                for (int nb = 0; nb < 2; ++nb) acc[nb] = __builtin_amdgcn_mfma_f32_16x16x32_f16(bf[nb][kk], af[kk], acc[nb], 0, 0, 0);
            if (ks + 1 < nk) { *(LAS u32x4*)(lds + (cur ^ 1) * 64 * CG_P + pr * CG_P + pc * 16) = ra; *(LAS u32x4*)(lds + (2 + (cur ^ 1)) * 64 * CG_P + pr * CG_P + pc * 16) = rb; }
            __syncthreads();
        }
        const size_t row = (size_t)(row0 + 16 * wm + li);
#pragma unroll
        for (int nb = 0; nb < 2; ++nb) { const int col = col0 + 32 * wn + 16 * nb + 4 * g;
            const f16x4 xh = *(const f16x4*)(X + row * D + col); const f32x4 xs = (f32x4){(float)xh[0], (float)xh[1], (float)xh[2], (float)xh[3]}, mg = *(const f32x4*)(modctx_gate + col);
            const f32x4 vv = xs * ALPHA + mg * acc[nb]; f16x4 hv; hv[0] = (f16)vv[0]; hv[1] = (f16)vv[1]; hv[2] = (f16)vv[2]; hv[3] = (f16)vv[3];
            *(f16x4*)(V + row * D + col) = hv; }
    }
}

__device__ __forceinline__ void ph_mod(const Params& P, LAS unsigned char* lds, int bid, int nblk) {
    const int tid = tid_fresh(); const int wave = tid >> 6, lane = tid & 63;
    float* mod = (float*)(P.ws + WS_MOD);
    LAS float* sv = (LAS float*)lds;
    LAS float* part = (LAS float*)(lds + 20480);
    for (int i = tid; i < 5 * D; i += NTHREADS) { const int v = i >> 10, k = i & 1023; sv[i] = silu_f(v < 4 ? P.c[v * D + k] : P.c_ctx[k]); }
    __syncthreads();
    for (int item = bid; item < DEPTH * 96; item += nblk) {
        const int l = item / 96, n = (item % 96) * 64 + lane;
        const float* w = P.ada_w + (size_t)l * D * 6144 + (size_t)(wave * 128) * 6144 + n;
        float a0 = 0.f, a1 = 0.f, a2 = 0.f, a3 = 0.f, a4 = 0.f;
        for (int k0 = 0; k0 < 128; k0 += 32) {
            float wv[32];
#pragma unroll
            for (int u = 0; u < 32; ++u) wv[u] = w[(size_t)(k0 + u) * 6144];
#pragma unroll
            for (int u = 0; u < 32; ++u) { const int kk = wave * 128 + k0 + u;
                a0 += sv[kk] * wv[u]; a1 += sv[D + kk] * wv[u]; a2 += sv[2 * D + kk] * wv[u]; a3 += sv[3 * D + kk] * wv[u]; a4 += sv[4 * D + kk] * wv[u]; }
        }
        LAS float* pw = part + wave * 320 + lane;
        pw[0] = a0; pw[64] = a1; pw[128] = a2; pw[192] = a3; pw[256] = a4;
        __syncthreads();
        if (tid < 320) { const int v = tid >> 6, ln = tid & 63; float t = 0.f;
#pragma unroll
            for (int wv = 0; wv < 8; ++wv) t += part[wv * 320 + v * 64 + ln];
            const int nn = (item % 96) * 64 + ln;
            mod[((size_t)l * 5 + v) * 6144 + nn] = t + P.ada_b[l * 6144 + nn]; }
        __syncthreads();
    }
}

constexpr int CV_P = 144;
__device__ __forceinline__ f16x4 tr_read_cv(LAS unsigned char* p) { const s16x4 v = __builtin_amdgcn_ds_read_tr16_b64_v4i16((LAS s16x4*)p); return __builtin_bit_cast(f16x4, v); }
__device__ __forceinline__ void convert_matrix(const float* W, int K, int N, f16* WT, int il, int half, LAS unsigned char* scr, int gw, int ngw, int lane, int& off) {
    const int items = (K / 64) * (N / 64), nblk = N / 64;
    const int li = lane & 15, g = lane >> 4;
    f32x4 r[16];
    auto load_item = [&](int item) { const int kb = item / nblk, nb = item % nblk; const float* src = W + (size_t)(64 * kb + g) * N + 64 * nb + 4 * li;
#pragma unroll
        for (int i = 0; i < 16; ++i) r[i] = *(const f32x4*)(src + (size_t)(4 * i) * N); };
    int it = gw - off; if (it < 0) it += ngw;
    off = (off + items) % ngw;
    if (it < items) load_item(it);
    for (; it < items; it += ngw) {
        const int kb = it / nblk, nb = it % nblk, k0 = 64 * kb, n0 = 64 * nb;
#pragma unroll
        for (int i = 0; i < 16; ++i) { f16x4 hv; hv[0] = (f16)r[i][0]; hv[1] = (f16)r[i][1]; hv[2] = (f16)r[i][2]; hv[3] = (f16)r[i][3];
            *(LAS f16x4*)(scr + (4 * i + g) * CV_P + li * 8) = hv; }
        if (it + ngw < items) load_item(it + ngw);
        f16x8 o[4][2];
#pragma unroll
        for (int nq = 0; nq < 4; ++nq)
#pragma unroll
            for (int ko = 0; ko < 2; ++ko) { LAS unsigned char* p = scr + (32 * ko + 8 * g + (li >> 2)) * CV_P + (16 * nq + 4 * (li & 3)) * 2;
                o[nq][ko] = __builtin_shufflevector(tr_read_cv(p), tr_read_cv(p + 4 * CV_P), 0, 1, 2, 3, 4, 5, 6, 7); }
#pragma unroll
        for (int nq = 0; nq < 4; ++nq) { const int n = n0 + 16 * nq + li;
            const int row = il == 1 ? ((n >> 7) * 256 + half * 128 + (n & 127)) : (il == 2 && n < 2048 ? ((n & ~127) + 2 * (n & 63) + ((n >> 6) & 1)) : n);
#pragma unroll
            for (int ko = 0; ko < 2; ++ko) *(f16x8*)(WT + (size_t)row * K + k0 + 32 * ko + 8 * g) = o[nq][ko]; }
    }
}
__device__ __forceinline__ void ph_convert_static(const Params& P, LAS unsigned char* lds, int bid, int nblk) {
    const int tidf = tid_fresh(); const int wave = tidf >> 6, lane = tidf & 63, gw = bid * NWAVES + wave, ngw = nblk * NWAVES;
    LAS unsigned char* scr = lds + wave * 16384; int off = 0;
    for (int j = 0; j < 2; ++j) {
        convert_matrix(P.e_w_in + (size_t)j * D * EVEN_IN, D, EVEN_IN, (f16*)(P.ws + WS_EWIN) + (size_t)j * EVEN_IN * D, 0, 0, scr, gw, ngw, lane, off);
        convert_matrix(P.e_w_out + (size_t)j * D * D, D, D, (f16*)(P.ws + WS_EWOUT) + (size_t)j * D * D, 0, 0, scr, gw, ngw, lane, off);
        convert_matrix(P.ffn_w1 + (size_t)j * D * FFN, D, FFN, (f16*)(P.ws + WS_FW13) + (size_t)j * 2 * FFN * D, 1, 0, scr, gw, ngw, lane, off);
        convert_matrix(P.ffn_w3 + (size_t)j * D * FFN, D, FFN, (f16*)(P.ws + WS_FW13) + (size_t)j * 2 * FFN * D, 1, 1, scr, gw, ngw, lane, off);
        convert_matrix(P.ffn_w2 + (size_t)j * FFN * D, FFN, D, (f16*)(P.ws + WS_FW2) + (size_t)j * D * FFN, 0, 0, scr, gw, ngw, lane, off);
        convert_matrix(P.o_w_in + (size_t)j * D * ODD_IN, D, ODD_IN, (f16*)(P.ws + WS_OWIN) + (size_t)j * ODD_IN * D, 2, 0, scr, gw, ngw, lane, off);
        convert_matrix(P.o_w_out + (size_t)j * 2048 * D, 2048, D, (f16*)(P.ws + WS_OWOUT) + (size_t)j * D * 2048, 0, 0, scr, gw, ngw, lane, off);
    }
}
__device__ __forceinline__ void convert_tile_plain(const float* W, int K, int N, f16* WT, LAS unsigned char* scr, int item, int lane) {
    const int nblk = N / 64, kb = item / nblk, nb = item % nblk, k0 = 64 * kb, n0 = 64 * nb, li = lane & 15, g = lane >> 4;
    const float* src = W + (size_t)(k0 + g) * N + n0 + 4 * li;
    f32x4 r[16];
#pragma unroll
    for (int i = 0; i < 16; ++i) r[i] = *(const f32x4*)(src + (size_t)(4 * i) * N);
#pragma unroll
    for (int i = 0; i < 16; ++i) { f16x4 hv; hv[0] = (f16)r[i][0]; hv[1] = (f16)r[i][1]; hv[2] = (f16)r[i][2]; hv[3] = (f16)r[i][3]; *(LAS f16x4*)(scr + (4 * i + g) * CV_P + li * 8) = hv; }
#pragma unroll
    for (int nq = 0; nq < 4; ++nq)
#pragma unroll
        for (int ko = 0; ko < 2; ++ko) { LAS unsigned char* p = scr + (32 * ko + 8 * g + (li >> 2)) * CV_P + (16 * nq + 4 * (li & 3)) * 2;
            const f16x8 o = __builtin_shufflevector(tr_read_cv(p), tr_read_cv(p + 4 * CV_P), 0, 1, 2, 3, 4, 5, 6, 7);
            *(f16x8*)(WT + (size_t)(n0 + 16 * nq + li) * K + k0 + 32 * ko + 8 * g) = o; }
}
__device__ __forceinline__ void convert_tile_il(const float* W, int K, int N, f16* WT, int half, LAS unsigned char* scr, int item, int lane) {
    const int nblk = N / 64, kb = item / nblk, nb = item % nblk, k0 = 64 * kb, n0 = 64 * nb, li = lane & 15, g = lane >> 4;
    const float* src = W + (size_t)(k0 + g) * N + n0 + 4 * li;
    f32x4 r[16];
#pragma unroll
    for (int i = 0; i < 16; ++i) r[i] = *(const f32x4*)(src + (size_t)(4 * i) * N);
#pragma unroll
    for (int i = 0; i < 16; ++i) { f16x4 hv; hv[0] = (f16)r[i][0]; hv[1] = (f16)r[i][1]; hv[2] = (f16)r[i][2]; hv[3] = (f16)r[i][3]; *(LAS f16x4*)(scr + (4 * i + g) * CV_P + li * 8) = hv; }
#pragma unroll
    for (int nq = 0; nq < 4; ++nq)
#pragma unroll
        for (int ko = 0; ko < 2; ++ko) { LAS unsigned char* p = scr + (32 * ko + 8 * g + (li >> 2)) * CV_P + (16 * nq + 4 * (li & 3)) * 2;
            const f16x8 o = __builtin_shufflevector(tr_read_cv(p), tr_read_cv(p + 4 * CV_P), 0, 1, 2, 3, 4, 5, 6, 7);
            const int n = n0 + 16 * nq + li;
            *(f16x8*)(WT + (size_t)((n >> 7) * 256 + half * 128 + (n & 127)) * K + k0 + 32 * ko + 8 * g) = o; }
}
constexpr int W13_TILES = (D / 64) * (EDIM / 64);
constexpr int W13_PRO = 5632;
__device__ __forceinline__ void bg_convert_w13(const Params& P, int j, int a, int b, int w0, f16* dst, LAS unsigned char* lds, int bid, int nblk) {
    if (bid < w0) return;
    const int nw = nblk - w0;
    const int tidf = tid_fresh(); const int wave = tidf >> 6, lane = tidf & 63;
    LAS unsigned char* scr = lds + wave * 16384;
    for (int gi = a + (bid - w0) * NWAVES + wave; gi < b; gi += nw * NWAVES) {
        const int e = gi / (2 * W13_TILES), r = gi % (2 * W13_TILES), half = r / W13_TILES, it = r % W13_TILES;
        const float* W = (half ? P.moe_w3 : P.moe_w1) + ((size_t)j * NE + e) * D * EDIM;
        convert_tile_il(W, D, EDIM, dst + (size_t)e * 2 * EDIM * D, half, scr, it, lane);
    }
}
constexpr int W2_TILES = (EDIM / 64) * (D / 64);
__device__ __forceinline__ void bg_convert_w2(const Params& P, int j, int a, int b, int heavy, LAS unsigned char* lds, int bid, int nblk) {
    const int w0 = heavy % nblk, nw = nblk - w0;
    if (bid < w0) return;
    const int tidf = tid_fresh(); const int wave = tidf >> 6, lane = tidf & 63;
    LAS unsigned char* scr = lds + wave * 16384;
    for (int gi = a + (bid - w0) * NWAVES + wave; gi < b; gi += nw * NWAVES) {
        const int e = gi / W2_TILES, it = gi % W2_TILES;
        convert_tile_plain(P.moe_w2 + ((size_t)j * NE + e) * D * EDIM, EDIM, D, (f16*)(P.ws + WS_MW2) + (size_t)e * D * EDIM, scr, it, lane);
    }
}
__device__ __forceinline__ void ph_convert_moe(const Params& P, int j, LAS unsigned char* lds, int bid, int nblk, int which = 3) {
    const int tidf = tid_fresh(); const int wave = tidf >> 6, lane = tidf & 63, gw = bid * NWAVES + wave, ngw = nblk * NWAVES;
    LAS unsigned char* scr = lds + wave * 16384; int off = 0;
    for (int e = 0; e < NE; ++e) {
        const size_t wo = ((size_t)j * NE + e) * D * EDIM;
        if (which & 1) {
            convert_matrix(P.moe_w1 + wo, D, EDIM, (f16*)(P.ws + WS_MW13) + (size_t)e * 2 * EDIM * D, 1, 0, scr, gw, ngw, lane, off);
            convert_matrix(P.moe_w3 + wo, D, EDIM, (f16*)(P.ws + WS_MW13) + (size_t)e * 2 * EDIM * D, 1, 1, scr, gw, ngw, lane, off);
        }
        if (which & 2) convert_matrix(P.moe_w2 + wo, EDIM, D, (f16*)(P.ws + WS_MW2) + (size_t)e * D * EDIM, 0, 0, scr, gw, ngw, lane, off);
    }
}

__device__ __forceinline__ void ph_prep0(const Params& P, int bid, int nblk) {
    const int tidf = tid_fresh(); const int wave = tidf >> 6, lane = tidf & 63, gw = bid * NWAVES + wave, ngw = nblk * NWAVES;
    const float* mod = (const float*)(P.ws + WS_MOD);
    f16* X = (f16*)(P.ws + WS_X); f16* H = (f16*)(P.ws + WS_H);
    for (int row0 = gw; row0 < M; row0 += 3 * ngw) {
        f32x4 v[3][4];
#pragma unroll
        for (int i = 0; i < 3; ++i) { const int row = row0 + i * ngw;
            if (row < M) { const float* src = row < TX ? P.x + (size_t)row * D : P.ctx + (size_t)(row - TX) * D;
#pragma unroll
                for (int j = 0; j < 4; ++j) v[i][j] = *(const f32x4*)(src + 4 * lane + 256 * j); } }
#pragma unroll
        for (int i = 0; i < 3; ++i) { const int row = row0 + i * ngw;
            if (row < M) { const float* mv = mod + (size_t)row_vec(row) * 6144;
#pragma unroll
                for (int j = 0; j < 4; ++j) { const int col = 4 * lane + 256 * j; const f32x4 vv = v[i][j];
                    { f16x4 xh; xh[0] = (f16)vv[0]; xh[1] = (f16)vv[1]; xh[2] = (f16)vv[2]; xh[3] = (f16)vv[3]; *(f16x4*)(X + (size_t)row * D + col) = xh; }
                    const f32x4 sh = *(const f32x4*)(mv + col), sc = *(const f32x4*)(mv + D + col);
                    const f32x4 h = vv * (sc + 1.0f) + sh; f16x4 hh; hh[0] = (f16)h[0]; hh[1] = (f16)h[1]; hh[2] = (f16)h[2]; hh[3] = (f16)h[3];
                    *(f16x4*)(H + (size_t)row * D + col) = hh; } } }
    }
}

template <int MODE>
__device__ __forceinline__ void ph_ln(const Params& P, int layer, int which, int bid, int nblk, bool last, LAS unsigned char* lds = nullptr, int mrows = M) {
    const int tidf = tid_fresh(); const int wave = tidf >> 6, lane = tidf & 63, gw = bid * NWAVES + wave, ngw = nblk * NWAVES;
    const float* mod = (const float*)(P.ws + WS_MOD);
    f16* X = (f16*)(P.ws + WS_X); const f16* V = (const f16*)(P.ws + WS_V); f16* H = (f16*)(P.ws + WS_H);
    const float* lg = P.ln_g + ((size_t)layer * 2 + which) * D; const float* lb = P.ln_b + ((size_t)layer * 2 + which) * D;
    const int ml = which == 0 ? layer : layer + 1; const int sh_off = which == 0 ? 3 * D : 0, sc_off = which == 0 ? 4 * D : D;
    const int j = layer >> 1;
    int* route = (int*)(P.ws + WS_ROUTE);
    const f16* Y2p = (const f16*)(P.ws + WS_Y2P);
    LAS unsigned* lcnt = (LAS unsigned*)lds;
    if (MODE == 1) { if (tidf < 16) lcnt[tidf] = 0u; __syncthreads(); }
    const int r_begin = (int)(((long)gw * mrows) / ngw), r_end = (int)(((long)(gw + 1) * mrows) / ngw);
    const bool has_next_mod = !(which == 1 && layer == DEPTH - 1);
    f32x4 pgg[4], pbb[4], psh[4], psc[4], pm5[4]; int curvec = -1;
#pragma unroll
    for (int q = 0; q < 4; ++q) { const int col = 4 * lane + 256 * q; pgg[q] = *(const f32x4*)(lg + col); pbb[q] = *(const f32x4*)(lb + col); }
    for (int row = r_begin; row < r_end; ++row) {
        const int vec = row_vec(row);
        if (vec != curvec) { curvec = vec;
            const float* mv = mod + ((size_t)(has_next_mod ? ml : layer) * 5 + vec) * 6144; const float* m5 = mod + ((size_t)layer * 5 + vec) * 6144 + 5 * D;
#pragma unroll
            for (int q = 0; q < 4; ++q) { const int col = 4 * lane + 256 * q; psh[q] = *(const f32x4*)(mv + sh_off + col); psc[q] = *(const f32x4*)(mv + sc_off + col); if (MODE == 2) pm5[q] = *(const f32x4*)(m5 + col); } }
        f32x4 v[4]; float s = 0.f;
        if (MODE == 2) {
            const int rtv = route[(size_t)row * 8 + (lane & 7)];
            const float g0 = __int_as_float(__shfl(rtv, 2)), g1 = __int_as_float(__shfl(rtv, 3)); const int p0 = __shfl(rtv, 6), p1 = __shfl(rtv, 7);
#pragma unroll
            for (int q = 0; q < 4; ++q) { const int col = 4 * lane + 256 * q; const f16x4 xh = *(const f16x4*)(X + (size_t)row * D + col); const f32x4 xs = (f32x4){(float)xh[0], (float)xh[1], (float)xh[2], (float)xh[3]};
                const f16x4 ya = *(const f16x4*)(Y2p + (size_t)p0 * D + col), yb = *(const f16x4*)(Y2p + (size_t)p1 * D + col); const f32x4 mg = pm5[q];
                f32x4 y;
#pragma unroll
                for (int e = 0; e < 4; ++e) y[e] = g0 * (float)ya[e] + g1 * (float)yb[e];
                v[q] = xs * ALPHA + mg * y; }
        } else {
#pragma unroll
            for (int q = 0; q < 4; ++q) { const f16x4 hv = *(const f16x4*)(V + (size_t)row * D + 4 * lane + 256 * q); v[q] = (f32x4){(float)hv[0], (float)hv[1], (float)hv[2], (float)hv[3]}; }
        }
#pragma unroll
        for (int q = 0; q < 4; ++q) s += (v[q][0] + v[q][1]) + (v[q][2] + v[q][3]);
        const float mean = wave_sum(s) * (1.f / D); float s2 = 0.f;
#pragma unroll
        for (int q = 0; q < 4; ++q) { v[q] = v[q] - mean; s2 += (v[q][0] * v[q][0] + v[q][1] * v[q][1]) + (v[q][2] * v[q][2] + v[q][3] * v[q][3]); }
        const float rstd = 1.0f / sqrtf(wave_sum(s2) * (1.f / D) + LN_EPS);
        float lg8[NE];
#pragma unroll
        for (int e = 0; e < NE; ++e) lg8[e] = 0.f;
#pragma unroll
        for (int q = 0; q < 4; ++q) { const int col = 4 * lane + 256 * q;
            const f32x4 gg = pgg[q], bb = pbb[q];
            const f32x4 y = v[q] * rstd * gg + bb;
            if (last) { if (row < TX) *(f32x4*)(P.out + (size_t)row * D + col) = y; }
            else {
                { f16x4 xh; xh[0] = (f16)y[0]; xh[1] = (f16)y[1]; xh[2] = (f16)y[2]; xh[3] = (f16)y[3]; *(f16x4*)(X + (size_t)row * D + col) = xh; }
                const f32x4 sh = psh[q], sc = psc[q];
                const f32x4 h = y * (sc + 1.0f) + sh; f16x4 hh; hh[0] = (f16)h[0]; hh[1] = (f16)h[1]; hh[2] = (f16)h[2]; hh[3] = (f16)h[3];
                *(f16x4*)(H + (size_t)row * D + col) = hh;
                if (MODE == 1) {
                    const float* rw = P.router_w + (size_t)j * D * NE + (size_t)col * NE;
#pragma unroll
                    for (int e4 = 0; e4 < 4; ++e4) {
                        const f32x4 w0 = *(const f32x4*)(rw + e4 * NE), w1 = *(const f32x4*)(rw + e4 * NE + 4);
                        lg8[0] += h[e4] * w0[0]; lg8[1] += h[e4] * w0[1]; lg8[2] += h[e4] * w0[2]; lg8[3] += h[e4] * w0[3];
                        lg8[4] += h[e4] * w1[0]; lg8[5] += h[e4] * w1[1]; lg8[6] += h[e4] * w1[2]; lg8[7] += h[e4] * w1[3];
                    }
                }
            }
        }
        if (MODE == 1) {
#pragma unroll
            for (int e = 0; e < NE; ++e) lg8[e] = wave_sum(lg8[e]) + P.router_b[j * NE + e];
            int e0 = 0; float v0 = lg8[0];
#pragma unroll
            for (int e = 1; e < NE; ++e) if (lg8[e] > v0) { v0 = lg8[e]; e0 = e; }
            int e1 = -1; float v1 = -3.0e38f;
#pragma unroll
            for (int e = 0; e < NE; ++e) if (e != e0 && lg8[e] > v1) { v1 = lg8[e]; e1 = e; }
            const float ex = __expf(v1 - v0), g0 = 1.0f / (1.0f + ex), g1 = ex / (1.0f + ex);
            if (lane == 0) {
                const int s0 = (int)__hip_atomic_fetch_add(lcnt + e0, 1u, __ATOMIC_RELAXED, __HIP_MEMORY_SCOPE_WORKGROUP), s1 = (int)__hip_atomic_fetch_add(lcnt + e1, 1u, __ATOMIC_RELAXED, __HIP_MEMORY_SCOPE_WORKGROUP);
                int* rt = route + (size_t)row * 8; rt[0] = e0; rt[1] = e1; rt[2] = __float_as_int(g0); rt[3] = __float_as_int(g1); rt[4] = s0; rt[5] = s1;
            }
        }
    }
    if (MODE == 1) {
        __syncthreads();
        if (tidf < NE) { unsigned* cnt = (unsigned*)(P.ws + WS_CTL) + CW_CNT + 64 * j; lcnt[8 + tidf] = atomicAdd(cnt + tidf, lcnt[tidf]); }
        __syncthreads();
        { const int row = r_begin + lane; if (row < r_end) { int* rt = route + (size_t)row * 8; const int e0 = rt[0], e1 = rt[1]; rt[4] += (int)lcnt[8 + e0]; rt[5] += (int)lcnt[8 + e1]; } }
        if (lane == 0) for (int row = r_begin + 64; row < r_end; ++row) { int* rt = route + (size_t)row * 8; const int e0 = rt[0], e1 = rt[1]; rt[4] += (int)lcnt[8 + e0]; rt[5] += (int)lcnt[8 + e1]; }
    }
}

__device__ __forceinline__ void ph_moe_gather(const Params& P, int j, int bid, int nblk, int mrows) {
    const int tidf = tid_fresh(); const int wave = tidf >> 6, lane = tidf & 63, gw = bid * NWAVES + wave, ngw = nblk * NWAVES;
    const unsigned* cnt = (const unsigned*)(P.ws + WS_CTL) + CW_CNT + 64 * j;
    int off[NE], pad[NE]; int acc = 0;
#pragma unroll
    for (int e = 0; e < NE; ++e) { off[e] = acc; const int c = (int)__hip_atomic_load(cnt + e, __ATOMIC_RELAXED, __HIP_MEMORY_SCOPE_AGENT); pad[e] = ((c + 255) >> 8) << 8; acc += pad[e]; }
    int* tilex = (int*)(P.ws + WS_TILEX);
    if (bid == 0 && tidf < 256) {
        const int t = tidf;
        if (t == 255) tilex[255] = acc >> 8;
        else if (t < MOE_TILES) { int ex = 0;
#pragma unroll
            for (int e = 0; e < NE; ++e) if (t * 256 >= off[e] && t * 256 < off[e] + pad[e]) ex = e;
            tilex[t] = ex; }
    }
    int* route = (int*)(P.ws + WS_ROUTE);
    const f16* H = (const f16*)(P.ws + WS_H); f16* Xp = (f16*)(P.ws + WS_XP);
    for (int row = gw; row < mrows; row += ngw) {
        int* rt = route + (size_t)row * 8;
        const int rtv = rt[lane & 7];
        const int e0 = __shfl(rtv, 0), e1 = __shfl(rtv, 1), s0 = __shfl(rtv, 4), s1 = __shfl(rtv, 5);
        int o0 = 0, o1 = 0;
#pragma unroll
        for (int e = 0; e < NE; ++e) { if (e == e0) o0 = off[e]; if (e == e1) o1 = off[e]; }
        const int p0 = o0 + s0, p1 = o1 + s1;
        if (lane == 0) { rt[6] = p0; rt[7] = p1; }
        const u32x4* src = (const u32x4*)(H + (size_t)row * D);
        const u32x4 a = src[lane], b = src[lane + 64];
        u32x4* d0 = (u32x4*)(Xp + (size_t)p0 * D); u32x4* d1 = (u32x4*)(Xp + (size_t)p1 * D);
        d0[lane] = a; d0[lane + 64] = b; d1[lane] = a; d1[lane + 64] = b;
    }
}

__device__ __forceinline__ void ph_rope_table(const Params& P, int bid, int nblk) {
    float* T = (float*)(P.ws + WS_ROPET);
    for (int idx = bid * NTHREADS + tid_fresh(); idx < 64 * 64; idx += nblk * NTHREADS) {
        const int pos = idx >> 6, i = idx & 63;
        const float inv = exp2f(-(float)i * (13.287712379549449f / 64.0f));
        float sn, cs; sincosf((float)pos * inv, &sn, &cs);
        T[2 * idx] = cs; T[2 * idx + 1] = sn;
    }
}
__device__ __forceinline__ f16x4 tr_read(LAS unsigned char* p) { const s16x4 v = __builtin_amdgcn_ds_read_tr16_b64_v4i16((LAS s16x4*)p); return __builtin_bit_cast(f16x4, v); }
__device__ __forceinline__ f16x8 cat8(const f16x4 a, const f16x4 b) { return __builtin_shufflevector(a, b, 0, 1, 2, 3, 4, 5, 6, 7); }
constexpr int RC = 64, RNCH = (CL + SEQ) / RC;
constexpr int SC = 32, SNCH = (CL + SEQ) / SC;
__device__ __forceinline__ int chunk_row0(int b, int c) { return c < CL / RC ? TX + b * CL + c * RC : b * SEQ + (c - CL / RC) * RC; }
__device__ __forceinline__ int schunk_row0(int b, int c) { return c < CL / SC ? TX + b * CL + c * SC : b * SEQ + (c - CL / SC) * SC; }

__device__ __forceinline__ void ph_ret_pm(const Params& P, int j, int bid, int nblk) {
    const int tidf = tid_fresh(); const int wave = tidf >> 6, lane = tidf & 63, gw = bid * NWAVES + wave, ngw = nblk * NWAVES;
    const int li = lane & 15, g = lane >> 4;
    const f16* Pb = (const f16*)(P.ws + WS_P); f16* PM = (f16*)(P.ws + WS_PM);
    for (int item = gw; item < 16 * SNCH; item += ngw) {
        const int bh = item / SNCH, c = item % SNCH, b = bh >> 2, h = bh & 3;
        const int row0 = schunk_row0(b, c);
        const float l2f = P.ret_ld[(j * 2 + 0) * 4 + h] * 1.4426950408889634f, l2b = P.ret_ld[(j * 2 + 1) * 4 + h] * 1.4426950408889634f;
        f32x4 acc[2][2];
#pragma unroll
        for (int sb = 0; sb < 2; ++sb)
#pragma unroll
            for (int tb = 0; tb < 2; ++tb) acc[sb][tb] = (f32x4){0.f, 0.f, 0.f, 0.f};
        const f16* kbase = Pb + (size_t)(row0 + li) * ODD_IN + 1024 + h * 256 + 8 * g;
        const f16* qbase = Pb + (size_t)(row0 + li) * ODD_IN + h * 256 + 8 * g;
        f16x8 kf[8][2], qf[8][2];
#pragma unroll
        for (int kk = 0; kk < 8; ++kk)
#pragma unroll
            for (int x = 0; x < 2; ++x) { kf[kk][x] = *(const f16x8*)(kbase + (size_t)(16 * x) * ODD_IN + 32 * kk); qf[kk][x] = *(const f16x8*)(qbase + (size_t)(16 * x) * ODD_IN + 32 * kk); }
#pragma unroll
        for (int kk = 0; kk < 8; ++kk)
#pragma unroll
            for (int sb = 0; sb < 2; ++sb)
#pragma unroll
                for (int tb = 0; tb < 2; ++tb) acc[sb][tb] = __builtin_amdgcn_mfma_f32_16x16x32_f16(kf[kk][sb], qf[kk][tb], acc[sb][tb], 0, 0, 0);
        f16* out = PM + (size_t)item * SC * SC;
#pragma unroll
        for (int sb = 0; sb < 2; ++sb)
#pragma unroll
            for (int tb = 0; tb < 2; ++tb) { const int t = 16 * tb + li; f16x4 o;
#pragma unroll
                for (int r = 0; r < 4; ++r) { const int sidx = 16 * sb + 4 * g + r; const int df = t - sidx;
                    const float w = df == 0 ? 2.0f : (df > 0 ? exp2f((float)df * l2f) : exp2f((float)(-df) * l2b));
                    o[r] = (f16)(acc[sb][tb][r] * w); }
                *(f16x4*)(out + (size_t)t * SC + 16 * sb + 4 * g) = o; }
    }
}

#ifndef SCAN_KA
#define SCAN_KA 3
#endif
#ifndef SCAN_QN
#define SCAN_QN 2
#endif
constexpr int RS_PP = 1024, RS_VG = 1088;
constexpr int RS_Q = 0, RS_K = 16 * RS_PP, RS_V = 32 * RS_PP, RS_BUF = RS_V + 4 * RS_VG;
__device__ __forceinline__ void ph_ret_scan(const Params& P, int j, LAS unsigned char* lds, int bid, int nblk) {
    const int tid = tid_fresh(); const int wave = __builtin_amdgcn_readfirstlane(tid >> 6), lane = tid & 63, li = lane & 15, g = lane >> 4;
    const bool producer = wave >= 4; const int vb = wave & 3, pw = wave & 3;
    const f16* Pb = (const f16*)(P.ws + WS_P); f16* OD = (f16*)(P.ws + WS_OD);
    for (int it0 = bid; it0 < 256; it0 += nblk) {
        const int item = (nblk == 256) ? ((it0 & 7) * 32 + (it0 >> 3)) : it0;
        const int vs = item & 7, dir = (item >> 3) & 1, h = (item >> 4) & 3, b = item >> 6;
        const float l2 = P.ret_ld[(j * 2 + dir) * 4 + h] * 1.4426950408889634f;
        const float g32 = exp2f(32.0f * l2);
        f32x4 S[16];
#pragma unroll
        for (int x = 0; x < 16; ++x) S[x] = (f32x4){0.f, 0.f, 0.f, 0.f};
        f16x8 wv;
#pragma unroll
        for (int e = 0; e < 8; ++e) { const int sI = 8 * g + e; wv[e] = (f16)exp2f((float)(dir ? sI : 31 - sI) * l2); }
        auto chunk_of = [&](int ci) { return dir == 0 ? ci : (ci < 8 ? 7 - ci : 8 + (127 - (ci - 8))); };
        auto issue = [&](int ci) {
            const int row0 = schunk_row0(b, chunk_of(ci));
            LAS unsigned char* base = lds + (ci & 3) * RS_BUF;
#pragma unroll
            for (int x = 0; x < 4; ++x) { const int pr = 4 * pw + x; const f16* rowp = Pb + (size_t)(row0 + 2 * pr + (lane >> 5)) * ODD_IN + h * 256;
                const int rowi = 2 * pr + (lane >> 5);
                __builtin_amdgcn_global_load_lds((const unsigned*)(rowp + (((lane & 31) ^ (rowi & 15)) * 8)), (LAS unsigned*)(base + RS_Q + pr * RS_PP), 16, 0, 0);
                __builtin_amdgcn_global_load_lds((const unsigned*)(rowp + 1024 + (((lane & 31) ^ (4 * (rowi & 3))) * 8)), (LAS unsigned*)(base + RS_K + pr * RS_PP), 16, 0, 0); }
            __builtin_amdgcn_global_load_lds((const unsigned*)(Pb + (size_t)(row0 + 8 * pw + (lane >> 3)) * ODD_IN + 2048 + h * 512 + vs * 64 + (lane & 7) * 8), (LAS unsigned*)(base + RS_V + pw * RS_VG), 16, 0, 0);
        };
        asm volatile("s_waitcnt vmcnt(0) lgkmcnt(0)" ::: "memory"); __builtin_amdgcn_s_barrier(); asm volatile("" ::: "memory");
        if (producer) { issue(0); issue(1); issue(2); asm volatile("s_waitcnt vmcnt(9)" ::: "memory"); }
        if (producer) {
            for (int ci = 0; ci < SNCH; ++ci) {
                asm volatile("" ::: "memory"); __builtin_amdgcn_s_barrier(); asm volatile("" ::: "memory");
                if (ci + 3 < SNCH) { issue(ci + 3); asm volatile("s_waitcnt vmcnt(9)" ::: "memory"); }
                else asm volatile("s_waitcnt vmcnt(0)" ::: "memory");
            }
        } else {
            f16x8 qfr[8][2];
            constexpr int KA = SCAN_KA, QN = SCAN_QN;
            auto rdq = [&](LAS unsigned char* bq, int kk) {
#pragma unroll
                for (int tb = 0; tb < 2; ++tb) { const int t = 16 * tb + li; qfr[kk][tb] = *(LAS f16x8*)(bq + RS_Q + t * 512 + (((4 * kk + g) ^ (t & 15)) * 16)); } };
            asm volatile("" ::: "memory"); __builtin_amdgcn_s_barrier(); asm volatile("" ::: "memory");
#pragma unroll
            for (int kk = 0; kk < QN; ++kk) rdq(lds, kk);
            asm volatile("s_waitcnt lgkmcnt(0)" ::: "memory");
            for (int ci = 0; ci < SNCH; ++ci) {
                if (ci > 0) { asm volatile("" ::: "memory"); __builtin_amdgcn_s_barrier(); asm volatile("" ::: "memory"); }
                LAS unsigned char* base = lds + (ci & 3) * RS_BUF;
                const int row0 = schunk_row0(b, chunk_of(ci));
                const int sr = 8 * g + (li >> 2);
                LAS unsigned char* vp = base + RS_V + (sr >> 3) * RS_VG + (sr & 7) * 128 + (vb * 16 + 4 * (li & 3)) * 2;
                LAS unsigned char* kp0 = base + RS_K + sr * 512 + (8 * (li & 3)) * 2;
                const int ksw = sr & 3;
#pragma unroll
                for (int kk = QN; kk < 8; ++kk) rdq(base, kk);
                f16x8 vf = cat8(tr_read(vp), tr_read(vp + 4 * 128));
                f16x8 kfr[16];
#pragma unroll
                for (int db = 0; db < KA; ++db) { LAS unsigned char* kp = kp0 + 64 * ((db >> 1) ^ ksw) + 8 * (db & 1); kfr[db] = cat8(tr_read(kp), tr_read(kp + 4 * 512)); }
                __builtin_amdgcn_sched_barrier(0);
                f32x4 o[2];
                o[0] = (f32x4){0.f, 0.f, 0.f, 0.f}; o[1] = (f32x4){0.f, 0.f, 0.f, 0.f};
#pragma unroll
                for (int kk = 0; kk < 8; ++kk) {
                    f16x8 sf;
#pragma unroll
                    for (int r = 0; r < 4; ++r) { sf[r] = (f16)S[2 * kk][r]; sf[4 + r] = (f16)S[2 * kk + 1][r]; }
#pragma unroll
                    for (int tb = 0; tb < 2; ++tb) o[tb] = __builtin_amdgcn_mfma_f32_16x16x32_f16(sf, qfr[kk][tb], o[tb], 0, 0, 0);
                }
#pragma unroll
                for (int tb = 0; tb < 2; ++tb) { const int t = 16 * tb + li; const float sc = exp2f((float)((dir ? 31 - t : t) + 1) * l2);
                    f16x4 ov; ov[0] = (f16)(o[tb][0] * sc); ov[1] = (f16)(o[tb][1] * sc); ov[2] = (f16)(o[tb][2] * sc); ov[3] = (f16)(o[tb][3] * sc);
                    const f16* optr = OD + ((size_t)dir * M + row0 + t) * 2048 + h * 512 + vs * 64 + vb * 16 + 4 * g; const u32x2 od = __builtin_bit_cast(u32x2, ov);
                    asm volatile("global_store_dwordx2 %0, %1, off\n\ts_nop 1" :: "v"(optr), "v"(od) : "memory"); }
                __builtin_amdgcn_sched_barrier(0);
#pragma unroll
                for (int db = KA; db < 16; ++db) { LAS unsigned char* kp = kp0 + 64 * ((db >> 1) ^ ksw) + 8 * (db & 1); kfr[db] = cat8(tr_read(kp), tr_read(kp + 4 * 512)); }
                if (ci + 1 < SNCH) { LAS unsigned char* nbase = lds + ((ci + 1) & 3) * RS_BUF;
#pragma unroll
                    for (int kk = 0; kk < QN; ++kk) rdq(nbase, kk); }
                __builtin_amdgcn_sched_barrier(0);
                vf = vf * wv;
#pragma unroll
                for (int db = 0; db < 16; ++db) S[db] = __builtin_amdgcn_mfma_f32_16x16x32_f16(kfr[db], vf, S[db] * g32, 0, 0, 0);
                asm volatile("s_waitcnt lgkmcnt(0)" ::: "memory");
            }
        }
    }
    asm volatile("s_waitcnt vmcnt(0) lgkmcnt(0)" ::: "memory"); __syncthreads();
}

constexpr int RF_VP = 1040, RF_PP = 80;
constexpr int RF_V = 0, RF_P = RC * RF_VP, RF_ST = RF_P + RC * RF_PP;
__device__ __forceinline__ void ph_ret_final(const Params& P, LAS unsigned char* lds, int bid, int nblk) {
    const int tid = tid_fresh(); const int wave = __builtin_amdgcn_readfirstlane(tid >> 6), lane = tid & 63, li = lane & 15, g = lane >> 4;
    const f16* Pb = (const f16*)(P.ws + WS_P); const f16* OD = (const f16*)(P.ws + WS_OD); const f16* PM = (const f16*)(P.ws + WS_PM); f16* MIX = (f16*)(P.ws + WS_MIX);
    u32x4 pv[8]; u32x2 pp;
    auto prefetch = [&](int item) {
        const int bh = item / RNCH, c = item % RNCH, b = bh >> 2, h = bh & 3; const int row0 = chunk_row0(b, c);
#pragma unroll
        for (int x = 0; x < 8; ++x) { const int p = tid + 512 * x; pv[x] = *(const u32x4*)(Pb + (size_t)(row0 + (p >> 6)) * ODD_IN + 2048 + h * 512 + (p & 63) * 8); }
        pp = *(const u32x2*)(PM + ((size_t)(bh * SNCH + 2 * c) * SC + (tid >> 3)) * SC + (tid & 7) * 4);
    };
    if (bid < 16 * RNCH) prefetch(bid);
    for (int item = bid; item < 16 * RNCH; item += nblk) {
        const int bh = item / RNCH, c = item % RNCH, b = bh >> 2, h = bh & 3;
        const int row0 = chunk_row0(b, c);
        LDS_BARRIER();
#pragma unroll
        for (int x = 0; x < 8; ++x) { const int p = tid + 512 * x; *(LAS u32x4*)(lds + RF_V + (p >> 6) * RF_VP + (p & 63) * 16) = pv[x]; }
        *(LAS u32x2*)(lds + RF_P + (tid >> 3) * RF_PP + (tid & 7) * 8) = pp;
        f16x8 oda[4][2], odb[4][2];
#pragma unroll
        for (int tb = 0; tb < 4; ++tb) { const size_t rr = (size_t)(row0 + 16 * tb + li) * 2048 + h * 512 + 64 * wave + 16 * g;
            oda[tb][0] = *(const f16x8*)(OD + rr); oda[tb][1] = *(const f16x8*)(OD + rr + 8); odb[tb][0] = *(const f16x8*)(OD + (size_t)M * 2048 + rr); odb[tb][1] = *(const f16x8*)(OD + (size_t)M * 2048 + rr + 8); }
        if (item + nblk < 16 * RNCH) prefetch(item + nblk);
        LDS_BARRIER();
        f32x4 acc[4][4];
        {
            f16x8 pf[4];
#pragma unroll
            for (int tb = 0; tb < 4; ++tb) pf[tb] = *(LAS f16x8*)(lds + RF_P + (16 * tb + li) * RF_PP + (8 * g) * 2);
#pragma unroll
            for (int vb = 0; vb < 4; ++vb) {
#pragma unroll
                for (int hf = 0; hf < 2; ++hf) {
                    LAS unsigned char* vp = lds + RF_V + (32 * hf + 8 * g + (li >> 2)) * RF_VP + (64 * wave + 16 * (li & 3) + 4 * vb) * 2;
                    const f16x8 vf = cat8(tr_read(vp), tr_read(vp + 4 * RF_VP));
#pragma unroll
                    for (int t2 = 0; t2 < 2; ++t2) acc[vb][2 * hf + t2] = __builtin_amdgcn_mfma_f32_16x16x32_f16(vf, pf[2 * hf + t2], (f32x4){0.f, 0.f, 0.f, 0.f}, 0, 0, 0);
                }
            }
        }
        float sum[4];
#pragma unroll
        for (int tb = 0; tb < 4; ++tb) { sum[tb] = 0.f;
            const f16x8 a0 = oda[tb][0], a1 = oda[tb][1], b0 = odb[tb][0], b1 = odb[tb][1];
#pragma unroll
            for (int vb = 0; vb < 4; ++vb)
#pragma unroll
                for (int r = 0; r < 4; ++r) { const int e = 4 * (vb & 1) + r; acc[vb][tb][r] += vb < 2 ? (float)a0[e] + (float)b0[e] : (float)a1[e] + (float)b1[e]; sum[tb] += acc[vb][tb][r]; } }
        LAS float* st = (LAS float*)(lds + RF_ST);
#pragma unroll
        for (int tb = 0; tb < 4; ++tb) { sum[tb] += __shfl_xor(sum[tb], 16); sum[tb] += __shfl_xor(sum[tb], 32); if (g == 0) st[(16 * tb + li) * 8 + wave] = sum[tb]; }
        LDS_BARRIER();
        float mean[4], var[4];
#pragma unroll
        for (int tb = 0; tb < 4; ++tb) { const f32x4 s0 = *(const LAS f32x4*)(st + (16 * tb + li) * 8), s1 = *(const LAS f32x4*)(st + (16 * tb + li) * 8 + 4);
            mean[tb] = ((s0[0] + s0[1]) + (s0[2] + s0[3]) + (s1[0] + s1[1]) + (s1[2] + s1[3])) * (1.f / 512.f); var[tb] = 0.f;
#pragma unroll
            for (int vb = 0; vb < 4; ++vb)
#pragma unroll
                for (int r = 0; r < 4; ++r) { acc[vb][tb][r] -= mean[tb]; var[tb] += acc[vb][tb][r] * acc[vb][tb][r]; } }
        LDS_BARRIER();
#pragma unroll
        for (int tb = 0; tb < 4; ++tb) { var[tb] += __shfl_xor(var[tb], 16); var[tb] += __shfl_xor(var[tb], 32); if (g == 0) st[(16 * tb + li) * 8 + wave] = var[tb]; }
        LDS_BARRIER();
#pragma unroll
        for (int tb = 0; tb < 4; ++tb) { const f32x4 s0 = *(const LAS f32x4*)(st + (16 * tb + li) * 8), s1 = *(const LAS f32x4*)(st + (16 * tb + li) * 8 + 4);
            const float vv = ((s0[0] + s0[1]) + (s0[2] + s0[3]) + (s1[0] + s1[1]) + (s1[2] + s1[3])) * (1.f / 512.f);
            const float rstd = 1.0f / sqrtf(vv + LN_EPS);
            const size_t prow = (size_t)(row0 + 16 * tb + li);
            { const int col = h * 512 + 64 * wave + 16 * g;
              const f16x8 g0 = *(const f16x8*)(Pb + prow * ODD_IN + 4096 + col), g1 = *(const f16x8*)(Pb + prow * ODD_IN + 4096 + col + 8); f16x8 o0, o1;
#pragma unroll
              for (int vb = 0; vb < 4; ++vb)
#pragma unroll
                  for (int r = 0; r < 4; ++r) { const int e = 4 * (vb & 1) + r; const float gq = vb < 2 ? (float)g0[e] : (float)g1[e]; const f16 y = (f16)(acc[vb][tb][r] * rstd * silu_f(gq)); if (vb < 2) o0[e] = y; else o1[e] = y; }
              *(f16x8*)(MIX + prow * 2048 + col) = o0; *(f16x8*)(MIX + prow * 2048 + col + 8) = o1; } }
    }
    __syncthreads();
}

constexpr int HC = 32, HNSEG = 16, HP = 272;
__device__ __forceinline__ int hseg_c0(int s) { return (17 * s) >> 1; }
constexpr int H_QB = 0, H_KB = HC * HP, H_Q16 = 2 * HC * HP, H_KE = 3 * HC * HP, H_V = 4 * HC * HP, H_GC = 5 * HC * HP, H_TOT = H_GC + 512;
__device__ __forceinline__ int hchunk_row0(int b, int dir, int p) { return p < 8 ? TX + b * CL + HC * (dir ? 7 - p : p) : b * SEQ + HC * (dir ? 135 - p : p - 8); }

__device__ __forceinline__ void ph_hgrn_local(const Params& P, int j, LAS unsigned char* lds, int bid, int nblk) {
    const int tid = tid_fresh(); const int wave = __builtin_amdgcn_readfirstlane(tid >> 6), lane = tid & 63, li = lane & 15, g = lane >> 4;
    const f16* Pb = (const f16*)(P.ws + WS_P); f16* OD = (f16*)(P.ws + WS_OD); f16* QD = (f16*)(P.ws + WS_HQD);
    float* UT = (float*)(P.ws + WS_HUT); float* GT = (float*)(P.ws + WS_HGT);
    for (int item = bid; item < 32 * HNSEG; item += nblk) {
        const int sidx = (item + (item >> 8)) & 15, bhd = item >> 4, dir = bhd & 1, h = (bhd >> 1) & 3, b = bhd >> 3;
        const int p0 = hseg_c0(sidx), nch = hseg_c0(sidx + 1) - p0; const int it = bhd * HNSEG + sidx;
        float lbv[2];
#pragma unroll
        for (int e = 0; e < 2; ++e) { const int cidx = h * 128 + 2 * lane + e;
            if (j == 0) lbv[e] = 0.f; else { const float l0 = P.hg_lb[(dir * 2 + 0) * 512 + cidx], l1 = P.hg_lb[(dir * 2 + 1) * 512 + cidx]; lbv[e] = 1.0f / (1.0f + __expf(l0 - l1)); } }
        float eseg[2] = {1.f, 1.f};
        f32x4 S[8];
#pragma unroll
        for (int x = 0; x < 8; ++x) S[x] = (f32x4){0.f, 0.f, 0.f, 0.f};
        f16x2 zc[4], qc[4]; u32x4 vc;
        auto load_chunk = [&](int cc) {
            const int row0 = hchunk_row0(b, dir, p0 + cc);
#pragma unroll
            for (int xs = 0; xs < 4; ++xs) { const int x = dir ? 3 - xs : xs; const f16* pr = Pb + (size_t)(row0 + 4 * wave + x) * EVEN_IN + h * 128 + 2 * lane;
                zc[xs] = *(const f16x2*)(pr + 2048 + dir * 512); qc[xs] = *(const f16x2*)(pr + 1536); }
            vc = *(const u32x4*)(Pb + (size_t)(row0 + (tid >> 4)) * EVEN_IN + 3072 + h * 128 + (tid & 15) * 8);
        };
        load_chunk(0);
        for (int cc = 0; cc < nch; ++cc) {
            const int row0 = hchunk_row0(b, dir, p0 + cc);
            LDS_BARRIER();
            *(LAS u32x4*)(lds + H_V + (tid >> 4) * HP + (tid & 15) * 16) = vc;
            float lc[4][2], kv[4][2], qv[4][2]; float run[2] = {0.f, 0.f};
#pragma unroll
            for (int xs = 0; xs < 4; ++xs) { const f16x2 z2 = zc[xs], q2 = qc[xs];
#pragma unroll
                for (int e = 0; e < 2; ++e) { const float z = (float)z2[e]; const float sg = __builtin_amdgcn_rcpf(1.0f + __expf(-z)); const float f = lbv[e] + (1.0f - lbv[e]) * sg;
                    run[e] += __logf(f); lc[xs][e] = run[e]; kv[xs][e] = (1.0f - lbv[e]) * (1.0f - sg); qv[xs][e] = silu_f((float)q2[e]); } }
            *(LAS f32x2*)(lds + H_TOT + (wave * 128 + 2 * lane) * 4) = (f32x2){run[0], run[1]};
            if (cc + 1 < nch) load_chunk(cc + 1);
            LDS_BARRIER();
            float offs[2] = {0.f, 0.f}, cl[2] = {0.f, 0.f};
#pragma unroll
            for (int gq = 0; gq < 8; ++gq) { const f32x2 t2 = *(const LAS f32x2*)(lds + H_TOT + (gq * 128 + 2 * lane) * 4); const bool before = dir ? (gq > wave) : (gq < wave);
                cl[0] += t2[0]; cl[1] += t2[1]; if (before) { offs[0] += t2[0]; offs[1] += t2[1]; } }
            const float gc0 = __expf(cl[0]), gc1 = __expf(cl[1]);
#pragma unroll
            for (int xs = 0; xs < 4; ++xs) { const int x = dir ? 3 - xs : xs; const int i = 4 * wave + x;
                float qs[2], ks[2], ke[2], qd[2];
#pragma unroll
                for (int e = 0; e < 2; ++e) { const float cum = offs[e] + lc[xs][e]; const float cumc = fmaxf(cum, -80.0f); const float e1 = __expf(cumc);
                    qs[e] = qv[xs][e] * e1; ks[e] = kv[xs][e] * __expf(-cumc); ke[e] = kv[xs][e] * __expf(cl[e] - cum); qd[e] = qs[e] * eseg[e]; }
                bf16x2 qb, kb; qb[0] = (__bf16)qs[0]; qb[1] = (__bf16)qs[1]; kb[0] = (__bf16)ks[0]; kb[1] = (__bf16)ks[1];
                f16x2 q16, k16, qd16; q16[0] = (f16)qs[0]; q16[1] = (f16)qs[1]; k16[0] = (f16)ke[0]; k16[1] = (f16)ke[1]; qd16[0] = (f16)qd[0]; qd16[1] = (f16)qd[1];
                *(LAS bf16x2*)(lds + H_QB + i * HP + lane * 4) = qb; *(LAS bf16x2*)(lds + H_KB + i * HP + lane * 4) = kb;
                *(LAS f16x2*)(lds + H_Q16 + i * HP + lane * 4) = q16; *(LAS f16x2*)(lds + H_KE + i * HP + lane * 4) = k16;
                *(f16x2*)(QD + ((size_t)dir * M + row0 + i) * 512 + h * 128 + 2 * lane) = qd16; }
            if (wave == 0) *(LAS f32x2*)(lds + H_GC + lane * 8) = (f32x2){gc0, gc1};
            eseg[0] *= gc0; eseg[1] *= gc1;
            LDS_BARRIER();
            bf16x8 kf[2][4], qf[2][4];
#pragma unroll
            for (int kk = 0; kk < 4; ++kk)
#pragma unroll
                for (int x = 0; x < 2; ++x) { kf[x][kk] = *(const LAS bf16x8*)(lds + H_KB + (16 * x + li) * HP + (32 * kk + 8 * g) * 2); qf[x][kk] = *(const LAS bf16x8*)(lds + H_QB + (16 * x + li) * HP + (32 * kk + 8 * g) * 2); }
            __builtin_amdgcn_sched_barrier(0);
            f32x4 at[2][2];
#pragma unroll
            for (int sb = 0; sb < 2; ++sb)
#pragma unroll
                for (int tb = 0; tb < 2; ++tb) at[sb][tb] = (f32x4){0.f, 0.f, 0.f, 0.f};
#pragma unroll
            for (int kk = 0; kk < 4; ++kk)
#pragma unroll
                for (int sb = 0; sb < 2; ++sb)
#pragma unroll
                    for (int tb = 0; tb < 2; ++tb) at[sb][tb] = __builtin_amdgcn_mfma_f32_16x16x32_bf16(kf[sb][kk], qf[tb][kk], at[sb][tb], 0, 0, 0);
            f16x8 vfp, vfn, af[2][4], kef[8]; f32x4 gcv[8];
            { LAS unsigned char* vp = lds + H_V + (4 * g + (li >> 2)) * HP + (16 * wave + 4 * (li & 3)) * 2; vfp = cat8(tr_read(vp), tr_read(vp + 16 * HP));
              LAS unsigned char* vp2 = lds + H_V + (8 * g + (li >> 2)) * HP + (16 * wave + 4 * (li & 3)) * 2; vfn = cat8(tr_read(vp2), tr_read(vp2 + 4 * HP)); }
#pragma unroll
            for (int kk = 0; kk < 4; ++kk)
#pragma unroll
                for (int tb = 0; tb < 2; ++tb) af[tb][kk] = *(const LAS f16x8*)(lds + H_Q16 + (16 * tb + li) * HP + (32 * kk + 8 * g) * 2);
#pragma unroll
            for (int db = 0; db < 8; ++db) { LAS unsigned char* kp = lds + H_KE + (8 * g + (li >> 2)) * HP + (32 * (db >> 1) + 8 * (li & 3) + 4 * (db & 1)) * 2;
                kef[db] = cat8(tr_read(kp), tr_read(kp + 4 * HP)); gcv[db] = *(const LAS f32x4*)(lds + H_GC + (32 * (db >> 1) + 8 * g + 4 * (db & 1)) * 4); }
            __builtin_amdgcn_sched_barrier(0);
            f16x8 pa[2];
#pragma unroll
            for (int tb = 0; tb < 2; ++tb)
#pragma unroll
                for (int sb = 0; sb < 2; ++sb)
#pragma unroll
                    for (int r = 0; r < 4; ++r) { const int si = 16 * sb + 4 * g + r, ti = 16 * tb + li; const bool keep = dir ? (si >= ti) : (si <= ti);
                        pa[tb][4 * sb + r] = (f16)(keep ? at[sb][tb][r] : 0.f); }
            f32x4 o[2];
#pragma unroll
            for (int tb = 0; tb < 2; ++tb) o[tb] = __builtin_amdgcn_mfma_f32_16x16x32_f16(vfp, pa[tb], (f32x4){0.f, 0.f, 0.f, 0.f}, 0, 0, 0);
#pragma unroll
            for (int kk = 0; kk < 4; ++kk) {
                f16x8 sf;
#pragma unroll
                for (int r = 0; r < 4; ++r) { sf[r] = (f16)S[2 * kk][r]; sf[4 + r] = (f16)S[2 * kk + 1][r]; }
#pragma unroll
                for (int tb = 0; tb < 2; ++tb) o[tb] = __builtin_amdgcn_mfma_f32_16x16x32_f16(sf, af[tb][kk], o[tb], 0, 0, 0);
            }
#pragma unroll
            for (int tb = 0; tb < 2; ++tb) { f16x4 ov; ov[0] = (f16)o[tb][0]; ov[1] = (f16)o[tb][1]; ov[2] = (f16)o[tb][2]; ov[3] = (f16)o[tb][3];
                *(f16x4*)(OD + ((size_t)dir * M + row0 + 16 * tb + li) * 512 + h * 128 + 16 * wave + 4 * g) = ov; }
#pragma unroll
            for (int db = 0; db < 8; ++db) S[db] = __builtin_amdgcn_mfma_f32_16x16x32_f16(kef[db], vfn, S[db] * gcv[db], 0, 0, 0);
        }
#pragma unroll
        for (int db = 0; db < 8; ++db) *(f32x4*)(UT + ((size_t)it * 128 + 16 * wave + li) * 128 + 32 * (db >> 1) + 8 * g + 4 * (db & 1)) = S[db];
        if (wave == 0) *(f32x2*)(GT + (size_t)it * 128 + 2 * lane) = (f32x2){eseg[0], eseg[1]};
    }
    __syncthreads();
}
__device__ __forceinline__ void ph_hgrn_carry(const Params& P, int bid, int nblk) {
    const float* UT = (const float*)(P.ws + WS_HUT); const float* GT = (const float*)(P.ws + WS_HGT); f16* ST = (f16*)(P.ws + WS_HST);
    for (int idx = bid * NTHREADS + tid_fresh(); idx < 32 * 128 * 32; idx += nblk * NTHREADS) {
        const int d4 = idx & 31, v = (idx >> 5) & 127, bhd = idx >> 12;
        f32x4 Sv = *(const f32x4*)(UT + ((size_t)(bhd * HNSEG) * 128 + v) * 128 + 4 * d4);
#pragma unroll
        for (int s0 = 1; s0 < HNSEG; s0 += 8) {
            f32x4 Gs[8], Us[8];
#pragma unroll
            for (int x = 0; x < 8; ++x) if (s0 + x < HNSEG) { const size_t it = (size_t)bhd * HNSEG + s0 + x; Gs[x] = *(const f32x4*)(GT + it * 128 + 4 * d4); Us[x] = *(const f32x4*)(UT + (it * 128 + v) * 128 + 4 * d4); }
#pragma unroll
            for (int x = 0; x < 8; ++x) if (s0 + x < HNSEG) { const size_t it = (size_t)bhd * HNSEG + s0 + x;
                f16x4 hv; hv[0] = (f16)Sv[0]; hv[1] = (f16)Sv[1]; hv[2] = (f16)Sv[2]; hv[3] = (f16)Sv[3];
                *(f16x4*)(ST + (it * 128 + v) * 128 + 4 * d4) = hv;
                Sv = Gs[x] * Sv + Us[x]; }
        }
    }
}
constexpr int HF_P = 256;
__device__ __forceinline__ void ph_hgrn_final(const Params& P, int j, LAS unsigned char* lds, int bid, int nblk) {
    const int tid = tid_fresh(); const int wave = __builtin_amdgcn_readfirstlane(tid >> 6), lane = tid & 63, li = lane & 15, g = lane >> 4;
    const f16* Pb = (const f16*)(P.ws + WS_P); const f16* OD = (const f16*)(P.ws + WS_OD); const f16* QD = (const f16*)(P.ws + WS_HQD); const f16* ST = (const f16*)(P.ws + WS_HST);
    f16* MIX = (f16*)(P.ws + WS_MIX); const float* ng = P.hg_norm_g + j * 128;
    for (int item = bid; item < 16 * HNSEG; item += nblk) {
        const int k = item & 15, bh = item >> 4, b = bh >> 2, h = bh & 3;
        const int c0 = hseg_c0(k), ntok = (hseg_c0(k + 1) - c0) * HC;
        const int blockrow0 = k == 0 ? TX + b * CL : b * SEQ + HC * (c0 - 8);
        u32x4 st[2][4]; f16x8 bq[2][4];
        f16x4 oa[8], ob[8], gv[8];
        if (k > 0) {
#pragma unroll
            for (int dir = 0; dir < 2; ++dir) { const int sidx = dir ? 16 - k : k; const size_t it = (size_t)(bh * 2 + dir) * HNSEG + sidx;
#pragma unroll
                for (int x = 0; x < 4; ++x) { const int p = tid + 512 * x; st[dir][x] = *(const u32x4*)(ST + (it * 128 + (p >> 4)) * 128 + (p & 15) * 8); } }
        }
        auto req = [&](int t0) {
            const size_t row = (size_t)(blockrow0 + t0 + li);
            if (k > 0) {
#pragma unroll
                for (int dir = 0; dir < 2; ++dir)
#pragma unroll
                    for (int kk = 0; kk < 4; ++kk) bq[dir][kk] = *(const f16x8*)(QD + ((size_t)dir * M + row) * 512 + h * 128 + 32 * kk + 8 * g); }
#pragma unroll
            for (int vb = 0; vb < 8; ++vb) { oa[vb] = *(const f16x4*)(OD + row * 512 + h * 128 + 32 * g + 4 * vb); ob[vb] = *(const f16x4*)(OD + ((size_t)M + row) * 512 + h * 128 + 32 * g + 4 * vb);
                gv[vb] = *(const f16x4*)(Pb + row * EVEN_IN + 3584 + h * 128 + 32 * g + 4 * vb); }
        };
        int t0 = 16 * wave;
        req(t0);
        __syncthreads();
        if (k > 0) {
#pragma unroll
            for (int dir = 0; dir < 2; ++dir)
#pragma unroll
                for (int x = 0; x < 4; ++x) { const int p = tid + 512 * x, v = p >> 4; *(LAS u32x4*)(lds + (dir * 128 + v) * HF_P + (((p & 15) ^ (4 * ((v >> 5) & 3) + (v & 3))) * 16)) = st[dir][x]; }
        }
        LDS_BARRIER();
        for (;;) {
            const size_t row = (size_t)(blockrow0 + t0 + li);
            f32x4 acc[8];
#pragma unroll
            for (int vb = 0; vb < 8; ++vb) acc[vb] = (f32x4){0.f, 0.f, 0.f, 0.f};
            if (k > 0) {
#pragma unroll
                for (int dir = 0; dir < 2; ++dir)
#pragma unroll
                    for (int kk = 0; kk < 4; ++kk) {
                        f16x8 af[8];
#pragma unroll
                        for (int vb = 0; vb < 8; ++vb) af[vb] = *(LAS f16x8*)(lds + (dir * 128 + 32 * (li >> 2) + 4 * vb + (li & 3)) * HF_P + (((4 * kk + g) ^ li) * 16));
#pragma unroll
                        for (int vb = 0; vb < 8; ++vb) acc[vb] = __builtin_amdgcn_mfma_f32_16x16x32_f16(af[vb], bq[dir][kk], acc[vb], 0, 0, 0);
                    }
            }
            float ss = 0.f;
#pragma unroll
            for (int vb = 0; vb < 8; ++vb) { const f16x4 a = oa[vb], bb = ob[vb];
                acc[vb] = acc[vb] + (f32x4){(float)a[0] + (float)bb[0], (float)a[1] + (float)bb[1], (float)a[2] + (float)bb[2], (float)a[3] + (float)bb[3]};
#pragma unroll
                for (int r = 0; r < 4; ++r) ss += acc[vb][r] * acc[vb][r]; }
            ss += __shfl_xor(ss, 16); ss += __shfl_xor(ss, 32);
            const float rr = 1.0f / sqrtf(ss * (1.f / 128.f) + NORM_EPS);
#pragma unroll
            for (int vb = 0; vb < 8; ++vb) { const int vc = 32 * g + 4 * vb; const f32x4 nv = *(const f32x4*)(ng + vc); f16x4 ov;
#pragma unroll
                for (int r = 0; r < 4; ++r) ov[r] = (f16)(acc[vb][r] * rr * nv[r] * silu_f((float)gv[vb][r]));
                *(f16x4*)(MIX + row * D + 512 + h * 128 + vc) = ov; }
            t0 += 128; if (t0 >= ntok) break;
            req(t0);
        }
    }
    __syncthreads();
}

constexpr int NA_P = 144;
constexpr int NA_CK = 0, NA_CV = 256 * NA_P, NA_BK = 2 * 256 * NA_P, NA_BV = NA_BK + 2 * 64 * NA_P, NA_BT = NA_BV + 2 * 64 * NA_P;
__device__ __forceinline__ void ph_na(const Params& P, int j, LAS unsigned char* lds, int bid, int nblk) {
    const int tid = tid_fresh(); const int wave = __builtin_amdgcn_readfirstlane(tid >> 6), lane = tid & 63, li = lane & 15, g = lane >> 4;
    const int wq = wave & 3, half = wave >> 2;
    const f16* Pb = (const f16*)(P.ws + WS_P); f16* MIX = (f16*)(P.ws + WS_MIX);
    LAS float* btab = (LAS float*)(lds + NA_BT + wave * 1024);
    constexpr int NX = NB * 8 * GW, NITEMS = NX + NB * 8 * (CL / 64);
    const bool xmap = (nblk == 256);
    const int npairs = NITEMS / 2, pstart = xmap ? (bid >> 3) : bid, pstep = xmap ? 32 : nblk, pend = xmap ? 136 : npairs;
    for (int lp = pstart; lp < pend; lp += pstep) {
        const int bhq = xmap ? ((bid & 7) * 4 + lp / 34) : (lp / 34), t0 = 2 * (lp % 34), t = t0 + half;
        const bool isx = t0 < 64;
        const int b = bhq >> 3, h = bhq & 7;
        int qrow, r = 0;
        if (isx) { r = t; qrow = b * SEQ + r * GW + 16 * wq + li; }
        else { qrow = TX + b * CL + 64 * (t - 64) + 16 * wq + li; }
        const int c = 16 * wq + li, cs = min(max(c - 8, 0), 48), rs = min(max(r - 4, 0), 56);
        const int rsA = min(max(t0 - 4, 0), 56), rsB = min(max(t0 + 1 - 4, 0), 56), nrows = isx ? rsB + 8 - rsA : 0;
        const int kc0 = wq == 0 ? 0 : (wq == 1 ? 8 : (wq == 2 ? 24 : 32));
        const float* rpbh = P.na_rpb + ((size_t)j * 8 + h) * 15 * 31;
        u32x4 ck[4], cv[4], bk[9], bv[9];
        { const f16* cb = Pb + (size_t)(TX + b * CL) * EVEN_IN + h * 64;
#pragma unroll
          for (int x = 0; x < 4; ++x) { const int p = tid + 512 * x; const f16* src = cb + (size_t)(p >> 3) * EVEN_IN + (p & 7) * 8; ck[x] = *(const u32x4*)(src + 512); cv[x] = *(const u32x4*)(src + 1024); } }
#pragma unroll
        for (int i = 0; i < 9; ++i) if (i < nrows) { const f16* src = Pb + (size_t)(b * SEQ + (rsA + i) * GW + (tid >> 3)) * EVEN_IN + h * 64 + (tid & 7) * 8; bk[i] = *(const u32x4*)(src + 512); bv[i] = *(const u32x4*)(src + 1024); }
        if (isx) {
#pragma unroll
            for (int x = 0; x < 4; ++x) { const int e = lane + 64 * x, bi = e >> 5, cc = e & 31; btab[e] = cc < 31 ? rpbh[(rs + bi - r + 7) * 31 + cc] : 0.f; }
        }
        f16x8 qf[2];
#pragma unroll
        for (int kk = 0; kk < 2; ++kk) { const f16x8 tq = *(const f16x8*)(Pb + (size_t)qrow * EVEN_IN + h * 64 + 32 * kk + 8 * g);
#pragma unroll
            for (int e = 0; e < 8; ++e) qf[kk][e] = (f16)((float)tq[e] * 0.125f); }
        unsigned vmask = 0u;
        const int bix0 = kc0 + 4 * g - c + 15;
#pragma unroll
        for (int jj = 0; jj < 8; ++jj) { const int mcol = kc0 + (jj < 4 ? 4 * g + jj : 16 + 4 * g + jj - 4); vmask |= ((mcol >= cs) && (mcol < cs + 16)) ? (1u << jj) : 0u; }
        f32x4 O[4];
#pragma unroll
        for (int x = 0; x < 4; ++x) O[x] = (f32x4){0.f, 0.f, 0.f, 0.f};
        float mrun = -1.0e30f, lsum = 0.f;
        auto process = [&](LAS unsigned char* kt, LAS unsigned char* vtl, int krow, int bi) {
            f16x8 kf[2][2], vf[4];
#pragma unroll
            for (int db = 0; db < 2; ++db)
#pragma unroll
                for (int kk = 0; kk < 2; ++kk) kf[db][kk] = *(LAS f16x8*)(kt + (krow + 16 * db + li) * NA_P + (32 * kk + 8 * g) * 2);
#pragma unroll
            for (int dvb = 0; dvb < 4; ++dvb) { LAS unsigned char* vp = vtl + (krow + 4 * g + (li >> 2)) * NA_P + (16 * dvb + 4 * (li & 3)) * 2; vf[dvb] = cat8(tr_read(vp), tr_read(vp + 16 * NA_P)); }
            f32x4 d1 = (f32x4){0.f, 0.f, 0.f, 0.f}, d2 = (f32x4){0.f, 0.f, 0.f, 0.f};
#pragma unroll
            for (int kk = 0; kk < 2; ++kk) { d1 = __builtin_amdgcn_mfma_f32_16x16x32_f16(kf[0][kk], qf[kk], d1, 0, 0, 0); d2 = __builtin_amdgcn_mfma_f32_16x16x32_f16(kf[1][kk], qf[kk], d2, 0, 0, 0); }
            float sc[8];
#pragma unroll
            for (int rr = 0; rr < 4; ++rr) { sc[rr] = d1[rr]; sc[4 + rr] = d2[rr]; }
            if (bi >= 0) {
                const LAS float* brow = btab + bi * 32;
                float bvv[8];
#pragma unroll
                for (int jj = 0; jj < 8; ++jj) bvv[jj] = brow[min(max(bix0 + (jj < 4 ? jj : 12 + jj), 0), 30)];
#pragma unroll
                for (int jj = 0; jj < 8; ++jj) asm volatile("" : "+v"(bvv[jj]));
#pragma unroll
                for (int jj = 0; jj < 8; ++jj) sc[jj] = ((vmask >> jj) & 1) ? sc[jj] + bvv[jj] : -1.0e30f;
            }
            float bm = fmaxf(fmaxf(fmaxf(sc[0], sc[1]), fmaxf(sc[2], sc[3])), fmaxf(fmaxf(sc[4], sc[5]), fmaxf(sc[6], sc[7])));
            bm = fmaxf(bm, __shfl_xor(bm, 16)); bm = fmaxf(bm, __shfl_xor(bm, 32));
            const float mn = fmaxf(mrun, bm), alpha = __expf(mrun - mn);
            float ps = 0.f; f16x8 pf;
#pragma unroll
            for (int jj = 0; jj < 8; ++jj) { const float pv = __expf(sc[jj] - mn); ps += pv; pf[jj] = (f16)pv; }
            lsum = lsum * alpha + ps; mrun = mn;
#pragma unroll
            for (int x = 0; x < 4; ++x) O[x] = O[x] * alpha;
#pragma unroll
            for (int dvb = 0; dvb < 4; ++dvb) O[dvb] = __builtin_amdgcn_mfma_f32_16x16x32_f16(vf[dvb], pf, O[dvb], 0, 0, 0);
        };
        __syncthreads();
#pragma unroll
        for (int x = 0; x < 4; ++x) { const int p = tid + 512 * x; *(LAS u32x4*)(lds + NA_CK + (p >> 3) * NA_P + (p & 7) * 16) = ck[x]; *(LAS u32x4*)(lds + NA_CV + (p >> 3) * NA_P + (p & 7) * 16) = cv[x]; }
        if (nrows > 0) { *(LAS u32x4*)(lds + NA_BK + (tid >> 3) * NA_P + (tid & 7) * 16) = bk[0]; *(LAS u32x4*)(lds + NA_BV + (tid >> 3) * NA_P + (tid & 7) * 16) = bv[0]; }
        LDS_BARRIER();
#pragma unroll
        for (int i = 0; i < 9; ++i) {
            if (i < nrows) {
                const int R = rsA + i; const bool active = R >= rs && R < rs + 8;
                if (active) process(lds + NA_BK + (i & 1) * 64 * NA_P, lds + NA_BV + (i & 1) * 64 * NA_P, kc0, R - rs);
                if (i + 1 < 9 && i + 1 < nrows) { *(LAS u32x4*)(lds + NA_BK + ((i + 1) & 1) * 64 * NA_P + (tid >> 3) * NA_P + (tid & 7) * 16) = bk[i + 1 < 9 ? i + 1 : 8];
                    *(LAS u32x4*)(lds + NA_BV + ((i + 1) & 1) * 64 * NA_P + (tid >> 3) * NA_P + (tid & 7) * 16) = bv[i + 1 < 9 ? i + 1 : 8]; }
                LDS_BARRIER();
            }
        }
#pragma unroll 2
        for (int cbk = 0; cbk < 8; ++cbk) process(lds + NA_CK, lds + NA_CV, 32 * cbk, -1);
        lsum += __shfl_xor(lsum, 16); lsum += __shfl_xor(lsum, 32);
        const float inv = 1.0f / lsum;
#pragma unroll
        for (int dvb = 0; dvb < 4; ++dvb) { f16x4 ov;
#pragma unroll
            for (int rr = 0; rr < 4; ++rr) ov[rr] = (f16)(O[dvb][rr] * inv);
            *(f16x4*)(MIX + (size_t)qrow * D + h * 64 + 16 * dvb + 4 * g) = ov; }
    }
    __syncthreads();
}

#define XB_TMO      128
#define XB_XCNT(j)  (256  + 64 * (j))
#define XB_XSUB(j)  (1280 + 64 * (j))
#define XB_XGEN(j)  (2304 + 64 * (j))
#define XB_TOP      3328
#define XB_TOPGEN   3392
#define XCD_BAR_WORDS 3456
#define XB_SPIN_CAP (1u << 20)
__device__ __forceinline__ unsigned xb_ld(unsigned* p)              { return __hip_atomic_load(p, __ATOMIC_RELAXED, __HIP_MEMORY_SCOPE_AGENT); }
__device__ __forceinline__ unsigned xb_add(unsigned* p, unsigned v) { return __hip_atomic_fetch_add(p, v, __ATOMIC_RELAXED, __HIP_MEMORY_SCOPE_AGENT); }
__device__ __forceinline__ unsigned xb_xcc_id() { return (unsigned)__builtin_amdgcn_s_getreg((3 << 11) | 20) & 0xFu; }
#define XB_SPIN(cond, bar) do { unsigned _sp = 0; while (cond) { __builtin_amdgcn_s_sleep(1); \
    if ((++_sp & 255u) == 0u) { if (xb_ld(&(bar)[XB_TMO])) break; if (_sp > XB_SPIN_CAP) { atomicAdd(&(bar)[XB_TMO], 1u); break; } } } } while (0)
struct XcdBarrier { unsigned* bar; unsigned x; volatile LAS unsigned* st; };
__device__ __forceinline__ XcdBarrier xcd_barrier_post(unsigned* bar, volatile LAS unsigned* st) {
    XcdBarrier b; b.bar = bar; b.x = xb_xcc_id(); b.st = st;
    if (threadIdx.x == 0) (void)xb_add(&bar[XB_XCNT(b.x)], 1u);
    return b;
}
__device__ __forceinline__ void xcd_barrier_complete(unsigned* bar, unsigned x, unsigned& nloc, unsigned& nx) {
    const unsigned G = gridDim.x * gridDim.y * gridDim.z;
    unsigned sum, cnt, mine, sp = 0u;
    for (;;) {
        sum = 0u; cnt = 0u; mine = 0u;
#pragma unroll
        for (unsigned j = 0; j < 16; ++j) { const unsigned c = xb_ld(&bar[XB_XCNT(j)]); sum += c; cnt += (c > 0u) ? 1u : 0u; mine = (j == x) ? c : mine; }
        if (sum == G) break;
        __builtin_amdgcn_s_sleep(1);
        if ((++sp & 255u) == 0u) { if (xb_ld(&bar[XB_TMO])) break; if (sp > XB_SPIN_CAP) { atomicAdd(&bar[XB_TMO], 1u); break; } }
    }
    nloc = mine > 0u ? mine : 1u; nx = cnt > 0u ? cnt : 1u;
}
__device__ __forceinline__ void xcd_barrier(const XcdBarrier& b) {
    asm volatile("s_waitcnt vmcnt(0)" ::: "memory");
    __syncthreads();
    if (threadIdx.x == 0) {
        unsigned* bar = b.bar;
        __builtin_amdgcn_s_waitcnt(0);
        unsigned nloc = b.st[0], nx = b.st[1];
        if (nloc == 0u) { xcd_barrier_complete(bar, b.x, nloc, nx); b.st[0] = nloc; b.st[1] = nx; }
        const unsigned old = xb_add(&bar[XB_XSUB(b.x)], 1u);
        const unsigned gen = old / nloc;
        if (old + 1u == (gen + 1u) * nloc) {
            __builtin_amdgcn_fence(__ATOMIC_RELEASE, "agent");
            asm volatile("s_waitcnt vmcnt(0)" ::: "memory");
            const unsigned og = xb_add(&bar[XB_TOP], 1u);
            const unsigned tg = og / nx;
            if (og + 1u == (tg + 1u) * nx) xb_add(&bar[XB_TOPGEN], 1u);
            else XB_SPIN(xb_ld(&bar[XB_TOPGEN]) == tg, bar);
            __builtin_amdgcn_fence(__ATOMIC_ACQUIRE, "agent");
            xb_add(&bar[XB_XGEN(b.x)], 1u);
            asm volatile("s_waitcnt vmcnt(0)" ::: "memory");
        } else {
            XB_SPIN(xb_ld(&bar[XB_XGEN(b.x)]) == gen, bar);
            __builtin_amdgcn_fence(__ATOMIC_ACQUIRE, "agent");
            asm volatile("s_waitcnt vmcnt(0)" ::: "memory");
        }
    }
    __syncthreads();
}

constexpr int LDS_BYTES = 159744;
constexpr int LDS_MISC = 155648;

__global__ void __launch_bounds__(NTHREADS, 2) mega_fwd(Params P) {
    extern __shared__ __attribute__((aligned(16))) unsigned char lds_raw[];
    LAS unsigned char* lds = (LAS unsigned char*)lds_raw;
    const int bid0 = blockIdx.x, nblk0 = gridDim.x;
    if (threadIdx.x < 64) ((LAS unsigned*)(lds + LDS_MISC))[threadIdx.x] = 0u;
    __syncthreads();
    XcdBarrier bar = xcd_barrier_post((unsigned*)(P.ws + WS_CTL) + CW_BAR, (volatile LAS unsigned*)(lds + LDS_MISC));
#define GRID_BAR() xcd_barrier(bar)

    {
    const int bid = bid0, nblk = nblk0;
    ph_mod(P, lds, bid, nblk);
    ph_rope_table(P, bid, nblk);
    ph_convert_static(P, lds, bid, nblk);
    ph_convert_moe(P, 0, lds, bid, nblk, 1);
    GRID_BAR();
    ph_prep0(P, bid, nblk);
    GRID_BAR();
    }

    for (int jj = 0; jj < 2; ++jj) {
        int bid_l = bid0, nblk_l = nblk0; asm volatile("" : "+s"(bid_l), "+s"(nblk_l));
        const int bid = bid_l, nblk = nblk_l;
        {
            const int layer = 2 * jj, j = jj;
            const float* modl = (const float*)(P.ws + WS_MOD) + (size_t)layer * 5 * 6144;
            {
                pg8::Gemm g{(const f16*)(P.ws + WS_H), (const f16*)(P.ws + WS_EWIN) + (size_t)j * EVEN_IN * D, M, EVEN_IN, D}; pg8::StaticOrder S; S.init(M, EVEN_IN, nblk, bid);
                pg8::EpiF16 E{(f16*)(P.ws + WS_P), EVEN_IN, EVEN_IN / 256};
                pg8::gemm_phase<pg8::EpiF16, pg8::StaticOrder, true, true>(lds, g, S, E);
                bg_convert_w2(P, jj, 0, 3200, ((M / 256) * (EVEN_IN / 256)) % nblk, lds, bid, nblk);
            }
            GRID_BAR();
            ph_na(P, j, lds, bid, nblk);
            ph_hgrn_local(P, j, lds, bid, nblk);
            bg_convert_w13(P, 1, jj == 0 ? 0 : 3400, jj == 0 ? 1400 : 4700, nblk == 256 ? 64 : 0, (f16*)(P.ws + WS_MW13B), lds, bid, nblk);
            GRID_BAR();
            ph_hgrn_carry(P, bid, nblk);
            GRID_BAR();
            ph_hgrn_final(P, j, lds, bid, nblk);
            GRID_BAR();
            {
                pg8::Gemm g{(const f16*)(P.ws + WS_MIX), (const f16*)(P.ws + WS_EWOUT) + (size_t)j * D * D, TX, D, D}; pg8::StaticOrder S; S.init(TX, D, nblk, bid);
                pg8::EpiResid E{(const f16*)(P.ws + WS_X), (f16*)(P.ws + WS_V), modl, 2 * D};
                pg8::gemm_phase<pg8::EpiResid, pg8::StaticOrder, true, true>(lds, g, S, E);
                gemm_ctx64(lds, (const f16*)(P.ws + WS_MIX), (const f16*)(P.ws + WS_EWOUT) + (size_t)j * D * D, D, (const f16*)(P.ws + WS_X), (f16*)(P.ws + WS_V), modl + 4 * 6144 + 2 * D, bid, nblk);
            }
            GRID_BAR();
            ph_ln<0>(P, layer, 0, bid, nblk, false);
            GRID_BAR();
            {
                pg8::Gemm g{(const f16*)(P.ws + WS_H), (const f16*)(P.ws + WS_FW13) + (size_t)j * 2 * FFN * D, M, 2 * FFN, D}; pg8::StaticOrder S; S.init(M, 2 * FFN, nblk, bid);
                pg8::EpiSwiglu E{(f16*)(P.ws + WS_G), FFN, 2 * FFN / 256};
                pg8::gemm_phase<pg8::EpiSwiglu, pg8::StaticOrder, true, true>(lds, g, S, E);
                bg_convert_w2(P, jj, 3200, 3840, ((M / 256) * (2 * FFN / 256)) % nblk, lds, bid, nblk);
            }
            GRID_BAR();
            {
                pg8::Gemm g{(const f16*)(P.ws + WS_G), (const f16*)(P.ws + WS_FW2) + (size_t)j * D * FFN, TX, D, FFN}; pg8::StaticOrder S; S.init(TX, D, nblk, bid);
                pg8::EpiResid E{(const f16*)(P.ws + WS_X), (f16*)(P.ws + WS_V), modl, 5 * D};
                pg8::gemm_phase<pg8::EpiResid, pg8::StaticOrder, true, true>(lds, g, S, E);
                gemm_ctx64(lds, (const f16*)(P.ws + WS_G), (const f16*)(P.ws + WS_FW2) + (size_t)j * D * FFN, FFN, (const f16*)(P.ws + WS_X), (f16*)(P.ws + WS_V), modl + 4 * 6144 + 5 * D, bid, nblk);
            }
            GRID_BAR();
            ph_ln<0>(P, layer, 1, bid, nblk, false);
            GRID_BAR();
        }
        {
            const int layer = 2 * jj + 1, j = jj;
            const bool last = (layer == DEPTH - 1);
            const float* modl = (const float*)(P.ws + WS_MOD) + (size_t)layer * 5 * 6144;
            {
                pg8::Gemm g{(const f16*)(P.ws + WS_H), (const f16*)(P.ws + WS_OWIN) + (size_t)j * ODD_IN * D, M, ODD_IN, D}; pg8::StaticOrder S; S.init(M, ODD_IN, nblk, bid);
                pg8::EpiRope E{(f16*)(P.ws + WS_P), (const float*)(P.ws + WS_ROPET)};
                pg8::gemm_phase<pg8::EpiRope, pg8::StaticOrder, true, true>(lds, g, S, E);
                bg_convert_w2(P, jj, 3840, 6400, ((M / 256) * (ODD_IN / 256)) % nblk, lds, bid, nblk);
            }
            GRID_BAR();
            ph_ret_pm(P, j, bid, nblk);
            ph_ret_scan(P, j, lds, bid, nblk);
            GRID_BAR();
            ph_ret_final(P, lds, bid, nblk);
            bg_convert_w13(P, 1, jj == 0 ? 1400 : 4700, jj == 0 ? 3400 : W13_PRO, nblk == 256 ? 64 : 0, (f16*)(P.ws + WS_MW13B), lds, bid, nblk);
            GRID_BAR();
            {
                pg8::Gemm g{(const f16*)(P.ws + WS_MIX), (const f16*)(P.ws + WS_OWOUT) + (size_t)j * D * 2048, TX, D, 2048}; pg8::StaticOrder S; S.init(TX, D, nblk, bid);
                pg8::EpiResid E{(const f16*)(P.ws + WS_X), (f16*)(P.ws + WS_V), modl, 2 * D};
                pg8::gemm_phase<pg8::EpiResid, pg8::StaticOrder, true, true>(lds, g, S, E);
                if (!last)
                    gemm_ctx64(lds, (const f16*)(P.ws + WS_MIX), (const f16*)(P.ws + WS_OWOUT) + (size_t)j * D * 2048, 2048, (const f16*)(P.ws + WS_X), (f16*)(P.ws + WS_V), modl + 4 * 6144 + 2 * D, bid, nblk);
            }
            GRID_BAR();
            ph_ln<1>(P, layer, 0, bid, nblk, false, lds, last ? TX : M);
            GRID_BAR();
            ph_moe_gather(P, j, bid, nblk, last ? TX : M);
            GRID_BAR();
            {
                const int* tilex = (const int*)(P.ws + WS_TILEX);
                const int ntiles = __builtin_amdgcn_readfirstlane(__hip_atomic_load(tilex + 255, __ATOMIC_RELAXED, __HIP_MEMORY_SCOPE_AGENT));
                pg8::Gemm g{(const f16*)(P.ws + WS_XP), (const f16*)(P.ws + (jj == 0 ? WS_MW13 : WS_MW13B)), MOE_ROWS, NE * 2 * EDIM, D};
                pg8::GroupedOrder S{tilex, ntiles, 2 * EDIM / 256, nblk, bid};
                pg8::EpiSwiglu E{(f16*)(P.ws + WS_GP), EDIM, 2 * EDIM / 256};
                pg8::gemm_phase<pg8::EpiSwiglu, pg8::GroupedOrder, true, true>(lds, g, S, E);
                bg_convert_w2(P, jj, 6400, NE * W2_TILES, (ntiles * (2 * EDIM / 256)) % nblk, lds, bid, nblk);
            }
            GRID_BAR();
            {
                const int* tilex = (const int*)(P.ws + WS_TILEX);
                const int ntiles = __builtin_amdgcn_readfirstlane(__hip_atomic_load(tilex + 255, __ATOMIC_RELAXED, __HIP_MEMORY_SCOPE_AGENT));
                pg8::Gemm g{(const f16*)(P.ws + WS_GP), (const f16*)(P.ws + WS_MW2), MOE_ROWS, NE * D, EDIM};
                pg8::GroupedOrder S{tilex, ntiles, D / 256, nblk, bid};
                pg8::EpiF16 E{(f16*)(P.ws + WS_Y2P), D, D / 256};
                pg8::gemm_phase<pg8::EpiF16, pg8::GroupedOrder, true, true>(lds, g, S, E);
                if (jj == 0) {
                    const int U = ntiles * (D / 256), heavy = U % nblk;
                    const int w0 = heavy, nw = nblk - heavy;
                    __syncthreads();
                    bg_convert_w13(P, 1, W13_PRO, NE * 2 * W13_TILES, w0, (f16*)(P.ws + WS_MW13B), lds, bid, nblk); (void)nw;
                }
            }
            GRID_BAR();
            ph_ln<2>(P, layer, 1, bid, nblk, last, nullptr, last ? TX : M);
            if (!last) GRID_BAR();
        }
    }
}

extern "C" void kernel_launch(void* const* d_in, const int* in_sizes, int n_in, void* d_out, int out_size, void* d_ws, size_t ws_size, hipStream_t stream) {
    static int grid = 0;
    if (grid == 0) {
        if (n_in != 24 || ws_size < WS_END) { fprintf(stderr, "kernel_launch: unexpected n_in %d or ws_size %zu (need %zu)\n", n_in, ws_size, (size_t)WS_END); grid = -1; return; }
        int dev = 0, cus = 0;
        if (hipGetDevice(&dev) != hipSuccess || hipDeviceGetAttribute(&cus, hipDeviceAttributeMultiprocessorCount, dev) != hipSuccess) { grid = -1; return; }
        if (hipFuncSetAttribute((const void*)mega_fwd, hipFuncAttributeMaxDynamicSharedMemorySize, LDS_BYTES) != hipSuccess) { grid = -1; return; }
        int per_cu = 0;
        (void)hipOccupancyMaxActiveBlocksPerMultiprocessor(&per_cu, (const void*)mega_fwd, NTHREADS, LDS_BYTES);
        (void)hipGetLastError();
        grid = cus;
    }
    if (grid < 0) return;
    Params p{};
    const float** pp = (const float**)&p;
    for (int i = 0; i < 24; ++i) pp[i] = (const float*)d_in[i];
    p.out = (float*)d_out; p.ws = (unsigned char*)d_ws;
    (void)hipMemsetAsync((char*)d_ws + WS_CTL, 0, CTL_BYTES, stream);
    hipLaunchKernelGGL(mega_fwd, dim3(grid), dim3(NTHREADS), LDS_BYTES, stream, p);
}
```

```cpp
#include <hip/hip_runtime.h>
#include <cstdio>
#include <cstdint>

#define LAS __attribute__((address_space(3)))
typedef _Float16 f16;
typedef f16 f16x8 __attribute__((ext_vector_type(8)));
typedef f16 f16x4 __attribute__((ext_vector_type(4)));
typedef f16 f16x2 __attribute__((ext_vector_type(2)));
typedef float f32x4 __attribute__((ext_vector_type(4)));
typedef float f32x2 __attribute__((ext_vector_type(2)));
typedef unsigned u32x4 __attribute__((ext_vector_type(4)));
typedef unsigned u32x2 __attribute__((ext_vector_type(2)));
typedef short s16x4 __attribute__((ext_vector_type(4)));
typedef __bf16 bf16x8 __attribute__((ext_vector_type(8)));
typedef __bf16 bf16x2 __attribute__((ext_vector_type(2)));

constexpr int D = 1024, NB = 4, SEQ = 4096, TX = NB * SEQ, CL = 256, TC = NB * CL, M = TX + TC;
constexpr int DEPTH = 4, GW = 64;
constexpr int EVEN_IN = 4096, ODD_IN = 6144, FFN = 2816, NE = 8, EDIM = 3584;
constexpr float ALPHA = 1.681792830507429f;
constexpr float LN_EPS = 1e-5f, NORM_EPS = 1e-6f;
constexpr int NTHREADS = 512, NWAVES = 8;
constexpr int MOE_ROWS = 36864, MOE_TILES = MOE_ROWS / 256;

constexpr size_t MiB = 1u << 20;
constexpr size_t WS_CTL = 0, CTL_BYTES = 32768;
constexpr size_t WS_MOD = 1 * MiB;
constexpr size_t WS_ROUTE = 2 * MiB;
constexpr size_t WS_TILEX = 3 * MiB;
constexpr size_t WS_ROPET = 3 * MiB + 65536;
constexpr size_t WS_EWIN = 4 * MiB;
constexpr size_t WS_EWOUT = WS_EWIN + 16 * MiB;
constexpr size_t WS_FW13 = WS_EWOUT + 4 * MiB;
constexpr size_t WS_FW2 = WS_FW13 + 22 * MiB;
constexpr size_t WS_OWIN = WS_FW2 + 11 * MiB;
constexpr size_t WS_OWOUT = WS_OWIN + 24 * MiB;
constexpr size_t WS_MW13 = WS_OWOUT + 8 * MiB;
constexpr size_t WS_MW2 = WS_MW13 + 112 * MiB;
constexpr size_t WS_X = WS_MW2 + 56 * MiB;
constexpr size_t WS_V = WS_X + 68 * MiB;
constexpr size_t WS_H = WS_V + 68 * MiB;
constexpr size_t WS_BIG = WS_H + 34 * MiB;
constexpr size_t WS_P = WS_BIG;
constexpr size_t WS_MIX = WS_BIG + 204 * MiB;
constexpr size_t WS_OD = WS_BIG + 272 * MiB;
constexpr size_t WS_G = WS_BIG;
constexpr size_t WS_XP = WS_BIG;
constexpr size_t WS_GP = WS_BIG + 72 * MiB;
constexpr size_t WS_Y2P = WS_BIG + 324 * MiB;
constexpr size_t WS_HST = WS_BIG + 136 * MiB;
constexpr size_t WS_HGT = WS_BIG + 154 * MiB;
constexpr size_t WS_HQD = WS_BIG + 340 * MiB;
constexpr size_t WS_HUT = WS_BIG + 374 * MiB;
constexpr size_t WS_PM = WS_BIG + 408 * MiB;
constexpr size_t WS_MW13B = WS_BIG + 424 * MiB;
constexpr size_t WS_END = WS_BIG + 536 * MiB;

constexpr int CW_CNT = 1024;
constexpr int CW_BAR = 4096;

struct Params {
    const float *x, *c, *ctx, *c_ctx, *ada_w, *ada_b, *ln_g, *ln_b, *e_w_in, *e_w_out, *na_rpb, *hg_lb, *hg_norm_g,
        *ffn_w1, *ffn_w3, *ffn_w2, *o_w_in, *o_w_out, *ret_ld, *router_w, *router_b, *moe_w1, *moe_w3, *moe_w2;
    float* out;
    unsigned char* ws;
};

#define LDS_BARRIER() do { asm volatile("s_waitcnt lgkmcnt(0)" ::: "memory"); __builtin_amdgcn_s_barrier(); asm volatile("" ::: "memory"); } while (0)
__device__ __forceinline__ int tid_fresh() { int t = threadIdx.x; asm volatile("" : "+v"(t)); return t; }
__device__ __forceinline__ float silu_f(float v) { return v * __builtin_amdgcn_rcpf(1.0f + __expf(-v)); }
__device__ __forceinline__ int row_vec(int row) { return row < TX ? (row >> 12) : 4; }
__device__ __forceinline__ float wave_sum(float v) {
#pragma unroll
    for (int o = 1; o < 64; o <<= 1) v += __shfl_xor(v, o);
    return v;
}

namespace pg8 {
constexpr int BM = 256, BK = 64, HALF = 128, HTB = HALF * BK * 2, STAGE_BYTES = 8 * HTB, NXCD = 8, WGM = 8;
__host__ __device__ __forceinline__ int lds_byte(int r, int c) { const int st = (r >> 4) * 2 + (c >> 5), rr = r & 15, cc = c & 31, ob = rr * 64 + cc * 2; return st * 1024 + (ob ^ (((ob >> 9) & 1) << 5)); }
__host__ __device__ __forceinline__ void stage_rc(int b, int& R, int& C) { const int st = b / 1024, sb = b % 1024, swz = sb ^ (((sb >> 9) & 1) << 5); R = (st >> 1) * 16 + swz / 64; C = (st & 1) * 32 + (swz % 64) / 2; }
__host__ __device__ __forceinline__ int perm32(int rho) { const int n = rho >> 4, i = rho & 15; return 8 * (i >> 2) + 4 * n + (i & 3); }

struct Unit { int pm, pn; };
struct Gemm { const f16* A; const f16* Bt; int M, N, K; };

struct StaticOrder {
    int nM, nN, nwg, G, c;
    __host__ __device__ void init(int M_, int N_, int G_, int c_) { nM = M_ / BM; nN = N_ / BM; nwg = nM * nN; G = G_; c = c_; }
    __host__ __device__ bool next(int i, Unit& u) const {
        const long L = (long)i * G + c; if (L >= nwg) return false;
        int wgid = (int)L; { const int q = nwg / NXCD, r = nwg % NXCD, xcd = wgid % NXCD, off = wgid / NXCD; wgid = (xcd < r ? xcd * (q + 1) : r * (q + 1) + (xcd - r) * q) + off; }
        const int nig = WGM * nN, gid = wgid / nig, fm = gid * WGM, gsz = (nM - fm) < WGM ? (nM - fm) : WGM;
        u.pm = fm + ((wgid % nig) % gsz); u.pn = (wgid % nig) / gsz; return true;
    }
    __device__ __forceinline__ void a_ready(const Unit&) const {}
    __device__ __forceinline__ void done(const Unit&) const {}
};
struct GroupedOrder {
    const int* tile_expert; int ntiles, nN, G, c;
    __device__ bool next(int i, Unit& u) const {
        const long L = (long)i * G + c; if (L >= (long)ntiles * nN) return false;
        const int pm = (int)(L / nN), pl = (int)(L % nN);
        u.pm = pm; u.pn = __builtin_amdgcn_readfirstlane(__hip_atomic_load(tile_expert + pm, __ATOMIC_RELAXED, __HIP_MEMORY_SCOPE_AGENT)) * nN + pl; return true;
    }
    __device__ __forceinline__ void a_ready(const Unit&) const {}
    __device__ __forceinline__ void done(const Unit&) const {}
};

template <class Epi, class Sched, bool ALIGN_EPI = false, bool SP2 = false>
__device__ __forceinline__ void gemm_phase(LAS unsigned char* lds, const Gemm g, const Sched& S, const Epi& E) {
    const int tid = tid_fresh(), wid = __builtin_amdgcn_readfirstlane(tid >> 6), lane = tid & 63, wr = wid >> 2, wc = wid & 3, fr = lane & 15, fq = lane >> 4;
    const int K = g.K, nt = K / BK;
    unsigned voffA[2], voffB[2];
#pragma unroll
    for (int i = 0; i < 2; ++i) { int R, C; stage_rc(tid * 16 + i * 8192, R, C); const int Rb = Epi::PERM ? ((R & ~31) + perm32(R & 31)) : R;
        voffA[i] = (unsigned)(R * K + C) * 2u; voffB[i] = (unsigned)(Rb * K + C) * 2u; }
    const size_t kstep = (size_t)(BK * 2);
    const size_t hstep = (size_t)HALF * K * 2;
    const size_t tstep = 2 * hstep;
    const unsigned ldsw = (unsigned)wid * 1024u;
    const int aoff = lds_byte(wr * 64 + fr, fq * 8), boff = lds_byte(wc * 32 + fr, fq * 8);
#define PG8_SA(b, h) (((b) * 2 + (h)) * HTB)
#define PG8_SB(b, h) ((4 + (b) * 2 + (h)) * HTB)
#define PG8_STAGE(bufoff, gbase, voff) do { _Pragma("unroll") for (int _i = 0; _i < 2; ++_i) \
        __builtin_amdgcn_global_load_lds((const unsigned*)((const char*)(gbase) + (voff)[_i]), (LAS unsigned*)(lds + (bufoff) + ldsw + _i * 8192), 16, 0, 0); } while (0)
#define PG8_LDA(dst, b, h) do { _Pragma("unroll") for (int m = 0; m < 4; ++m) _Pragma("unroll") for (int k = 0; k < 2; ++k) dst[m][k] = *(const LAS f16x8*)(lds + PG8_SA(b, h) + aoff + m * 2048 + k * 1024); } while (0)
#define PG8_LDB(dst, b, h) do { _Pragma("unroll") for (int n = 0; n < 2; ++n) _Pragma("unroll") for (int k = 0; k < 2; ++k) dst[n][k] = *(const LAS f16x8*)(lds + PG8_SB(b, h) + boff + n * 2048 + k * 1024); } while (0)
#define PG8_MMA(ai, bj, At, Bt) do { __builtin_amdgcn_s_setprio(1); _Pragma("unroll") for (int m = 0; m < 4; ++m) _Pragma("unroll") for (int n = 0; n < 2; ++n) _Pragma("unroll") for (int k = 0; k < 2; ++k) \
        acc[ai][bj][m][n] = __builtin_amdgcn_mfma_f32_16x16x32_f16(Bt[n][k], At[m][k], acc[ai][bj][m][n], 0, 0, 0); __builtin_amdgcn_s_setprio(0); } while (0)
#define PG8_WAIT_V(n) asm volatile("s_waitcnt vmcnt(" #n ")" ::: "memory")
#define PG8_WAIT_L(n) asm volatile("s_waitcnt lgkmcnt(" #n ")" ::: "memory")
#define PG8_BAR __builtin_amdgcn_s_barrier()
#define PG8_SCHED __builtin_amdgcn_sched_barrier(0)
    Unit cur, nxt; int ui = 0;
    if (!S.next(0, cur)) return;
    f32x4 acc[2][2][4][2];
#pragma unroll
    for (int a = 0; a < 2; ++a)
#pragma unroll
        for (int b = 0; b < 2; ++b)
#pragma unroll
            for (int m = 0; m < 4; ++m)
#pragma unroll
                for (int n = 0; n < 2; ++n) acc[a][b][m][n] = (f32x4){0.f, 0.f, 0.f, 0.f};
    f16x8 At[4][2], B0[2][2], B1[2][2];
    const char* cA = (const char*)g.A + (size_t)cur.pm * tstep; const char* cB = (const char*)g.Bt + (size_t)cur.pn * tstep;
    S.a_ready(cur);
    if constexpr (SP2) {
        PG8_STAGE(PG8_SB(0, 0), cB, voffB); PG8_STAGE(PG8_SB(0, 1), cB + hstep, voffB); PG8_STAGE(PG8_SA(0, 0), cA, voffA); PG8_STAGE(PG8_SA(0, 1), cA + hstep, voffA);
        if (wr == 1) PG8_BAR;
        PG8_WAIT_V(2); PG8_BAR;
        PG8_STAGE(PG8_SB(1, 0), cB + kstep, voffB); PG8_STAGE(PG8_SA(1, 0), cA + kstep, voffA); PG8_STAGE(PG8_SB(1, 1), cB + hstep + kstep, voffB);
        PG8_WAIT_V(6); PG8_BAR;
    } else {
        PG8_STAGE(PG8_SB(0, 0), cB, voffB); PG8_STAGE(PG8_SA(0, 0), cA, voffA); PG8_STAGE(PG8_SB(0, 1), cB + hstep, voffB); PG8_STAGE(PG8_SA(0, 1), cA + hstep, voffA);
        if (wr == 1) PG8_BAR;
        PG8_WAIT_V(4); PG8_BAR;
        PG8_STAGE(PG8_SB(1, 0), cB + kstep, voffB); PG8_STAGE(PG8_SA(1, 0), cA + kstep, voffA); PG8_STAGE(PG8_SB(1, 1), cB + hstep + kstep, voffB);
        PG8_WAIT_V(6); PG8_BAR;
    }
    for (;;) {
        const bool has_next = S.next(ui + 1, nxt);
        const char* nA = has_next ? (const char*)g.A + (size_t)nxt.pm * tstep : cA; const char* nB = has_next ? (const char*)g.Bt + (size_t)nxt.pn * tstep : cB;
        for (int t = 0; t < nt; t += 2) {
            const bool last = (t == nt - 2);
            const char* a1 = cA + (size_t)(t + 1) * kstep;
            const char* a2 = last ? nA : cA + (size_t)(t + 2) * kstep; const char* b2 = last ? nB : cB + (size_t)(t + 2) * kstep;
            const char* a3 = a2 + kstep; const char* b3 = b2 + kstep;
            if (last && has_next) S.a_ready(nxt);
            if constexpr (SP2) {
            PG8_LDB(B0, 0, 0); PG8_LDB(B1, 0, 1); PG8_SCHED; PG8_LDA(At, 0, 0); PG8_STAGE(PG8_SA(1, 1), a1 + hstep, voffA);
            PG8_WAIT_V(8); PG8_WAIT_L(0); PG8_BAR; PG8_MMA(0, 0, At, B0); PG8_MMA(0, 1, At, B1); PG8_BAR; PG8_SCHED;
            PG8_LDA(At, 0, 1); PG8_STAGE(PG8_SB(0, 0), b2, voffB); PG8_STAGE(PG8_SB(0, 1), b2 + hstep, voffB); PG8_STAGE(PG8_SA(0, 0), a2, voffA);
            PG8_WAIT_V(8); PG8_WAIT_L(0); PG8_BAR; PG8_MMA(1, 0, At, B0); PG8_MMA(1, 1, At, B1); PG8_BAR; PG8_SCHED;
            PG8_LDB(B0, 1, 0); PG8_LDB(B1, 1, 1); PG8_SCHED; PG8_LDA(At, 1, 0); PG8_STAGE(PG8_SA(0, 1), a2 + hstep, voffA);
            PG8_WAIT_V(8); PG8_WAIT_L(0); PG8_BAR; PG8_MMA(0, 0, At, B0); PG8_MMA(0, 1, At, B1); PG8_BAR; PG8_SCHED;
            PG8_LDA(At, 1, 1); PG8_STAGE(PG8_SB(1, 0), b3, voffB); PG8_STAGE(PG8_SB(1, 1), b3 + hstep, voffB); PG8_STAGE(PG8_SA(1, 0), a3, voffA);
            PG8_WAIT_V(8); PG8_WAIT_L(0); PG8_BAR; PG8_MMA(1, 0, At, B0); PG8_MMA(1, 1, At, B1); PG8_BAR; PG8_SCHED;
            } else {
            PG8_LDB(B0, 0, 0); PG8_SCHED; PG8_LDA(At, 0, 0); PG8_STAGE(PG8_SA(1, 1), a1 + hstep, voffA);
            PG8_WAIT_L(8); PG8_BAR; PG8_WAIT_L(0); PG8_MMA(0, 0, At, B0); PG8_BAR; PG8_SCHED;
            PG8_LDB(B1, 0, 1); PG8_STAGE(PG8_SB(0, 0), b2, voffB);
            PG8_BAR; PG8_WAIT_L(0); PG8_MMA(0, 1, At, B1); PG8_BAR;
            PG8_LDA(At, 0, 1); PG8_STAGE(PG8_SA(0, 0), a2, voffA);
            PG8_BAR; PG8_WAIT_L(0); PG8_MMA(1, 0, At, B0); PG8_BAR; PG8_SCHED;
            PG8_STAGE(PG8_SB(0, 1), b2 + hstep, voffB);
            PG8_WAIT_V(6); PG8_BAR; PG8_MMA(1, 1, At, B1); PG8_BAR;
            PG8_LDB(B0, 1, 0); PG8_SCHED; PG8_LDA(At, 1, 0); PG8_STAGE(PG8_SA(0, 1), a2 + hstep, voffA);
            PG8_WAIT_L(8); PG8_BAR; PG8_WAIT_L(0); PG8_MMA(0, 0, At, B0); PG8_BAR; PG8_SCHED;
            PG8_LDB(B1, 1, 1); PG8_STAGE(PG8_SB(1, 0), b3, voffB);
            PG8_BAR; PG8_WAIT_L(0); PG8_MMA(0, 1, At, B1); PG8_BAR;
            PG8_LDA(At, 1, 1); PG8_STAGE(PG8_SA(1, 0), a3, voffA);
            PG8_BAR; PG8_WAIT_L(0); PG8_MMA(1, 0, At, B0); PG8_BAR; PG8_SCHED;
            PG8_STAGE(PG8_SB(1, 1), b3 + hstep, voffB);
            PG8_WAIT_V(6); PG8_BAR; PG8_MMA(1, 1, At, B1); PG8_BAR;
            }
        }
        if constexpr (ALIGN_EPI) { if (wr == 0) PG8_BAR; }
        E(acc, cur, wr, wc, fr, fq); S.done(cur);
        if (!has_next) break;
#pragma unroll
        for (int a = 0; a < 2; ++a)
#pragma unroll
            for (int b = 0; b < 2; ++b)
#pragma unroll
                for (int m = 0; m < 4; ++m)
#pragma unroll
                    for (int n = 0; n < 2; ++n) acc[a][b][m][n] = (f32x4){0.f, 0.f, 0.f, 0.f};
        cur = nxt; cA = nA; cB = nB; ++ui;
        if constexpr (ALIGN_EPI) { if (wr == 1) PG8_BAR; }
    }
    PG8_WAIT_V(0);
    if constexpr (!ALIGN_EPI) { if (wr == 0) PG8_BAR; }
    PG8_BAR;
#undef PG8_SA
#undef PG8_SB
#undef PG8_STAGE
#undef PG8_LDA
#undef PG8_LDB
#undef PG8_MMA
#undef PG8_WAIT_V
#undef PG8_WAIT_L
#undef PG8_BAR
#undef PG8_SCHED
}

__device__ __forceinline__ u32x4 pack8(const f32x4 a, const f32x4 b) {
    f16x8 h; h[0] = (f16)a[0]; h[1] = (f16)a[1]; h[2] = (f16)a[2]; h[3] = (f16)a[3]; h[4] = (f16)b[0]; h[5] = (f16)b[1]; h[6] = (f16)b[2]; h[7] = (f16)b[3];
    return __builtin_bit_cast(u32x4, h);
}
struct EpiF16 {
    static constexpr bool PERM = true;
    f16* O; int ldc; int nN_local;
    __device__ __forceinline__ void operator()(const f32x4 (&acc)[2][2][4][2], const Unit& u, int wr, int wc, int fr, int fq) const {
        const int row0 = u.pm * BM + wr * 64 + fr; const int col0 = (u.pn % nN_local) * BM + wc * 32 + 8 * fq;
#pragma unroll
        for (int ai = 0; ai < 2; ++ai)
#pragma unroll
            for (int m = 0; m < 4; ++m) { f16* rowp = O + (size_t)(row0 + ai * HALF + m * 16) * ldc + col0;
#pragma unroll
                for (int bj = 0; bj < 2; ++bj) *(u32x4*)(rowp + bj * HALF) = pack8(acc[ai][bj][m][0], acc[ai][bj][m][1]); }
    }
};
struct EpiRope {
    static constexpr bool PERM = true;
    f16* O; const float* T;
    __device__ __forceinline__ void operator()(const f32x4 (&acc)[2][2][4][2], const Unit& u, int wr, int wc, int fr, int fq) const {
        const int row0 = u.pm * BM + wr * 64 + fr; const int col0 = u.pn * BM + wc * 32 + 8 * fq;
        const bool isq = u.pn < 4, isk = u.pn >= 4 && u.pn < 8, latent = u.pm < TX / BM;
#pragma unroll
        for (int ai = 0; ai < 2; ++ai)
#pragma unroll
            for (int m = 0; m < 4; ++m) { const int row = row0 + ai * HALF + m * 16; f16* rowp = O + (size_t)row * ODD_IN + col0; const int n = row & (SEQ - 1);
#pragma unroll
                for (int bj = 0; bj < 2; ++bj) { f32x4 v0 = acc[ai][bj][m][0], v1 = acc[ai][bj][m][1];
                    if (isq || isk) {
                        if (latent) { const int c = col0 + bj * HALF; const int pos = ((c >> 7) & 1) ? (n & 63) : (n >> 6); const float* tp = T + ((size_t)pos * 64 + ((c & 127) >> 1)) * 2;
                            const f32x4 t0 = *(const f32x4*)tp, t1 = *(const f32x4*)(tp + 4);
                            const f32x4 a = v0, b2 = v1;
                            v0[0] = a[0] * t0[0] - a[1] * t0[1]; v0[1] = a[1] * t0[0] + a[0] * t0[1]; v0[2] = a[2] * t0[2] - a[3] * t0[3]; v0[3] = a[3] * t0[2] + a[2] * t0[3];
                            v1[0] = b2[0] * t1[0] - b2[1] * t1[1]; v1[1] = b2[1] * t1[0] + b2[0] * t1[1]; v1[2] = b2[2] * t1[2] - b2[3] * t1[3]; v1[3] = b2[3] * t1[2] + b2[2] * t1[3]; }
                        if (isk) { v0 = v0 * 0.0625f; v1 = v1 * 0.0625f; }
                    }
                    *(u32x4*)(rowp + bj * HALF) = pack8(v0, v1); } }
    }
};
struct EpiSwiglu {
    static constexpr bool PERM = true;
    f16* O; int ldc; int nN_local;
    __device__ __forceinline__ void operator()(const f32x4 (&acc)[2][2][4][2], const Unit& u, int wr, int wc, int fr, int fq) const {
        const int row0 = u.pm * BM + wr * 64 + fr; const int col0 = (u.pn % nN_local) * HALF + wc * 32 + 8 * fq;
#pragma unroll
        for (int ai = 0; ai < 2; ++ai)
#pragma unroll
            for (int m = 0; m < 4; ++m) { f16* rowp = O + (size_t)(row0 + ai * HALF + m * 16) * ldc + col0;
                f32x4 r0, r1;
#pragma unroll
                for (int j = 0; j < 4; ++j) { r0[j] = silu_f(acc[ai][0][m][0][j]) * acc[ai][1][m][0][j]; r1[j] = silu_f(acc[ai][0][m][1][j]) * acc[ai][1][m][1][j]; }
                *(u32x4*)rowp = pack8(r0, r1); }
    }
};
struct EpiResid {
    static constexpr bool PERM = false;
    const f16* X; f16* V; const float* modl; int gate;
    __device__ __forceinline__ void operator()(const f32x4 (&acc)[2][2][4][2], const Unit& u, int wr, int wc, int fr, int fq) const {
        const int row0 = u.pm * BM + wr * 64 + fr, col0 = u.pn * BM + wc * 32 + 4 * fq;
#pragma unroll
        for (int ai = 0; ai < 2; ++ai)
#pragma unroll
            for (int m = 0; m < 4; ++m) { const int row = row0 + ai * HALF + m * 16; const size_t off = (size_t)row * D + col0;
                const float* mrow = modl + row_vec(row) * 6144 + gate + col0;
#pragma unroll
                for (int bj = 0; bj < 2; ++bj)
#pragma unroll
                    for (int n = 0; n < 2; ++n) { const f16x4 xh = *(const f16x4*)(X + off + bj * HALF + n * 16); const f32x4 xs = (f32x4){(float)xh[0], (float)xh[1], (float)xh[2], (float)xh[3]}; const f32x4 mg = *(const f32x4*)(mrow + bj * HALF + n * 16);
                        const f32x4 vv = xs * ALPHA + mg * acc[ai][bj][m][n]; f16x4 hv; hv[0] = (f16)vv[0]; hv[1] = (f16)vv[1]; hv[2] = (f16)vv[2]; hv[3] = (f16)vv[3];
                        *(f16x4*)(V + off + bj * HALF + n * 16) = hv; } }
    }
};
}

constexpr int CG_P = 144;
__device__ __forceinline__ void gemm_ctx64(LAS unsigned char* lds, const f16* A, const f16* Bt, int K, const f16* X, f16* V, const float* modctx_gate, int bid, int nblk) {
    const int tid = tid_fresh(); const int wave = __builtin_amdgcn_readfirstlane(tid >> 6), lane = tid & 63, li = lane & 15, g = lane >> 4;
    const int wm = wave & 3, wn = wave >> 2, pr = tid >> 3, pc = tid & 7, nk = K / 64;
    for (int tile = bid; tile < 256; tile += nblk) {
        const int row0 = TX + 64 * (tile >> 4), col0 = 64 * (tile & 15);
        const f16* ap = A + (size_t)(row0 + pr) * K + pc * 8; const f16* bp = Bt + (size_t)(col0 + pr) * K + pc * 8;
        f32x4 acc[2]; acc[0] = (f32x4){0.f, 0.f, 0.f, 0.f}; acc[1] = (f32x4){0.f, 0.f, 0.f, 0.f};
        u32x4 ra = *(const u32x4*)ap, rb = *(const u32x4*)bp;
        __syncthreads();
        *(LAS u32x4*)(lds + pr * CG_P + pc * 16) = ra; *(LAS u32x4*)(lds + 2 * 64 * CG_P + pr * CG_P + pc * 16) = rb;
        __syncthreads();
        for (int ks = 0; ks < nk; ++ks) {
            const int cur = ks & 1;
            if (ks + 1 < nk) { ra = *(const u32x4*)(ap + 64 * (ks + 1)); rb = *(const u32x4*)(bp + 64 * (ks + 1)); }
            LAS unsigned char* As = lds + cur * 64 * CG_P; LAS unsigned char* Bs = lds + (2 + cur) * 64 * CG_P;
            f16x8 af[2], bf[2][2];
#pragma unroll
            for (int kk = 0; kk < 2; ++kk) { af[kk] = *(LAS f16x8*)(As + (16 * wm + li) * CG_P + (32 * kk + 8 * g) * 2);
#pragma unroll
                for (int nb = 0; nb < 2; ++nb) bf[nb][kk] = *(LAS f16x8*)(Bs + (32 * wn + 16 * nb + li) * CG_P + (32 * kk + 8 * g) * 2); }
#pragma unroll
            for (int kk = 0; kk < 2; ++kk)
#pragma unroll
                for (int nb = 0; nb < 2; ++nb) acc[nb] = __builtin_amdgcn_mfma_f32_16x16x32_f16(bf[nb][kk], af[kk], acc[nb], 0, 0, 0);
            if (ks + 1 < nk) { *(LAS u32x4*)(lds + (cur ^ 1) * 64 * CG_P + pr * CG_P + pc * 16) = ra; *(LAS u32x4*)(lds + (2 + (cur ^ 1)) * 64 * CG_P + pr * CG_P + pc * 16) = rb; }
            __syncthreads();
        }
        const size_t row = (size_t)(row0 + 16 * wm + li);
#pragma unroll
        for (int nb = 0; nb < 2; ++nb) { const int col = col0 + 32 * wn + 16 * nb + 4 * g;
            const f16x4 xh = *(const f16x4*)(X + row * D + col); const f32x4 xs = (f32x4){(float)xh[0], (float)xh[1], (float)xh[2], (float)xh[3]}, mg = *(const f32x4*)(modctx_gate + col);
            const f32x4 vv = xs * ALPHA + mg * acc[nb]; f16x4 hv; hv[0] = (f16)vv[0]; hv[1] = (f16)vv[1]; hv[2] = (f16)vv[2]; hv[3] = (f16)vv[3];
            *(f16x4*)(V + row * D + col) = hv; }
    }
}

__device__ __forceinline__ void ph_mod(const Params& P, LAS unsigned char* lds, int bid, int nblk) {
    const int tid = tid_fresh(); const int wave = tid >> 6, lane = tid & 63;
    float* mod = (float*)(P.ws + WS_MOD);
    LAS float* sv = (LAS float*)lds;
    LAS float* part = (LAS float*)(lds + 20480);
    for (int i = tid; i < 5 * D; i += NTHREADS) { const int v = i >> 10, k = i & 1023; sv[i] = silu_f(v < 4 ? P.c[v * D + k] : P.c_ctx[k]); }
    __syncthreads();
    for (int item = bid; item < DEPTH * 96; item += nblk) {
        const int l = item / 96, n = (item % 96) * 64 + lane;
        const float* w = P.ada_w + (size_t)l * D * 6144 + (size_t)(wave * 128) * 6144 + n;
        float a0 = 0.f, a1 = 0.f, a2 = 0.f, a3 = 0.f, a4 = 0.f;
        for (int k0 = 0; k0 < 128; k0 += 32) {
            float wv[32];
#pragma unroll
            for (int u = 0; u < 32; ++u) wv[u] = w[(size_t)(k0 + u) * 6144];
#pragma unroll
            for (int u = 0; u < 32; ++u) { const int kk = wave * 128 + k0 + u;
                a0 += sv[kk] * wv[u]; a1 += sv[D + kk] * wv[u]; a2 += sv[2 * D + kk] * wv[u]; a3 += sv[3 * D + kk] * wv[u]; a4 += sv[4 * D + kk] * wv[u]; }
        }
        LAS float* pw = part + wave * 320 + lane;
        pw[0] = a0; pw[64] = a1; pw[128] = a2; pw[192] = a3; pw[256] = a4;
        __syncthreads();
        if (tid < 320) { const int v = tid >> 6, ln = tid & 63; float t = 0.f;
#pragma unroll
            for (int wv = 0; wv < 8; ++wv) t += part[wv * 320 + v * 64 + ln];
            const int nn = (item % 96) * 64 + ln;
            mod[((size_t)l * 5 + v) * 6144 + nn] = t + P.ada_b[l * 6144 + nn]; }
        __syncthreads();
    }
}

constexpr int CV_P = 144;
__device__ __forceinline__ f16x4 tr_read_cv(LAS unsigned char* p) { const s16x4 v = __builtin_amdgcn_ds_read_tr16_b64_v4i16((LAS s16x4*)p); return __builtin_bit_cast(f16x4, v); }
__device__ __forceinline__ void convert_matrix(const float* W, int K, int N, f16* WT, int il, int half, LAS unsigned char* scr, int gw, int ngw, int lane, int& off) {
    const int items = (K / 64) * (N / 64), nblk = N / 64;
    const int li = lane & 15, g = lane >> 4;
    f32x4 r[16];
    auto load_item = [&](int item) { const int kb = item / nblk, nb = item % nblk; const float* src = W + (size_t)(64 * kb + g) * N + 64 * nb + 4 * li;
#pragma unroll
        for (int i = 0; i < 16; ++i) r[i] = *(const f32x4*)(src + (size_t)(4 * i) * N); };
    int it = gw - off; if (it < 0) it += ngw;
    off = (off + items) % ngw;
    if (it < items) load_item(it);
    for (; it < items; it += ngw) {
        const int kb = it / nblk, nb = it % nblk, k0 = 64 * kb, n0 = 64 * nb;
#pragma unroll
        for (int i = 0; i < 16; ++i) { f16x4 hv; hv[0] = (f16)r[i][0]; hv[1] = (f16)r[i][1]; hv[2] = (f16)r[i][2]; hv[3] = (f16)r[i][3];
            *(LAS f16x4*)(scr + (4 * i + g) * CV_P + li * 8) = hv; }
        if (it + ngw < items) load_item(it + ngw);
        f16x8 o[4][2];
#pragma unroll
        for (int nq = 0; nq < 4; ++nq)
#pragma unroll
            for (int ko = 0; ko < 2; ++ko) { LAS unsigned char* p = scr + (32 * ko + 8 * g + (li >> 2)) * CV_P + (16 * nq + 4 * (li & 3)) * 2;
                o[nq][ko] = __builtin_shufflevector(tr_read_cv(p), tr_read_cv(p + 4 * CV_P), 0, 1, 2, 3, 4, 5, 6, 7); }
#pragma unroll
        for (int nq = 0; nq < 4; ++nq) { const int n = n0 + 16 * nq + li;
            const int row = il == 1 ? ((n >> 7) * 256 + half * 128 + (n & 127)) : (il == 2 && n < 2048 ? ((n & ~127) + 2 * (n & 63) + ((n >> 6) & 1)) : n);
#pragma unroll
            for (int ko = 0; ko < 2; ++ko) *(f16x8*)(WT + (size_t)row * K + k0 + 32 * ko + 8 * g) = o[nq][ko]; }
    }
}
__device__ __forceinline__ void ph_convert_static(const Params& P, LAS unsigned char* lds, int bid, int nblk) {
    const int tidf = tid_fresh(); const int wave = tidf >> 6, lane = tidf & 63, gw = bid * NWAVES + wave, ngw = nblk * NWAVES;
    LAS unsigned char* scr = lds + wave * 16384; int off = 0;
    for (int j = 0; j < 2; ++j) {
        convert_matrix(P.e_w_in + (size_t)j * D * EVEN_IN, D, EVEN_IN, (f16*)(P.ws + WS_EWIN) + (size_t)j * EVEN_IN * D, 0, 0, scr, gw, ngw, lane, off);
        convert_matrix(P.e_w_out + (size_t)j * D * D, D, D, (f16*)(P.ws + WS_EWOUT) + (size_t)j * D * D, 0, 0, scr, gw, ngw, lane, off);
        convert_matrix(P.ffn_w1 + (size_t)j * D * FFN, D, FFN, (f16*)(P.ws + WS_FW13) + (size_t)j * 2 * FFN * D, 1, 0, scr, gw, ngw, lane, off);
        convert_matrix(P.ffn_w3 + (size_t)j * D * FFN, D, FFN, (f16*)(P.ws + WS_FW13) + (size_t)j * 2 * FFN * D, 1, 1, scr, gw, ngw, lane, off);
        convert_matrix(P.ffn_w2 + (size_t)j * FFN * D, FFN, D, (f16*)(P.ws + WS_FW2) + (size_t)j * D * FFN, 0, 0, scr, gw, ngw, lane, off);
        convert_matrix(P.o_w_in + (size_t)j * D * ODD_IN, D, ODD_IN, (f16*)(P.ws + WS_OWIN) + (size_t)j * ODD_IN * D, 2, 0, scr, gw, ngw, lane, off);
        convert_matrix(P.o_w_out + (size_t)j * 2048 * D, 2048, D, (f16*)(P.ws + WS_OWOUT) + (size_t)j * D * 2048, 0, 0, scr, gw, ngw, lane, off);
    }
}
__device__ __forceinline__ void convert_tile_plain(const float* W, int K, int N, f16* WT, LAS unsigned char* scr, int item, int lane) {
    const int nblk = N / 64, kb = item / nblk, nb = item % nblk, k0 = 64 * kb, n0 = 64 * nb, li = lane & 15, g = lane >> 4;
    const float* src = W + (size_t)(k0 + g) * N + n0 + 4 * li;
    f32x4 r[16];
#pragma unroll
    for (int i = 0; i < 16; ++i) r[i] = *(const f32x4*)(src + (size_t)(4 * i) * N);
#pragma unroll
    for (int i = 0; i < 16; ++i) { f16x4 hv; hv[0] = (f16)r[i][0]; hv[1] = (f16)r[i][1]; hv[2] = (f16)r[i][2]; hv[3] = (f16)r[i][3]; *(LAS f16x4*)(scr + (4 * i + g) * CV_P + li * 8) = hv; }
#pragma unroll
    for (int nq = 0; nq < 4; ++nq)
#pragma unroll
        for (int ko = 0; ko < 2; ++ko) { LAS unsigned char* p = scr + (32 * ko + 8 * g + (li >> 2)) * CV_P + (16 * nq + 4 * (li & 3)) * 2;
            const f16x8 o = __builtin_shufflevector(tr_read_cv(p), tr_read_cv(p + 4 * CV_P), 0, 1, 2, 3, 4, 5, 6, 7);
            *(f16x8*)(WT + (size_t)(n0 + 16 * nq + li) * K + k0 + 32 * ko + 8 * g) = o; }
}
__device__ __forceinline__ void convert_tile_il(const float* W, int K, int N, f16* WT, int half, LAS unsigned char* scr, int item, int lane) {
    const int nblk = N / 64, kb = item / nblk, nb = item % nblk, k0 = 64 * kb, n0 = 64 * nb, li = lane & 15, g = lane >> 4;
    const float* src = W + (size_t)(k0 + g) * N + n0 + 4 * li;
    f32x4 r[16];
#pragma unroll
    for (int i = 0; i < 16; ++i) r[i] = *(const f32x4*)(src + (size_t)(4 * i) * N);
#pragma unroll
    for (int i = 0; i < 16; ++i) { f16x4 hv; hv[0] = (f16)r[i][0]; hv[1] = (f16)r[i][1]; hv[2] = (f16)r[i][2]; hv[3] = (f16)r[i][3]; *(LAS f16x4*)(scr + (4 * i + g) * CV_P + li * 8) = hv; }
#pragma unroll
    for (int nq = 0; nq < 4; ++nq)
#pragma unroll
        for (int ko = 0; ko < 2; ++ko) { LAS unsigned char* p = scr + (32 * ko + 8 * g + (li >> 2)) * CV_P + (16 * nq + 4 * (li & 3)) * 2;
            const f16x8 o = __builtin_shufflevector(tr_read_cv(p), tr_read_cv(p + 4 * CV_P), 0, 1, 2, 3, 4, 5, 6, 7);
            const int n = n0 + 16 * nq + li;
            *(f16x8*)(WT + (size_t)((n >> 7) * 256 + half * 128 + (n & 127)) * K + k0 + 32 * ko + 8 * g) = o; }
}
constexpr int W13_TILES = (D / 64) * (EDIM / 64);
constexpr int W13_PRO = 5632;
__device__ __forceinline__ void bg_convert_w13(const Params& P, int j, int a, int b, int w0, f16* dst, LAS unsigned char* lds, int bid, int nblk) {
    if (bid < w0) return;
    const int nw = nblk - w0;
    const int tidf = tid_fresh(); const int wave = tidf >> 6, lane = tidf & 63;
    LAS unsigned char* scr = lds + wave * 16384;
    for (int gi = a + (bid - w0) * NWAVES + wave; gi < b; gi += nw * NWAVES) {
        const int e = gi / (2 * W13_TILES), r = gi % (2 * W13_TILES), half = r / W13_TILES, it = r % W13_TILES;
        const float* W = (half ? P.moe_w3 : P.moe_w1) + ((size_t)j * NE + e) * D * EDIM;
        convert_tile_il(W, D, EDIM, dst + (size_t)e * 2 * EDIM * D, half, scr, it, lane);
    }
}
constexpr int W2_TILES = (EDIM / 64) * (D / 64);
__device__ __forceinline__ void bg_convert_w2(const Params& P, int j, int a, int b, int heavy, LAS unsigned char* lds, int bid, int nblk) {
    const int w0 = heavy % nblk, nw = nblk - w0;
    if (bid < w0) return;
    const int tidf = tid_fresh(); const int wave = tidf >> 6, lane = tidf & 63;
    LAS unsigned char* scr = lds + wave * 16384;
    for (int gi = a + (bid - w0) * NWAVES + wave; gi < b; gi += nw * NWAVES) {
        const int e = gi / W2_TILES, it = gi % W2_TILES;
        convert_tile_plain(P.moe_w2 + ((size_t)j * NE + e) * D * EDIM, EDIM, D, (f16*)(P.ws + WS_MW2) + (size_t)e * D * EDIM, scr, it, lane);
    }
}
__device__ __forceinline__ void ph_convert_moe(const Params& P, int j, LAS unsigned char* lds, int bid, int nblk, int which = 3) {
    const int tidf = tid_fresh(); const int wave = tidf >> 6, lane = tidf & 63, gw = bid * NWAVES + wave, ngw = nblk * NWAVES;
    LAS unsigned char* scr = lds + wave * 16384; int off = 0;
    for (int e = 0; e < NE; ++e) {
        const size_t wo = ((size_t)j * NE + e) * D * EDIM;
        if (which & 1) {
            convert_matrix(P.moe_w1 + wo, D, EDIM, (f16*)(P.ws + WS_MW13) + (size_t)e * 2 * EDIM * D, 1, 0, scr, gw, ngw, lane, off);
            convert_matrix(P.moe_w3 + wo, D, EDIM, (f16*)(P.ws + WS_MW13) + (size_t)e * 2 * EDIM * D, 1, 1, scr, gw, ngw, lane, off);
        }
        if (which & 2) convert_matrix(P.moe_w2 + wo, EDIM, D, (f16*)(P.ws + WS_MW2) + (size_t)e * D * EDIM, 0, 0, scr, gw, ngw, lane, off);
    }
}

__device__ __forceinline__ void ph_prep0(const Params& P, int bid, int nblk) {
    const int tidf = tid_fresh(); const int wave = tidf >> 6, lane = tidf & 63, gw = bid * NWAVES + wave, ngw = nblk * NWAVES;
    const float* mod = (const float*)(P.ws + WS_MOD);
    f16* X = (f16*)(P.ws + WS_X); f16* H = (f16*)(P.ws + WS_H);
    for (int row0 = gw; row0 < M; row0 += 3 * ngw) {
        f32x4 v[3][4];
#pragma unroll
        for (int i = 0; i < 3; ++i) { const int row = row0 + i * ngw;
            if (row < M) { const float* src = row < TX ? P.x + (size_t)row * D : P.ctx + (size_t)(row - TX) * D;
#pragma unroll
                for (int j = 0; j < 4; ++j) v[i][j] = *(const f32x4*)(src + 4 * lane + 256 * j); } }
#pragma unroll
        for (int i = 0; i < 3; ++i) { const int row = row0 + i * ngw;
            if (row < M) { const float* mv = mod + (size_t)row_vec(row) * 6144;
#pragma unroll
                for (int j = 0; j < 4; ++j) { const int col = 4 * lane + 256 * j; const f32x4 vv = v[i][j];
                    { f16x4 xh; xh[0] = (f16)vv[0]; xh[1] = (f16)vv[1]; xh[2] = (f16)vv[2]; xh[3] = (f16)vv[3]; *(f16x4*)(X + (size_t)row * D + col) = xh; }
                    const f32x4 sh = *(const f32x4*)(mv + col), sc = *(const f32x4*)(mv + D + col);
                    const f32x4 h = vv * (sc + 1.0f) + sh; f16x4 hh; hh[0] = (f16)h[0]; hh[1] = (f16)h[1]; hh[2] = (f16)h[2]; hh[3] = (f16)h[3];
                    *(f16x4*)(H + (size_t)row * D + col) = hh; } } }
    }
}

template <int MODE>
__device__ __forceinline__ void ph_ln(const Params& P, int layer, int which, int bid, int nblk, bool last, LAS unsigned char* lds = nullptr, int mrows = M) {
    const int tidf = tid_fresh(); const int wave = tidf >> 6, lane = tidf & 63, gw = bid * NWAVES + wave, ngw = nblk * NWAVES;
    const float* mod = (const float*)(P.ws + WS_MOD);
    f16* X = (f16*)(P.ws + WS_X); const f16* V = (const f16*)(P.ws + WS_V); f16* H = (f16*)(P.ws + WS_H);
    const float* lg = P.ln_g + ((size_t)layer * 2 + which) * D; const float* lb = P.ln_b + ((size_t)layer * 2 + which) * D;
    const int ml = which == 0 ? layer : layer + 1; const int sh_off = which == 0 ? 3 * D : 0, sc_off = which == 0 ? 4 * D : D;
    const int j = layer >> 1;
    int* route = (int*)(P.ws + WS_ROUTE);
    const f16* Y2p = (const f16*)(P.ws + WS_Y2P);
    LAS unsigned* lcnt = (LAS unsigned*)lds;
    if (MODE == 1) { if (tidf < 16) lcnt[tidf] = 0u; __syncthreads(); }
    const int r_begin = (int)(((long)gw * mrows) / ngw), r_end = (int)(((long)(gw + 1) * mrows) / ngw);
    const bool has_next_mod = !(which == 1 && layer == DEPTH - 1);
    f32x4 pgg[4], pbb[4], psh[4], psc[4], pm5[4]; int curvec = -1;
#pragma unroll
    for (int q = 0; q < 4; ++q) { const int col = 4 * lane + 256 * q; pgg[q] = *(const f32x4*)(lg + col); pbb[q] = *(const f32x4*)(lb + col); }
    for (int row = r_begin; row < r_end; ++row) {
        const int vec = row_vec(row);
        if (vec != curvec) { curvec = vec;
            const float* mv = mod + ((size_t)(has_next_mod ? ml : layer) * 5 + vec) * 6144; const float* m5 = mod + ((size_t)layer * 5 + vec) * 6144 + 5 * D;
#pragma unroll
            for (int q = 0; q < 4; ++q) { const int col = 4 * lane + 256 * q; psh[q] = *(const f32x4*)(mv + sh_off + col); psc[q] = *(const f32x4*)(mv + sc_off + col); if (MODE == 2) pm5[q] = *(const f32x4*)(m5 + col); } }
        f32x4 v[4]; float s = 0.f;
        if (MODE == 2) {
            const int rtv = route[(size_t)row * 8 + (lane & 7)];
            const float g0 = __int_as_float(__shfl(rtv, 2)), g1 = __int_as_float(__shfl(rtv, 3)); const int p0 = __shfl(rtv, 6), p1 = __shfl(rtv, 7);
#pragma unroll
            for (int q = 0; q < 4; ++q) { const int col = 4 * lane + 256 * q; const f16x4 xh = *(const f16x4*)(X + (size_t)row * D + col); const f32x4 xs = (f32x4){(float)xh[0], (float)xh[1], (float)xh[2], (float)xh[3]};
                const f16x4 ya = *(const f16x4*)(Y2p + (size_t)p0 * D + col), yb = *(const f16x4*)(Y2p + (size_t)p1 * D + col); const f32x4 mg = pm5[q];
                f32x4 y;
#pragma unroll
                for (int e = 0; e < 4; ++e) y[e] = g0 * (float)ya[e] + g1 * (float)yb[e];
                v[q] = xs * ALPHA + mg * y; }
        } else {
#pragma unroll
            for (int q = 0; q < 4; ++q) { const f16x4 hv = *(const f16x4*)(V + (size_t)row * D + 4 * lane + 256 * q); v[q] = (f32x4){(float)hv[0], (float)hv[1], (float)hv[2], (float)hv[3]}; }
        }
#pragma unroll
        for (int q = 0; q < 4; ++q) s += (v[q][0] + v[q][1]) + (v[q][2] + v[q][3]);
        const float mean = wave_sum(s) * (1.f / D); float s2 = 0.f;
#pragma unroll
        for (int q = 0; q < 4; ++q) { v[q] = v[q] - mean; s2 += (v[q][0] * v[q][0] + v[q][1] * v[q][1]) + (v[q][2] * v[q][2] + v[q][3] * v[q][3]); }
        const float rstd = 1.0f / sqrtf(wave_sum(s2) * (1.f / D) + LN_EPS);
        float lg8[NE];
#pragma unroll
        for (int e = 0; e < NE; ++e) lg8[e] = 0.f;
#pragma unroll
        for (int q = 0; q < 4; ++q) { const int col = 4 * lane + 256 * q;
            const f32x4 gg = pgg[q], bb = pbb[q];
            const f32x4 y = v[q] * rstd * gg + bb;
            if (last) { if (row < TX) *(f32x4*)(P.out + (size_t)row * D + col) = y; }
            else {
                { f16x4 xh; xh[0] = (f16)y[0]; xh[1] = (f16)y[1]; xh[2] = (f16)y[2]; xh[3] = (f16)y[3]; *(f16x4*)(X + (size_t)row * D + col) = xh; }
                const f32x4 sh = psh[q], sc = psc[q];
                const f32x4 h = y * (sc + 1.0f) + sh; f16x4 hh; hh[0] = (f16)h[0]; hh[1] = (f16)h[1]; hh[2] = (f16)h[2]; hh[3] = (f16)h[3];
                *(f16x4*)(H + (size_t)row * D + col) = hh;
                if (MODE == 1) {
                    const float* rw = P.router_w + (size_t)j * D * NE + (size_t)col * NE;
#pragma unroll
                    for (int e4 = 0; e4 < 4; ++e4) {
                        const f32x4 w0 = *(const f32x4*)(rw + e4 * NE), w1 = *(const f32x4*)(rw + e4 * NE + 4);
                        lg8[0] += h[e4] * w0[0]; lg8[1] += h[e4] * w0[1]; lg8[2] += h[e4] * w0[2]; lg8[3] += h[e4] * w0[3];
                        lg8[4] += h[e4] * w1[0]; lg8[5] += h[e4] * w1[1]; lg8[6] += h[e4] * w1[2]; lg8[7] += h[e4] * w1[3];
                    }
                }
            }
        }
        if (MODE == 1) {
#pragma unroll
            for (int e = 0; e < NE; ++e) lg8[e] = wave_sum(lg8[e]) + P.router_b[j * NE + e];
            int e0 = 0; float v0 = lg8[0];
#pragma unroll
            for (int e = 1; e < NE; ++e) if (lg8[e] > v0) { v0 = lg8[e]; e0 = e; }
            int e1 = -1; float v1 = -3.0e38f;
#pragma unroll
            for (int e = 0; e < NE; ++e) if (e != e0 && lg8[e] > v1) { v1 = lg8[e]; e1 = e; }
            const float ex = __expf(v1 - v0), g0 = 1.0f / (1.0f + ex), g1 = ex / (1.0f + ex);
            if (lane == 0) {
                const int s0 = (int)__hip_atomic_fetch_add(lcnt + e0, 1u, __ATOMIC_RELAXED, __HIP_MEMORY_SCOPE_WORKGROUP), s1 = (int)__hip_atomic_fetch_add(lcnt + e1, 1u, __ATOMIC_RELAXED, __HIP_MEMORY_SCOPE_WORKGROUP);
                int* rt = route + (size_t)row * 8; rt[0] = e0; rt[1] = e1; rt[2] = __float_as_int(g0); rt[3] = __float_as_int(g1); rt[4] = s0; rt[5] = s1;
            }
        }
    }
    if (MODE == 1) {
        __syncthreads();
        if (tidf < NE) { unsigned* cnt = (unsigned*)(P.ws + WS_CTL) + CW_CNT + 64 * j; lcnt[8 + tidf] = atomicAdd(cnt + tidf, lcnt[tidf]); }
        __syncthreads();
        { const int row = r_begin + lane; if (row < r_end) { int* rt = route + (size_t)row * 8; const int e0 = rt[0], e1 = rt[1]; rt[4] += (int)lcnt[8 + e0]; rt[5] += (int)lcnt[8 + e1]; } }
        if (lane == 0) for (int row = r_begin + 64; row < r_end; ++row) { int* rt = route + (size_t)row * 8; const int e0 = rt[0], e1 = rt[1]; rt[4] += (int)lcnt[8 + e0]; rt[5] += (int)lcnt[8 + e1]; }
    }
}

__device__ __forceinline__ void ph_moe_gather(const Params& P, int j, int bid, int nblk, int mrows) {
    const int tidf = tid_fresh(); const int wave = tidf >> 6, lane = tidf & 63, gw = bid * NWAVES + wave, ngw = nblk * NWAVES;
    const unsigned* cnt = (const unsigned*)(P.ws + WS_CTL) + CW_CNT + 64 * j;
    int off[NE], pad[NE]; int acc = 0;
#pragma unroll
    for (int e = 0; e < NE; ++e) { off[e] = acc; const int c = (int)__hip_atomic_load(cnt + e, __ATOMIC_RELAXED, __HIP_MEMORY_SCOPE_AGENT); pad[e] = ((c + 255) >> 8) << 8; acc += pad[e]; }
    int* tilex = (int*)(P.ws + WS_TILEX);
    if (bid == 0 && tidf < 256) {
        const int t = tidf;
        if (t == 255) tilex[255] = acc >> 8;
        else if (t < MOE_TILES) { int ex = 0;
#pragma unroll
            for (int e = 0; e < NE; ++e) if (t * 256 >= off[e] && t * 256 < off[e] + pad[e]) ex = e;
            tilex[t] = ex; }
    }
    int* route = (int*)(P.ws + WS_ROUTE);
    const f16* H = (const f16*)(P.ws + WS_H); f16* Xp = (f16*)(P.ws + WS_XP);
    for (int row = gw; row < mrows; row += ngw) {
        int* rt = route + (size_t)row * 8;
        const int rtv = rt[lane & 7];
        const int e0 = __shfl(rtv, 0), e1 = __shfl(rtv, 1), s0 = __shfl(rtv, 4), s1 = __shfl(rtv, 5);
        int o0 = 0, o1 = 0;
#pragma unroll
        for (int e = 0; e < NE; ++e) { if (e == e0) o0 = off[e]; if (e == e1) o1 = off[e]; }
        const int p0 = o0 + s0, p1 = o1 + s1;
        if (lane == 0) { rt[6] = p0; rt[7] = p1; }
        const u32x4* src = (const u32x4*)(H + (size_t)row * D);
        const u32x4 a = src[lane], b = src[lane + 64];
        u32x4* d0 = (u32x4*)(Xp + (size_t)p0 * D); u32x4* d1 = (u32x4*)(Xp + (size_t)p1 * D);
        d0[lane] = a; d0[lane + 64] = b; d1[lane] = a; d1[lane + 64] = b;
    }
}

__device__ __forceinline__ void ph_rope_table(const Params& P, int bid, int nblk) {
    float* T = (float*)(P.ws + WS_ROPET);
    for (int idx = bid * NTHREADS + tid_fresh(); idx < 64 * 64; idx += nblk * NTHREADS) {
        const int pos = idx >> 6, i = idx & 63;
        const float inv = exp2f(-(float)i * (13.287712379549449f / 64.0f));
        float sn, cs; sincosf((float)pos * inv, &sn, &cs);
        T[2 * idx] = cs; T[2 * idx + 1] = sn;
    }
}
__device__ __forceinline__ f16x4 tr_read(LAS unsigned char* p) { const s16x4 v = __builtin_amdgcn_ds_read_tr16_b64_v4i16((LAS s16x4*)p); return __builtin_bit_cast(f16x4, v); }
__device__ __forceinline__ f16x8 cat8(const f16x4 a, const f16x4 b) { return __builtin_shufflevector(a, b, 0, 1, 2, 3, 4, 5, 6, 7); }
constexpr int RC = 64, RNCH = (CL + SEQ) / RC;
constexpr int SC = 32, SNCH = (CL + SEQ) / SC;
__device__ __forceinline__ int chunk_row0(int b, int c) { return c < CL / RC ? TX + b * CL + c * RC : b * SEQ + (c - CL / RC) * RC; }
__device__ __forceinline__ int schunk_row0(int b, int c) { return c < CL / SC ? TX + b * CL + c * SC : b * SEQ + (c - CL / SC) * SC; }

__device__ __forceinline__ void ph_ret_pm(const Params& P, int j, int bid, int nblk) {
    const int tidf = tid_fresh(); const int wave = tidf >> 6, lane = tidf & 63, gw = bid * NWAVES + wave, ngw = nblk * NWAVES;
    const int li = lane & 15, g = lane >> 4;
    const f16* Pb = (const f16*)(P.ws + WS_P); f16* PM = (f16*)(P.ws + WS_PM);
    for (int item = gw; item < 16 * SNCH; item += ngw) {
        const int bh = item / SNCH, c = item % SNCH, b = bh >> 2, h = bh & 3;
        const int row0 = schunk_row0(b, c);
        const float l2f = P.ret_ld[(j * 2 + 0) * 4 + h] * 1.4426950408889634f, l2b = P.ret_ld[(j * 2 + 1) * 4 + h] * 1.4426950408889634f;
        f32x4 acc[2][2];
#pragma unroll
        for (int sb = 0; sb < 2; ++sb)
#pragma unroll
            for (int tb = 0; tb < 2; ++tb) acc[sb][tb] = (f32x4){0.f, 0.f, 0.f, 0.f};
        const f16* kbase = Pb + (size_t)(row0 + li) * ODD_IN + 1024 + h * 256 + 8 * g;
        const f16* qbase = Pb + (size_t)(row0 + li) * ODD_IN + h * 256 + 8 * g;
        f16x8 kf[8][2], qf[8][2];
#pragma unroll
        for (int kk = 0; kk < 8; ++kk)
#pragma unroll
            for (int x = 0; x < 2; ++x) { kf[kk][x] = *(const f16x8*)(kbase + (size_t)(16 * x) * ODD_IN + 32 * kk); qf[kk][x] = *(const f16x8*)(qbase + (size_t)(16 * x) * ODD_IN + 32 * kk); }
#pragma unroll
        for (int kk = 0; kk < 8; ++kk)
#pragma unroll
            for (int sb = 0; sb < 2; ++sb)
#pragma unroll
                for (int tb = 0; tb < 2; ++tb) acc[sb][tb] = __builtin_amdgcn_mfma_f32_16x16x32_f16(kf[kk][sb], qf[kk][tb], acc[sb][tb], 0, 0, 0);
        f16* out = PM + (size_t)item * SC * SC;
#pragma unroll
        for (int sb = 0; sb < 2; ++sb)
#pragma unroll
            for (int tb = 0; tb < 2; ++tb) { const int t = 16 * tb + li; f16x4 o;
#pragma unroll
                for (int r = 0; r < 4; ++r) { const int sidx = 16 * sb + 4 * g + r; const int df = t - sidx;
                    const float w = df == 0 ? 2.0f : (df > 0 ? exp2f((float)df * l2f) : exp2f((float)(-df) * l2b));
                    o[r] = (f16)(acc[sb][tb][r] * w); }
                *(f16x4*)(out + (size_t)t * SC + 16 * sb + 4 * g) = o; }
    }
}

constexpr int RS_PP = 1024, RS_VG = 1088;
constexpr int RS_Q = 0, RS_K = 16 * RS_PP, RS_V = 32 * RS_PP, RS_BUF = RS_V + 4 * RS_VG;
__device__ __forceinline__ void ph_ret_scan(const Params& P, int j, LAS unsigned char* lds, int bid, int nblk) {
    const int tid = tid_fresh(); const int wave = __builtin_amdgcn_readfirstlane(tid >> 6), lane = tid & 63, li = lane & 15, g = lane >> 4;
    const bool producer = wave >= 4; const int vb = wave & 3, pw = wave & 3;
    const f16* Pb = (const f16*)(P.ws + WS_P); f16* OD = (f16*)(P.ws + WS_OD);
    for (int it0 = bid; it0 < 256; it0 += nblk) {
        const int item = (nblk == 256) ? ((it0 & 7) * 32 + (it0 >> 3)) : it0;
        const int vs = item & 7, dir = (item >> 3) & 1, h = (item >> 4) & 3, b = item >> 6;
        const float l2 = P.ret_ld[(j * 2 + dir) * 4 + h] * 1.4426950408889634f;
        const float g32 = exp2f(32.0f * l2);
        f32x4 S[16];
#pragma unroll
        for (int x = 0; x < 16; ++x) S[x] = (f32x4){0.f, 0.f, 0.f, 0.f};
        f16x8 wv;
#pragma unroll
        for (int e = 0; e < 8; ++e) { const int sI = 8 * g + e; wv[e] = (f16)exp2f((float)(dir ? sI : 31 - sI) * l2); }
        auto chunk_of = [&](int ci) { return dir == 0 ? ci : (ci < 8 ? 7 - ci : 8 + (127 - (ci - 8))); };
        auto issue = [&](int ci) {
            const int row0 = schunk_row0(b, chunk_of(ci));
            LAS unsigned char* base = lds + (ci & 3) * RS_BUF;
#pragma unroll
            for (int x = 0; x < 4; ++x) { const int pr = 4 * pw + x; const f16* rowp = Pb + (size_t)(row0 + 2 * pr + (lane >> 5)) * ODD_IN + h * 256;
                const int rowi = 2 * pr + (lane >> 5);
                __builtin_amdgcn_global_load_lds((const unsigned*)(rowp + (((lane & 31) ^ (rowi & 15)) * 8)), (LAS unsigned*)(base + RS_Q + pr * RS_PP), 16, 0, 0);
                __builtin_amdgcn_global_load_lds((const unsigned*)(rowp + 1024 + (((lane & 31) ^ (4 * (rowi & 3))) * 8)), (LAS unsigned*)(base + RS_K + pr * RS_PP), 16, 0, 0); }
            __builtin_amdgcn_global_load_lds((const unsigned*)(Pb + (size_t)(row0 + 8 * pw + (lane >> 3)) * ODD_IN + 2048 + h * 512 + vs * 64 + (lane & 7) * 8), (LAS unsigned*)(base + RS_V + pw * RS_VG), 16, 0, 0);
        };
        asm volatile("s_waitcnt vmcnt(0) lgkmcnt(0)" ::: "memory"); __builtin_amdgcn_s_barrier(); asm volatile("" ::: "memory");
        if (producer) { issue(0); issue(1); issue(2); asm volatile("s_waitcnt vmcnt(18)" ::: "memory"); }
        if (producer) {
            for (int ci = 0; ci < SNCH; ++ci) {
                asm volatile("" ::: "memory"); __builtin_amdgcn_s_barrier(); asm volatile("" ::: "memory");
                if (ci + 3 < SNCH) { issue(ci + 3); asm volatile("s_waitcnt vmcnt(18)" ::: "memory"); }
                else if (ci + 2 < SNCH) asm volatile("s_waitcnt vmcnt(9)" ::: "memory");
                else asm volatile("s_waitcnt vmcnt(0)" ::: "memory");
            }
        } else {
            for (int ci = 0; ci < SNCH; ++ci) {
                asm volatile("" ::: "memory"); __builtin_amdgcn_s_barrier(); asm volatile("" ::: "memory");
                LAS unsigned char* base = lds + (ci & 3) * RS_BUF;
                const int row0 = schunk_row0(b, chunk_of(ci));
                const int sr = 8 * g + (li >> 2);
                LAS unsigned char* vp = base + RS_V + (sr >> 3) * RS_VG + (sr & 7) * 128 + (vb * 16 + 4 * (li & 3)) * 2;
                LAS unsigned char* kp0 = base + RS_K + sr * 512 + (8 * (li & 3)) * 2;
                const int ksw = sr & 3;
                f16x8 qfr[8][2], kfr[16];
#define RS_RDQ(kk) do { _Pragma("unroll") for (int tb = 0; tb < 2; ++tb) { const int t = 16 * tb + li; qfr[kk][tb] = *(LAS f16x8*)(base + RS_Q + t * 512 + (((4 * (kk) + g) ^ (t & 15)) * 16)); } } while (0)
#define RS_RDK(db) do { LAS unsigned char* kp = kp0 + 64 * (((db) >> 1) ^ ksw) + 8 * ((db) & 1); kfr[db] = cat8(tr_read(kp), tr_read(kp + 4 * 512)); } while (0)
                constexpr int DQ = 4, DK = 6;
#pragma unroll
                for (int kk = 0; kk < DQ; ++kk) RS_RDQ(kk);
                f16x8 vf = cat8(tr_read(vp), tr_read(vp + 4 * 128));
                __builtin_amdgcn_sched_barrier(0);
                f32x4 o[2];
                o[0] = (f32x4){0.f, 0.f, 0.f, 0.f}; o[1] = (f32x4){0.f, 0.f, 0.f, 0.f};
#pragma unroll
                for (int kk = 0; kk < 8; ++kk) {
                    if (kk + DQ < 8) RS_RDQ(kk + DQ); else if (kk + DQ - 8 < DK) RS_RDK(kk + DQ - 8);
                    f16x8 sf;
#pragma unroll
                    for (int r = 0; r < 4; ++r) { sf[r] = (f16)S[2 * kk][r]; sf[4 + r] = (f16)S[2 * kk + 1][r]; }
#pragma unroll
                    for (int tb = 0; tb < 2; ++tb) o[tb] = __builtin_amdgcn_mfma_f32_16x16x32_f16(sf, qfr[kk][tb], o[tb], 0, 0, 0);
                    __builtin_amdgcn_sched_barrier(0);
                }
#pragma unroll
                for (int db = DQ; db < DK; ++db) RS_RDK(db);
                __builtin_amdgcn_sched_barrier(0);
#pragma unroll
                for (int tb = 0; tb < 2; ++tb) { const int t = 16 * tb + li; const float sc = exp2f((float)((dir ? 31 - t : t) + 1) * l2);
                    f16x4 ov; ov[0] = (f16)(o[tb][0] * sc); ov[1] = (f16)(o[tb][1] * sc); ov[2] = (f16)(o[tb][2] * sc); ov[3] = (f16)(o[tb][3] * sc);
                    const f16* optr = OD + ((size_t)dir * M + row0 + t) * 2048 + h * 512 + vs * 64 + vb * 16 + 4 * g; const u32x2 od = __builtin_bit_cast(u32x2, ov);
                    asm volatile("global_store_dwordx2 %0, %1, off\n\ts_nop 1" :: "v"(optr), "v"(od) : "memory"); }
                vf = vf * wv;
                __builtin_amdgcn_sched_barrier(0);
#pragma unroll
                for (int db = 0; db < 16; ++db) {
                    if (db + DK < 16) RS_RDK(db + DK);
                    S[db] = __builtin_amdgcn_mfma_f32_16x16x32_f16(kfr[db], vf, S[db] * g32, 0, 0, 0);
                    __builtin_amdgcn_sched_barrier(0);
                }
#undef RS_RDQ
#undef RS_RDK
                asm volatile("s_waitcnt lgkmcnt(0)" ::: "memory");
            }
        }
    }
    asm volatile("s_waitcnt vmcnt(0) lgkmcnt(0)" ::: "memory"); __syncthreads();
}

constexpr int RF_VP = 1040, RF_PP = 80;
constexpr int RF_V = 0, RF_P = RC * RF_VP, RF_ST = RF_P + RC * RF_PP;
__device__ __forceinline__ void ph_ret_final(const Params& P, LAS unsigned char* lds, int bid, int nblk) {
    const int tid = tid_fresh(); const int wave = __builtin_amdgcn_readfirstlane(tid >> 6), lane = tid & 63, li = lane & 15, g = lane >> 4;
    const f16* Pb = (const f16*)(P.ws + WS_P); const f16* OD = (const f16*)(P.ws + WS_OD); const f16* PM = (const f16*)(P.ws + WS_PM); f16* MIX = (f16*)(P.ws + WS_MIX);
    u32x4 pv[8]; u32x2 pp;
    auto prefetch = [&](int item) {
        const int bh = item / RNCH, c = item % RNCH, b = bh >> 2, h = bh & 3; const int row0 = chunk_row0(b, c);
#pragma unroll
        for (int x = 0; x < 8; ++x) { const int p = tid + 512 * x; pv[x] = *(const u32x4*)(Pb + (size_t)(row0 + (p >> 6)) * ODD_IN + 2048 + h * 512 + (p & 63) * 8); }
        pp = *(const u32x2*)(PM + ((size_t)(bh * SNCH + 2 * c) * SC + (tid >> 3)) * SC + (tid & 7) * 4);
    };
    if (bid < 16 * RNCH) prefetch(bid);
    for (int item = bid; item < 16 * RNCH; item += nblk) {
        const int bh = item / RNCH, c = item % RNCH, b = bh >> 2, h = bh & 3;
        const int row0 = chunk_row0(b, c);
        LDS_BARRIER();
#pragma unroll
        for (int x = 0; x < 8; ++x) { const int p = tid + 512 * x; *(LAS u32x4*)(lds + RF_V + (p >> 6) * RF_VP + (p & 63) * 16) = pv[x]; }
        *(LAS u32x2*)(lds + RF_P + (tid >> 3) * RF_PP + (tid & 7) * 8) = pp;
        f16x8 oda[4][2], odb[4][2];
#pragma unroll
        for (int tb = 0; tb < 4; ++tb) { const size_t rr = (size_t)(row0 + 16 * tb + li) * 2048 + h * 512 + 64 * wave + 16 * g;
            oda[tb][0] = *(const f16x8*)(OD + rr); oda[tb][1] = *(const f16x8*)(OD + rr + 8); odb[tb][0] = *(const f16x8*)(OD + (size_t)M * 2048 + rr); odb[tb][1] = *(const f16x8*)(OD + (size_t)M * 2048 + rr + 8); }
        if (item + nblk < 16 * RNCH) prefetch(item + nblk);
        LDS_BARRIER();
        f32x4 acc[4][4];
        {
            f16x8 pf[4];
#pragma unroll
            for (int tb = 0; tb < 4; ++tb) pf[tb] = *(LAS f16x8*)(lds + RF_P + (16 * tb + li) * RF_PP + (8 * g) * 2);
#pragma unroll
            for (int vb = 0; vb < 4; ++vb) {
#pragma unroll
                for (int hf = 0; hf < 2; ++hf) {
                    LAS unsigned char* vp = lds + RF_V + (32 * hf + 8 * g + (li >> 2)) * RF_VP + (64 * wave + 16 * (li & 3) + 4 * vb) * 2;
                    const f16x8 vf = cat8(tr_read(vp), tr_read(vp + 4 * RF_VP));
#pragma unroll
                    for (int t2 = 0; t2 < 2; ++t2) acc[vb][2 * hf + t2] = __builtin_amdgcn_mfma_f32_16x16x32_f16(vf, pf[2 * hf + t2], (f32x4){0.f, 0.f, 0.f, 0.f}, 0, 0, 0);
                }
            }
        }
        float sum[4];
#pragma unroll
        for (int tb = 0; tb < 4; ++tb) { sum[tb] = 0.f;
            const f16x8 a0 = oda[tb][0], a1 = oda[tb][1], b0 = odb[tb][0], b1 = odb[tb][1];
#pragma unroll
            for (int vb = 0; vb < 4; ++vb)
#pragma unroll
                for (int r = 0; r < 4; ++r) { const int e = 4 * (vb & 1) + r; acc[vb][tb][r] += vb < 2 ? (float)a0[e] + (float)b0[e] : (float)a1[e] + (float)b1[e]; sum[tb] += acc[vb][tb][r]; } }
        LAS float* st = (LAS float*)(lds + RF_ST);
#pragma unroll
        for (int tb = 0; tb < 4; ++tb) { sum[tb] += __shfl_xor(sum[tb], 16); sum[tb] += __shfl_xor(sum[tb], 32); if (g == 0) st[(16 * tb + li) * 8 + wave] = sum[tb]; }
        LDS_BARRIER();
        float mean[4], var[4];
#pragma unroll
        for (int tb = 0; tb < 4; ++tb) { const f32x4 s0 = *(const LAS f32x4*)(st + (16 * tb + li) * 8), s1 = *(const LAS f32x4*)(st + (16 * tb + li) * 8 + 4);
            mean[tb] = ((s0[0] + s0[1]) + (s0[2] + s0[3]) + (s1[0] + s1[1]) + (s1[2] + s1[3])) * (1.f / 512.f); var[tb] = 0.f;
#pragma unroll
            for (int vb = 0; vb < 4; ++vb)
#pragma unroll
                for (int r = 0; r < 4; ++r) { acc[vb][tb][r] -= mean[tb]; var[tb] += acc[vb][tb][r] * acc[vb][tb][r]; } }
        LDS_BARRIER();
#pragma unroll
        for (int tb = 0; tb < 4; ++tb) { var[tb] += __shfl_xor(var[tb], 16); var[tb] += __shfl_xor(var[tb], 32); if (g == 0) st[(16 * tb + li) * 8 + wave] = var[tb]; }
        LDS_BARRIER();
#pragma unroll
        for (int tb = 0; tb < 4; ++tb) { const f32x4 s0 = *(const LAS f32x4*)(st + (16 * tb + li) * 8), s1 = *(const LAS f32x4*)(st + (16 * tb + li) * 8 + 4);
            const float vv = ((s0[0] + s0[1]) + (s0[2] + s0[3]) + (s1[0] + s1[1]) + (s1[2] + s1[3])) * (1.f / 512.f);
            const float rstd = 1.0f / sqrtf(vv + LN_EPS);
            const size_t prow = (size_t)(row0 + 16 * tb + li);
            { const int col = h * 512 + 64 * wave + 16 * g;
              const f16x8 g0 = *(const f16x8*)(Pb + prow * ODD_IN + 4096 + col), g1 = *(const f16x8*)(Pb + prow * ODD_IN + 4096 + col + 8); f16x8 o0, o1;
#pragma unroll
              for (int vb = 0; vb < 4; ++vb)
#pragma unroll
                  for (int r = 0; r < 4; ++r) { const int e = 4 * (vb & 1) + r; const float gq = vb < 2 ? (float)g0[e] : (float)g1[e]; const f16 y = (f16)(acc[vb][tb][r] * rstd * silu_f(gq)); if (vb < 2) o0[e] = y; else o1[e] = y; }
              *(f16x8*)(MIX + prow * 2048 + col) = o0; *(f16x8*)(MIX + prow * 2048 + col + 8) = o1; } }
    }
    __syncthreads();
}

constexpr int HC = 32, HNSEG = 16, HP = 272;
__device__ __forceinline__ int hseg_c0(int s) { return (17 * s) >> 1; }
constexpr int H_QB = 0, H_KB = HC * HP, H_Q16 = 2 * HC * HP, H_KE = 3 * HC * HP, H_V = 4 * HC * HP, H_GC = 5 * HC * HP, H_TOT = H_GC + 512;
__device__ __forceinline__ int hchunk_row0(int b, int dir, int p) { return p < 8 ? TX + b * CL + HC * (dir ? 7 - p : p) : b * SEQ + HC * (dir ? 135 - p : p - 8); }

__device__ __forceinline__ void ph_hgrn_local(const Params& P, int j, LAS unsigned char* lds, int bid, int nblk) {
    const int tid = tid_fresh(); const int wave = __builtin_amdgcn_readfirstlane(tid >> 6), lane = tid & 63, li = lane & 15, g = lane >> 4;
    const f16* Pb = (const f16*)(P.ws + WS_P); f16* OD = (f16*)(P.ws + WS_OD); f16* QD = (f16*)(P.ws + WS_HQD);
    float* UT = (float*)(P.ws + WS_HUT); float* GT = (float*)(P.ws + WS_HGT);
    for (int item = bid; item < 32 * HNSEG; item += nblk) {
        const int sidx = (item + (item >> 8)) & 15, bhd = item >> 4, dir = bhd & 1, h = (bhd >> 1) & 3, b = bhd >> 3;
        const int p0 = hseg_c0(sidx), nch = hseg_c0(sidx + 1) - p0; const int it = bhd * HNSEG + sidx;
        float lbv[2];
#pragma unroll
        for (int e = 0; e < 2; ++e) { const int cidx = h * 128 + 2 * lane + e;
            if (j == 0) lbv[e] = 0.f; else { const float l0 = P.hg_lb[(dir * 2 + 0) * 512 + cidx], l1 = P.hg_lb[(dir * 2 + 1) * 512 + cidx]; lbv[e] = 1.0f / (1.0f + __expf(l0 - l1)); } }
        float eseg[2] = {1.f, 1.f};
        f32x4 S[8];
#pragma unroll
        for (int x = 0; x < 8; ++x) S[x] = (f32x4){0.f, 0.f, 0.f, 0.f};
        f16x2 zc[4], qc[4]; u32x4 vc;
        auto load_chunk = [&](int cc) {
            const int row0 = hchunk_row0(b, dir, p0 + cc);
#pragma unroll
            for (int xs = 0; xs < 4; ++xs) { const int x = dir ? 3 - xs : xs; const f16* pr = Pb + (size_t)(row0 + 4 * wave + x) * EVEN_IN + h * 128 + 2 * lane;
                zc[xs] = *(const f16x2*)(pr + 2048 + dir * 512); qc[xs] = *(const f16x2*)(pr + 1536); }
            vc = *(const u32x4*)(Pb + (size_t)(row0 + (tid >> 4)) * EVEN_IN + 3072 + h * 128 + (tid & 15) * 8);
        };
        load_chunk(0);
        for (int cc = 0; cc < nch; ++cc) {
            const int row0 = hchunk_row0(b, dir, p0 + cc);
            LDS_BARRIER();
            *(LAS u32x4*)(lds + H_V + (tid >> 4) * HP + (tid & 15) * 16) = vc;
            float lc[4][2], kv[4][2], qv[4][2]; float run[2] = {0.f, 0.f};
#pragma unroll
            for (int xs = 0; xs < 4; ++xs) { const f16x2 z2 = zc[xs], q2 = qc[xs];
#pragma unroll
                for (int e = 0; e < 2; ++e) { const float z = (float)z2[e]; const float sg = __builtin_amdgcn_rcpf(1.0f + __expf(-z)); const float f = lbv[e] + (1.0f - lbv[e]) * sg;
                    run[e] += __logf(f); lc[xs][e] = run[e]; kv[xs][e] = (1.0f - lbv[e]) * (1.0f - sg); qv[xs][e] = silu_f((float)q2[e]); } }
            *(LAS f32x2*)(lds + H_TOT + (wave * 128 + 2 * lane) * 4) = (f32x2){run[0], run[1]};
            if (cc + 1 < nch) load_chunk(cc + 1);
            LDS_BARRIER();
            float offs[2] = {0.f, 0.f}, cl[2] = {0.f, 0.f};
#pragma unroll
            for (int gq = 0; gq < 8; ++gq) { const f32x2 t2 = *(const LAS f32x2*)(lds + H_TOT + (gq * 128 + 2 * lane) * 4); const bool before = dir ? (gq > wave) : (gq < wave);
                cl[0] += t2[0]; cl[1] += t2[1]; if (before) { offs[0] += t2[0]; offs[1] += t2[1]; } }
            const float gc0 = __expf(cl[0]), gc1 = __expf(cl[1]);
#pragma unroll
            for (int xs = 0; xs < 4; ++xs) { const int x = dir ? 3 - xs : xs; const int i = 4 * wave + x;
                float qs[2], ks[2], ke[2], qd[2];
#pragma unroll
                for (int e = 0; e < 2; ++e) { const float cum = offs[e] + lc[xs][e]; const float cumc = fmaxf(cum, -80.0f); const float e1 = __expf(cumc);
                    qs[e] = qv[xs][e] * e1; ks[e] = kv[xs][e] * __expf(-cumc); ke[e] = kv[xs][e] * __expf(cl[e] - cum); qd[e] = qs[e] * eseg[e]; }
                bf16x2 qb, kb; qb[0] = (__bf16)qs[0]; qb[1] = (__bf16)qs[1]; kb[0] = (__bf16)ks[0]; kb[1] = (__bf16)ks[1];
                f16x2 q16, k16, qd16; q16[0] = (f16)qs[0]; q16[1] = (f16)qs[1]; k16[0] = (f16)ke[0]; k16[1] = (f16)ke[1]; qd16[0] = (f16)qd[0]; qd16[1] = (f16)qd[1];
                *(LAS bf16x2*)(lds + H_QB + i * HP + lane * 4) = qb; *(LAS bf16x2*)(lds + H_KB + i * HP + lane * 4) = kb;
                *(LAS f16x2*)(lds + H_Q16 + i * HP + lane * 4) = q16; *(LAS f16x2*)(lds + H_KE + i * HP + lane * 4) = k16;
                *(f16x2*)(QD + ((size_t)dir * M + row0 + i) * 512 + h * 128 + 2 * lane) = qd16; }
            if (wave == 0) *(LAS f32x2*)(lds + H_GC + lane * 8) = (f32x2){gc0, gc1};
            eseg[0] *= gc0; eseg[1] *= gc1;
            LDS_BARRIER();
            bf16x8 kf[2][4], qf[2][4];
#pragma unroll
            for (int kk = 0; kk < 4; ++kk)
#pragma unroll
                for (int x = 0; x < 2; ++x) { kf[x][kk] = *(const LAS bf16x8*)(lds + H_KB + (16 * x + li) * HP + (32 * kk + 8 * g) * 2); qf[x][kk] = *(const LAS bf16x8*)(lds + H_QB + (16 * x + li) * HP + (32 * kk + 8 * g) * 2); }
            __builtin_amdgcn_sched_barrier(0);
            f32x4 at[2][2];
#pragma unroll
            for (int sb = 0; sb < 2; ++sb)
#pragma unroll
                for (int tb = 0; tb < 2; ++tb) at[sb][tb] = (f32x4){0.f, 0.f, 0.f, 0.f};
#pragma unroll
            for (int kk = 0; kk < 4; ++kk)
#pragma unroll
                for (int sb = 0; sb < 2; ++sb)
#pragma unroll
                    for (int tb = 0; tb < 2; ++tb) at[sb][tb] = __builtin_amdgcn_mfma_f32_16x16x32_bf16(kf[sb][kk], qf[tb][kk], at[sb][tb], 0, 0, 0);
            f16x8 vfp, vfn, af[2][4], kef[8]; f32x4 gcv[8];
            { LAS unsigned char* vp = lds + H_V + (4 * g + (li >> 2)) * HP + (16 * wave + 4 * (li & 3)) * 2; vfp = cat8(tr_read(vp), tr_read(vp + 16 * HP));
              LAS unsigned char* vp2 = lds + H_V + (8 * g + (li >> 2)) * HP + (16 * wave + 4 * (li & 3)) * 2; vfn = cat8(tr_read(vp2), tr_read(vp2 + 4 * HP)); }
#pragma unroll
            for (int kk = 0; kk < 4; ++kk)
#pragma unroll
                for (int tb = 0; tb < 2; ++tb) af[tb][kk] = *(const LAS f16x8*)(lds + H_Q16 + (16 * tb + li) * HP + (32 * kk + 8 * g) * 2);
#pragma unroll
            for (int db = 0; db < 8; ++db) { LAS unsigned char* kp = lds + H_KE + (8 * g + (li >> 2)) * HP + (32 * (db >> 1) + 8 * (li & 3) + 4 * (db & 1)) * 2;
                kef[db] = cat8(tr_read(kp), tr_read(kp + 4 * HP)); gcv[db] = *(const LAS f32x4*)(lds + H_GC + (32 * (db >> 1) + 8 * g + 4 * (db & 1)) * 4); }
            __builtin_amdgcn_sched_barrier(0);
            f16x8 pa[2];
#pragma unroll
            for (int tb = 0; tb < 2; ++tb)
#pragma unroll
                for (int sb = 0; sb < 2; ++sb)
#pragma unroll
                    for (int r = 0; r < 4; ++r) { const int si = 16 * sb + 4 * g + r, ti = 16 * tb + li; const bool keep = dir ? (si >= ti) : (si <= ti);
                        pa[tb][4 * sb + r] = (f16)(keep ? at[sb][tb][r] : 0.f); }
            f32x4 o[2];
#pragma unroll
            for (int tb = 0; tb < 2; ++tb) o[tb] = __builtin_amdgcn_mfma_f32_16x16x32_f16(vfp, pa[tb], (f32x4){0.f, 0.f, 0.f, 0.f}, 0, 0, 0);
#pragma unroll
            for (int kk = 0; kk < 4; ++kk) {
                f16x8 sf;
#pragma unroll
                for (int r = 0; r < 4; ++r) { sf[r] = (f16)S[2 * kk][r]; sf[4 + r] = (f16)S[2 * kk + 1][r]; }
#pragma unroll
                for (int tb = 0; tb < 2; ++tb) o[tb] = __builtin_amdgcn_mfma_f32_16x16x32_f16(sf, af[tb][kk], o[tb], 0, 0, 0);
            }
#pragma unroll
            for (int tb = 0; tb < 2; ++tb) { f16x4 ov; ov[0] = (f16)o[tb][0]; ov[1] = (f16)o[tb][1]; ov[2] = (f16)o[tb][2]; ov[3] = (f16)o[tb][3];
                *(f16x4*)(OD + ((size_t)dir * M + row0 + 16 * tb + li) * 512 + h * 128 + 16 * wave + 4 * g) = ov; }
#pragma unroll
            for (int db = 0; db < 8; ++db) S[db] = __builtin_amdgcn_mfma_f32_16x16x32_f16(kef[db], vfn, S[db] * gcv[db], 0, 0, 0);
        }
#pragma unroll
        for (int db = 0; db < 8; ++db) *(f32x4*)(UT + ((size_t)it * 128 + 16 * wave + li) * 128 + 32 * (db >> 1) + 8 * g + 4 * (db & 1)) = S[db];
        if (wave == 0) *(f32x2*)(GT + (size_t)it * 128 + 2 * lane) = (f32x2){eseg[0], eseg[1]};
    }
    __syncthreads();
}
__device__ __forceinline__ void ph_hgrn_carry(const Params& P, int bid, int nblk) {
    const float* UT = (const float*)(P.ws + WS_HUT); const float* GT = (const float*)(P.ws + WS_HGT); f16* ST = (f16*)(P.ws + WS_HST);
    for (int idx = bid * NTHREADS + tid_fresh(); idx < 32 * 128 * 32; idx += nblk * NTHREADS) {
        const int d4 = idx & 31, v = (idx >> 5) & 127, bhd = idx >> 12;
        f32x4 Sv = *(const f32x4*)(UT + ((size_t)(bhd * HNSEG) * 128 + v) * 128 + 4 * d4);
#pragma unroll
        for (int s0 = 1; s0 < HNSEG; s0 += 8) {
            f32x4 Gs[8], Us[8];
#pragma unroll
            for (int x = 0; x < 8; ++x) if (s0 + x < HNSEG) { const size_t it = (size_t)bhd * HNSEG + s0 + x; Gs[x] = *(const f32x4*)(GT + it * 128 + 4 * d4); Us[x] = *(const f32x4*)(UT + (it * 128 + v) * 128 + 4 * d4); }
#pragma unroll
            for (int x = 0; x < 8; ++x) if (s0 + x < HNSEG) { const size_t it = (size_t)bhd * HNSEG + s0 + x;
                f16x4 hv; hv[0] = (f16)Sv[0]; hv[1] = (f16)Sv[1]; hv[2] = (f16)Sv[2]; hv[3] = (f16)Sv[3];
                *(f16x4*)(ST + (it * 128 + v) * 128 + 4 * d4) = hv;
                Sv = Gs[x] * Sv + Us[x]; }
        }
    }
}
constexpr int HF_P = 256;
__device__ __forceinline__ void ph_hgrn_final(const Params& P, int j, LAS unsigned char* lds, int bid, int nblk) {
    const int tid = tid_fresh(); const int wave = __builtin_amdgcn_readfirstlane(tid >> 6), lane = tid & 63, li = lane & 15, g = lane >> 4;
    const f16* Pb = (const f16*)(P.ws + WS_P); const f16* OD = (const f16*)(P.ws + WS_OD); const f16* QD = (const f16*)(P.ws + WS_HQD); const f16* ST = (const f16*)(P.ws + WS_HST);
    f16* MIX = (f16*)(P.ws + WS_MIX); const float* ng = P.hg_norm_g + j * 128;
    for (int item = bid; item < 16 * HNSEG; item += nblk) {
        const int k = item & 15, bh = item >> 4, b = bh >> 2, h = bh & 3;
        const int c0 = hseg_c0(k), ntok = (hseg_c0(k + 1) - c0) * HC;
        const int blockrow0 = k == 0 ? TX + b * CL : b * SEQ + HC * (c0 - 8);
        u32x4 st[2][4]; f16x8 bq[2][4];
        f16x4 oa[8], ob[8], gv[8];
        if (k > 0) {
#pragma unroll
            for (int dir = 0; dir < 2; ++dir) { const int sidx = dir ? 16 - k : k; const size_t it = (size_t)(bh * 2 + dir) * HNSEG + sidx;
#pragma unroll
                for (int x = 0; x < 4; ++x) { const int p = tid + 512 * x; st[dir][x] = *(const u32x4*)(ST + (it * 128 + (p >> 4)) * 128 + (p & 15) * 8); } }
        }
        auto req = [&](int t0) {
            const size_t row = (size_t)(blockrow0 + t0 + li);
            if (k > 0) {
#pragma unroll
                for (int dir = 0; dir < 2; ++dir)
#pragma unroll
                    for (int kk = 0; kk < 4; ++kk) bq[dir][kk] = *(const f16x8*)(QD + ((size_t)dir * M + row) * 512 + h * 128 + 32 * kk + 8 * g); }
#pragma unroll
            for (int vb = 0; vb < 8; ++vb) { oa[vb] = *(const f16x4*)(OD + row * 512 + h * 128 + 32 * g + 4 * vb); ob[vb] = *(const f16x4*)(OD + ((size_t)M + row) * 512 + h * 128 + 32 * g + 4 * vb);
                gv[vb] = *(const f16x4*)(Pb + row * EVEN_IN + 3584 + h * 128 + 32 * g + 4 * vb); }
        };
        int t0 = 16 * wave;
        req(t0);
        __syncthreads();
        if (k > 0) {
#pragma unroll
            for (int dir = 0; dir < 2; ++dir)
#pragma unroll
                for (int x = 0; x < 4; ++x) { const int p = tid + 512 * x, v = p >> 4; *(LAS u32x4*)(lds + (dir * 128 + v) * HF_P + (((p & 15) ^ (4 * ((v >> 5) & 3) + (v & 3))) * 16)) = st[dir][x]; }
        }
        LDS_BARRIER();
        for (;;) {
            const size_t row = (size_t)(blockrow0 + t0 + li);
            f32x4 acc[8];
#pragma unroll
            for (int vb = 0; vb < 8; ++vb) acc[vb] = (f32x4){0.f, 0.f, 0.f, 0.f};
            if (k > 0) {
#pragma unroll
                for (int dir = 0; dir < 2; ++dir)
#pragma unroll
                    for (int kk = 0; kk < 4; ++kk) {
                        f16x8 af[8];
#pragma unroll
                        for (int vb = 0; vb < 8; ++vb) af[vb] = *(LAS f16x8*)(lds + (dir * 128 + 32 * (li >> 2) + 4 * vb + (li & 3)) * HF_P + (((4 * kk + g) ^ li) * 16));
#pragma unroll
                        for (int vb = 0; vb < 8; ++vb) acc[vb] = __builtin_amdgcn_mfma_f32_16x16x32_f16(af[vb], bq[dir][kk], acc[vb], 0, 0, 0);
                    }
            }
            float ss = 0.f;
#pragma unroll
            for (int vb = 0; vb < 8; ++vb) { const f16x4 a = oa[vb], bb = ob[vb];
                acc[vb] = acc[vb] + (f32x4){(float)a[0] + (float)bb[0], (float)a[1] + (float)bb[1], (float)a[2] + (float)bb[2], (float)a[3] + (float)bb[3]};
#pragma unroll
                for (int r = 0; r < 4; ++r) ss += acc[vb][r] * acc[vb][r]; }
            ss += __shfl_xor(ss, 16); ss += __shfl_xor(ss, 32);
            const float rr = 1.0f / sqrtf(ss * (1.f / 128.f) + NORM_EPS);
#pragma unroll
            for (int vb = 0; vb < 8; ++vb) { const int vc = 32 * g + 4 * vb; const f32x4 nv = *(const f32x4*)(ng + vc); f16x4 ov;
#pragma unroll
                for (int r = 0; r < 4; ++r) ov[r] = (f16)(acc[vb][r] * rr * nv[r] * silu_f((float)gv[vb][r]));
                *(f16x4*)(MIX + row * D + 512 + h * 128 + vc) = ov; }
            t0 += 128; if (t0 >= ntok) break;
            req(t0);
        }
    }
    __syncthreads();
}

constexpr int NA_P = 144;
constexpr int NA_CK = 0, NA_CV = 256 * NA_P, NA_BK = 2 * 256 * NA_P, NA_BV = NA_BK + 2 * 64 * NA_P, NA_BT = NA_BV + 2 * 64 * NA_P;
__device__ __forceinline__ void ph_na(const Params& P, int j, LAS unsigned char* lds, int bid, int nblk) {
    const int tid = tid_fresh(); const int wave = __builtin_amdgcn_readfirstlane(tid >> 6), lane = tid & 63, li = lane & 15, g = lane >> 4;
    const int wq = wave & 3, half = wave >> 2;
    const f16* Pb = (const f16*)(P.ws + WS_P); f16* MIX = (f16*)(P.ws + WS_MIX);
    LAS float* btab = (LAS float*)(lds + NA_BT + wave * 1024);
    constexpr int NX = NB * 8 * GW, NITEMS = NX + NB * 8 * (CL / 64);
    const bool xmap = (nblk == 256);
    const int npairs = NITEMS / 2, pstart = xmap ? (bid >> 3) : bid, pstep = xmap ? 32 : nblk, pend = xmap ? 136 : npairs;
    for (int lp = pstart; lp < pend; lp += pstep) {
        const int bhq = xmap ? ((bid & 7) * 4 + lp / 34) : (lp / 34), t0 = 2 * (lp % 34), t = t0 + half;
        const bool isx = t0 < 64;
        const int b = bhq >> 3, h = bhq & 7;
        int qrow, r = 0;
        if (isx) { r = t; qrow = b * SEQ + r * GW + 16 * wq + li; }
        else { qrow = TX + b * CL + 64 * (t - 64) + 16 * wq + li; }
        const int c = 16 * wq + li, cs = min(max(c - 8, 0), 48), rs = min(max(r - 4, 0), 56);
        const int rsA = min(max(t0 - 4, 0), 56), rsB = min(max(t0 + 1 - 4, 0), 56), nrows = isx ? rsB + 8 - rsA : 0;
        const int kc0 = wq == 0 ? 0 : (wq == 1 ? 8 : (wq == 2 ? 24 : 32));
        const float* rpbh = P.na_rpb + ((size_t)j * 8 + h) * 15 * 31;
        u32x4 ck[4], cv[4], bk[9], bv[9];
        { const f16* cb = Pb + (size_t)(TX + b * CL) * EVEN_IN + h * 64;
#pragma unroll
          for (int x = 0; x < 4; ++x) { const int p = tid + 512 * x; const f16* src = cb + (size_t)(p >> 3) * EVEN_IN + (p & 7) * 8; ck[x] = *(const u32x4*)(src + 512); cv[x] = *(const u32x4*)(src + 1024); } }
#pragma unroll
        for (int i = 0; i < 9; ++i) if (i < nrows) { const f16* src = Pb + (size_t)(b * SEQ + (rsA + i) * GW + (tid >> 3)) * EVEN_IN + h * 64 + (tid & 7) * 8; bk[i] = *(const u32x4*)(src + 512); bv[i] = *(const u32x4*)(src + 1024); }
        if (isx) {
#pragma unroll
            for (int x = 0; x < 4; ++x) { const int e = lane + 64 * x, bi = e >> 5, cc = e & 31; btab[e] = cc < 31 ? rpbh[(rs + bi - r + 7) * 31 + cc] : 0.f; }
        }
        f16x8 qf[2];
#pragma unroll
        for (int kk = 0; kk < 2; ++kk) { const f16x8 tq = *(const f16x8*)(Pb + (size_t)qrow * EVEN_IN + h * 64 + 32 * kk + 8 * g);
#pragma unroll
            for (int e = 0; e < 8; ++e) qf[kk][e] = (f16)((float)tq[e] * 0.125f); }
        unsigned vmask = 0u;
        const int bix0 = kc0 + 4 * g - c + 15;
#pragma unroll
        for (int jj = 0; jj < 8; ++jj) { const int mcol = kc0 + (jj < 4 ? 4 * g + jj : 16 + 4 * g + jj - 4); vmask |= ((mcol >= cs) && (mcol < cs + 16)) ? (1u << jj) : 0u; }
        f32x4 O[4];
#pragma unroll
        for (int x = 0; x < 4; ++x) O[x] = (f32x4){0.f, 0.f, 0.f, 0.f};
        float mrun = -1.0e30f, lsum = 0.f;
        auto process = [&](LAS unsigned char* kt, LAS unsigned char* vtl, int krow, int bi) {
            f16x8 kf[2][2], vf[4];
#pragma unroll
            for (int db = 0; db < 2; ++db)
#pragma unroll
                for (int kk = 0; kk < 2; ++kk) kf[db][kk] = *(LAS f16x8*)(kt + (krow + 16 * db + li) * NA_P + (32 * kk + 8 * g) * 2);
#pragma unroll
            for (int dvb = 0; dvb < 4; ++dvb) { LAS unsigned char* vp = vtl + (krow + 4 * g + (li >> 2)) * NA_P + (16 * dvb + 4 * (li & 3)) * 2; vf[dvb] = cat8(tr_read(vp), tr_read(vp + 16 * NA_P)); }
            f32x4 d1 = (f32x4){0.f, 0.f, 0.f, 0.f}, d2 = (f32x4){0.f, 0.f, 0.f, 0.f};
#pragma unroll
            for (int kk = 0; kk < 2; ++kk) { d1 = __builtin_amdgcn_mfma_f32_16x16x32_f16(kf[0][kk], qf[kk], d1, 0, 0, 0); d2 = __builtin_amdgcn_mfma_f32_16x16x32_f16(kf[1][kk], qf[kk], d2, 0, 0, 0); }
            float sc[8];
#pragma unroll
            for (int rr = 0; rr < 4; ++rr) { sc[rr] = d1[rr]; sc[4 + rr] = d2[rr]; }
            if (bi >= 0) {
                const LAS float* brow = btab + bi * 32;
                float bvv[8];
#pragma unroll
                for (int jj = 0; jj < 8; ++jj) bvv[jj] = brow[min(max(bix0 + (jj < 4 ? jj : 12 + jj), 0), 30)];
#pragma unroll
                for (int jj = 0; jj < 8; ++jj) asm volatile("" : "+v"(bvv[jj]));
#pragma unroll
                for (int jj = 0; jj < 8; ++jj) sc[jj] = ((vmask >> jj) & 1) ? sc[jj] + bvv[jj] : -1.0e30f;
            }
            float bm = fmaxf(fmaxf(fmaxf(sc[0], sc[1]), fmaxf(sc[2], sc[3])), fmaxf(fmaxf(sc[4], sc[5]), fmaxf(sc[6], sc[7])));
            bm = fmaxf(bm, __shfl_xor(bm, 16)); bm = fmaxf(bm, __shfl_xor(bm, 32));
            const float mn = fmaxf(mrun, bm), alpha = __expf(mrun - mn);
            float ps = 0.f; f16x8 pf;
#pragma unroll
            for (int jj = 0; jj < 8; ++jj) { const float pv = __expf(sc[jj] - mn); ps += pv; pf[jj] = (f16)pv; }
            lsum = lsum * alpha + ps; mrun = mn;
#pragma unroll
            for (int x = 0; x < 4; ++x) O[x] = O[x] * alpha;
#pragma unroll
            for (int dvb = 0; dvb < 4; ++dvb) O[dvb] = __builtin_amdgcn_mfma_f32_16x16x32_f16(vf[dvb], pf, O[dvb], 0, 0, 0);
        };
        __syncthreads();
#pragma unroll
        for (int x = 0; x < 4; ++x) { const int p = tid + 512 * x; *(LAS u32x4*)(lds + NA_CK + (p >> 3) * NA_P + (p & 7) * 16) = ck[x]; *(LAS u32x4*)(lds + NA_CV + (p >> 3) * NA_P + (p & 7) * 16) = cv[x]; }
        if (nrows > 0) { *(LAS u32x4*)(lds + NA_BK + (tid >> 3) * NA_P + (tid & 7) * 16) = bk[0]; *(LAS u32x4*)(lds + NA_BV + (tid >> 3) * NA_P + (tid & 7) * 16) = bv[0]; }
        LDS_BARRIER();
#pragma unroll
        for (int i = 0; i < 9; ++i) {
            if (i < nrows) {
                const int R = rsA + i; const bool active = R >= rs && R < rs + 8;
                if (active) process(lds + NA_BK + (i & 1) * 64 * NA_P, lds + NA_BV + (i & 1) * 64 * NA_P, kc0, R - rs);
                if (i + 1 < 9 && i + 1 < nrows) { *(LAS u32x4*)(lds + NA_BK + ((i + 1) & 1) * 64 * NA_P + (tid >> 3) * NA_P + (tid & 7) * 16) = bk[i + 1 < 9 ? i + 1 : 8];
                    *(LAS u32x4*)(lds + NA_BV + ((i + 1) & 1) * 64 * NA_P + (tid >> 3) * NA_P + (tid & 7) * 16) = bv[i + 1 < 9 ? i + 1 : 8]; }
                LDS_BARRIER();
            }
        }
#pragma unroll 2
        for (int cbk = 0; cbk < 8; ++cbk) process(lds + NA_CK, lds + NA_CV, 32 * cbk, -1);
        lsum += __shfl_xor(lsum, 16); lsum += __shfl_xor(lsum, 32);
        const float inv = 1.0f / lsum;
#pragma unroll
        for (int dvb = 0; dvb < 4; ++dvb) { f16x4 ov;
#pragma unroll
            for (int rr = 0; rr < 4; ++rr) ov[rr] = (f16)(O[dvb][rr] * inv);
            *(f16x4*)(MIX + (size_t)qrow * D + h * 64 + 16 * dvb + 4 * g) = ov; }
    }
    __syncthreads();
}

#define XB_TMO      128
#define XB_XCNT(j)  (256  + 64 * (j))
#define XB_XSUB(j)  (1280 + 64 * (j))
#define XB_XGEN(j)  (2304 + 64 * (j))
#define XB_TOP      3328
#define XB_TOPGEN   3392
#define XCD_BAR_WORDS 3456
#define XB_SPIN_CAP (1u << 20)
__device__ __forceinline__ unsigned xb_ld(unsigned* p)              { return __hip_atomic_load(p, __ATOMIC_RELAXED, __HIP_MEMORY_SCOPE_AGENT); }
__device__ __forceinline__ unsigned xb_add(unsigned* p, unsigned v) { return __hip_atomic_fetch_add(p, v, __ATOMIC_RELAXED, __HIP_MEMORY_SCOPE_AGENT); }
__device__ __forceinline__ unsigned xb_xcc_id() { return (unsigned)__builtin_amdgcn_s_getreg((3 << 11) | 20) & 0xFu; }
#define XB_SPIN(cond, bar) do { unsigned _sp = 0; while (cond) { __builtin_amdgcn_s_sleep(1); \
    if ((++_sp & 255u) == 0u) { if (xb_ld(&(bar)[XB_TMO])) break; if (_sp > XB_SPIN_CAP) { atomicAdd(&(bar)[XB_TMO], 1u); break; } } } } while (0)
struct XcdBarrier { unsigned* bar; unsigned x; volatile LAS unsigned* st; };
__device__ __forceinline__ XcdBarrier xcd_barrier_post(unsigned* bar, volatile LAS unsigned* st) {
    XcdBarrier b; b.bar = bar; b.x = xb_xcc_id(); b.st = st;
    if (threadIdx.x == 0) (void)xb_add(&bar[XB_XCNT(b.x)], 1u);
    return b;
}
__device__ __forceinline__ void xcd_barrier_complete(unsigned* bar, unsigned x, unsigned& nloc, unsigned& nx) {
    const unsigned G = gridDim.x * gridDim.y * gridDim.z;
    unsigned sum, cnt, mine, sp = 0u;
    for (;;) {
        sum = 0u; cnt = 0u; mine = 0u;
#pragma unroll
        for (unsigned j = 0; j < 16; ++j) { const unsigned c = xb_ld(&bar[XB_XCNT(j)]); sum += c; cnt += (c > 0u) ? 1u : 0u; mine = (j == x) ? c : mine; }
        if (sum == G) break;
        __builtin_amdgcn_s_sleep(1);
        if ((++sp & 255u) == 0u) { if (xb_ld(&bar[XB_TMO])) break; if (sp > XB_SPIN_CAP) { atomicAdd(&bar[XB_TMO], 1u); break; } }
    }
    nloc = mine > 0u ? mine : 1u; nx = cnt > 0u ? cnt : 1u;
}
__device__ __forceinline__ void xcd_barrier(const XcdBarrier& b) {
    asm volatile("s_waitcnt vmcnt(0)" ::: "memory");
    __syncthreads();
    if (threadIdx.x == 0) {
        unsigned* bar = b.bar;
        __builtin_amdgcn_s_waitcnt(0);
        unsigned nloc = b.st[0], nx = b.st[1];
        if (nloc == 0u) { xcd_barrier_complete(bar, b.x, nloc, nx); b.st[0] = nloc; b.st[1] = nx; }
        const unsigned old = xb_add(&bar[XB_XSUB(b.x)], 1u);
        const unsigned gen = old / nloc;
        if (old + 1u == (gen + 1u) * nloc) {
            __builtin_amdgcn_fence(__ATOMIC_RELEASE, "agent");
            asm volatile("s_waitcnt vmcnt(0)" ::: "memory");
            const unsigned og = xb_add(&bar[XB_TOP], 1u);
            const unsigned tg = og / nx;
            if (og + 1u == (tg + 1u) * nx) xb_add(&bar[XB_TOPGEN], 1u);
            else XB_SPIN(xb_ld(&bar[XB_TOPGEN]) == tg, bar);
            __builtin_amdgcn_fence(__ATOMIC_ACQUIRE, "agent");
            xb_add(&bar[XB_XGEN(b.x)], 1u);
            asm volatile("s_waitcnt vmcnt(0)" ::: "memory");
        } else {
            XB_SPIN(xb_ld(&bar[XB_XGEN(b.x)]) == gen, bar);
            __builtin_amdgcn_fence(__ATOMIC_ACQUIRE, "agent");
            asm volatile("s_waitcnt vmcnt(0)" ::: "memory");
        }
    }
    __syncthreads();
}

constexpr int LDS_BYTES = 159744;
constexpr int LDS_MISC = 155648;

__global__ void __launch_bounds__(NTHREADS, 2) mega_fwd(Params P) {
    extern __shared__ __attribute__((aligned(16))) unsigned char lds_raw[];
    LAS unsigned char* lds = (LAS unsigned char*)lds_raw;
    const int bid0 = blockIdx.x, nblk0 = gridDim.x;
    if (threadIdx.x < 64) ((LAS unsigned*)(lds + LDS_MISC))[threadIdx.x] = 0u;
    __syncthreads();
    XcdBarrier bar = xcd_barrier_post((unsigned*)(P.ws + WS_CTL) + CW_BAR, (volatile LAS unsigned*)(lds + LDS_MISC));
#define GRID_BAR() xcd_barrier(bar)

    {
    const int bid = bid0, nblk = nblk0;
    ph_mod(P, lds, bid, nblk);
    ph_rope_table(P, bid, nblk);
    ph_convert_static(P, lds, bid, nblk);
    ph_convert_moe(P, 0, lds, bid, nblk, 1);
    GRID_BAR();
    ph_prep0(P, bid, nblk);
    GRID_BAR();
    }

    for (int jj = 0; jj < 2; ++jj) {
        int bid_l = bid0, nblk_l = nblk0; asm volatile("" : "+s"(bid_l), "+s"(nblk_l));
        const int bid = bid_l, nblk = nblk_l;
        {
            const int layer = 2 * jj, j = jj;
            const float* modl = (const float*)(P.ws + WS_MOD) + (size_t)layer * 5 * 6144;
            {
                pg8::Gemm g{(const f16*)(P.ws + WS_H), (const f16*)(P.ws + WS_EWIN) + (size_t)j * EVEN_IN * D, M, EVEN_IN, D}; pg8::StaticOrder S; S.init(M, EVEN_IN, nblk, bid);
                pg8::EpiF16 E{(f16*)(P.ws + WS_P), EVEN_IN, EVEN_IN / 256};
                pg8::gemm_phase<pg8::EpiF16, pg8::StaticOrder, true, true>(lds, g, S, E);
                bg_convert_w2(P, jj, 0, 3200, ((M / 256) * (EVEN_IN / 256)) % nblk, lds, bid, nblk);
            }
            GRID_BAR();
            ph_na(P, j, lds, bid, nblk);
            ph_hgrn_local(P, j, lds, bid, nblk);
            bg_convert_w13(P, 1, jj == 0 ? 0 : 3400, jj == 0 ? 1400 : 4700, nblk == 256 ? 64 : 0, (f16*)(P.ws + WS_MW13B), lds, bid, nblk);
            GRID_BAR();
            ph_hgrn_carry(P, bid, nblk);
            GRID_BAR();
            ph_hgrn_final(P, j, lds, bid, nblk);
            GRID_BAR();
            {
                pg8::Gemm g{(const f16*)(P.ws + WS_MIX), (const f16*)(P.ws + WS_EWOUT) + (size_t)j * D * D, TX, D, D}; pg8::StaticOrder S; S.init(TX, D, nblk, bid);
                pg8::EpiResid E{(const f16*)(P.ws + WS_X), (f16*)(P.ws + WS_V), modl, 2 * D};
                pg8::gemm_phase<pg8::EpiResid, pg8::StaticOrder, true, true>(lds, g, S, E);
                gemm_ctx64(lds, (const f16*)(P.ws + WS_MIX), (const f16*)(P.ws + WS_EWOUT) + (size_t)j * D * D, D, (const f16*)(P.ws + WS_X), (f16*)(P.ws + WS_V), modl + 4 * 6144 + 2 * D, bid, nblk);
            }
            GRID_BAR();
            ph_ln<0>(P, layer, 0, bid, nblk, false);
            GRID_BAR();
            {
                pg8::Gemm g{(const f16*)(P.ws + WS_H), (const f16*)(P.ws + WS_FW13) + (size_t)j * 2 * FFN * D, M, 2 * FFN, D}; pg8::StaticOrder S; S.init(M, 2 * FFN, nblk, bid);
                pg8::EpiSwiglu E{(f16*)(P.ws + WS_G), FFN, 2 * FFN / 256};
                pg8::gemm_phase<pg8::EpiSwiglu, pg8::StaticOrder, true, true>(lds, g, S, E);
                bg_convert_w2(P, jj, 3200, 3840, ((M / 256) * (2 * FFN / 256)) % nblk, lds, bid, nblk);
            }
            GRID_BAR();
            {
                pg8::Gemm g{(const f16*)(P.ws + WS_G), (const f16*)(P.ws + WS_FW2) + (size_t)j * D * FFN, TX, D, FFN}; pg8::StaticOrder S; S.init(TX, D, nblk, bid);
                pg8::EpiResid E{(const f16*)(P.ws + WS_X), (f16*)(P.ws + WS_V), modl, 5 * D};
                pg8::gemm_phase<pg8::EpiResid, pg8::StaticOrder, true, true>(lds, g, S, E);
                gemm_ctx64(lds, (const f16*)(P.ws + WS_G), (const f16*)(P.ws + WS_FW2) + (size_t)j * D * FFN, FFN, (const f16*)(P.ws + WS_X), (f16*)(P.ws + WS_V), modl + 4 * 6144 + 5 * D, bid, nblk);
            }
            GRID_BAR();
            ph_ln<0>(P, layer, 1, bid, nblk, false);
            GRID_BAR();
        }
        {
            const int layer = 2 * jj + 1, j = jj;
            const bool last = (layer == DEPTH - 1);
            const float* modl = (const float*)(P.ws + WS_MOD) + (size_t)layer * 5 * 6144;
            {
                pg8::Gemm g{(const f16*)(P.ws + WS_H), (const f16*)(P.ws + WS_OWIN) + (size_t)j * ODD_IN * D, M, ODD_IN, D}; pg8::StaticOrder S; S.init(M, ODD_IN, nblk, bid);
                pg8::EpiRope E{(f16*)(P.ws + WS_P), (const float*)(P.ws + WS_ROPET)};
                pg8::gemm_phase<pg8::EpiRope, pg8::StaticOrder, true, true>(lds, g, S, E);
                bg_convert_w2(P, jj, 3840, 6400, ((M / 256) * (ODD_IN / 256)) % nblk, lds, bid, nblk);
            }
            GRID_BAR();
            ph_ret_pm(P, j, bid, nblk);
            ph_ret_scan(P, j, lds, bid, nblk);
            GRID_BAR();
            ph_ret_final(P, lds, bid, nblk);
            bg_convert_w13(P, 1, jj == 0 ? 1400 : 4700, jj == 0 ? 3400 : W13_PRO, nblk == 256 ? 64 : 0, (f16*)(P.ws + WS_MW13B), lds, bid, nblk);
            GRID_BAR();
            {
                pg8::Gemm g{(const f16*)(P.ws + WS_MIX), (const f16*)(P.ws + WS_OWOUT) + (size_t)j * D * 2048, TX, D, 2048}; pg8::StaticOrder S; S.init(TX, D, nblk, bid);
                pg8::EpiResid E{(const f16*)(P.ws + WS_X), (f16*)(P.ws + WS_V), modl, 2 * D};
                pg8::gemm_phase<pg8::EpiResid, pg8::StaticOrder, true, true>(lds, g, S, E);
                if (!last)
                    gemm_ctx64(lds, (const f16*)(P.ws + WS_MIX), (const f16*)(P.ws + WS_OWOUT) + (size_t)j * D * 2048, 2048, (const f16*)(P.ws + WS_X), (f16*)(P.ws + WS_V), modl + 4 * 6144 + 2 * D, bid, nblk);
            }
            GRID_BAR();
            ph_ln<1>(P, layer, 0, bid, nblk, false, lds, last ? TX : M);
            GRID_BAR();
            ph_moe_gather(P, j, bid, nblk, last ? TX : M);
            GRID_BAR();
            {
                const int* tilex = (const int*)(P.ws + WS_TILEX);
                const int ntiles = __builtin_amdgcn_readfirstlane(__hip_atomic_load(tilex + 255, __ATOMIC_RELAXED, __HIP_MEMORY_SCOPE_AGENT));
                pg8::Gemm g{(const f16*)(P.ws + WS_XP), (const f16*)(P.ws + (jj == 0 ? WS_MW13 : WS_MW13B)), MOE_ROWS, NE * 2 * EDIM, D};
                pg8::GroupedOrder S{tilex, ntiles, 2 * EDIM / 256, nblk, bid};
                pg8::EpiSwiglu E{(f16*)(P.ws + WS_GP), EDIM, 2 * EDIM / 256};
                pg8::gemm_phase<pg8::EpiSwiglu, pg8::GroupedOrder, true, true>(lds, g, S, E);
                bg_convert_w2(P, jj, 6400, NE * W2_TILES, (ntiles * (2 * EDIM / 256)) % nblk, lds, bid, nblk);
            }
            GRID_BAR();
            {
                const int* tilex = (const int*)(P.ws + WS_TILEX);
                const int ntiles = __builtin_amdgcn_readfirstlane(__hip_atomic_load(tilex + 255, __ATOMIC_RELAXED, __HIP_MEMORY_SCOPE_AGENT));
                pg8::Gemm g{(const f16*)(P.ws + WS_GP), (const f16*)(P.ws + WS_MW2), MOE_ROWS, NE * D, EDIM};
                pg8::GroupedOrder S{tilex, ntiles, D / 256, nblk, bid};
                pg8::EpiF16 E{(f16*)(P.ws + WS_Y2P), D, D / 256};
                pg8::gemm_phase<pg8::EpiF16, pg8::GroupedOrder, true, true>(lds, g, S, E);
                if (jj == 0) {
                    const int U = ntiles * (D / 256), heavy = U % nblk;
                    const int w0 = heavy, nw = nblk - heavy;
                    __syncthreads();
                    bg_convert_w13(P, 1, W13_PRO, NE * 2 * W13_TILES, w0, (f16*)(P.ws + WS_MW13B), lds, bid, nblk); (void)nw;
                }
            }
            GRID_BAR();
            ph_ln<2>(P, layer, 1, bid, nblk, last, nullptr, last ? TX : M);
            if (!last) GRID_BAR();
        }
    }
}

extern "C" void kernel_launch(void* const* d_in, const int* in_sizes, int n_in, void* d_out, int out_size, void* d_ws, size_t ws_size, hipStream_t stream) {
    static int grid = 0;
    if (grid == 0) {
        if (n_in != 24 || ws_size < WS_END) { fprintf(stderr, "kernel_launch: unexpected n_in %d or ws_size %zu (need %zu)\n", n_in, ws_size, (size_t)WS_END); grid = -1; return; }
        int dev = 0, cus = 0;
        if (hipGetDevice(&dev) != hipSuccess || hipDeviceGetAttribute(&cus, hipDeviceAttributeMultiprocessorCount, dev) != hipSuccess) { grid = -1; return; }
        if (hipFuncSetAttribute((const void*)mega_fwd, hipFuncAttributeMaxDynamicSharedMemorySize, LDS_BYTES) != hipSuccess) { grid = -1; return; }
        int per_cu = 0;
        (void)hipOccupancyMaxActiveBlocksPerMultiprocessor(&per_cu, (const void*)mega_fwd, NTHREADS, LDS_BYTES);
        (void)hipGetLastError();
        grid = cus;
    }
    if (grid < 0) return;
    Params p{};
    const float** pp = (const float**)&p;
    for (int i = 0; i < 24; ++i) pp[i] = (const float*)d_in[i];
    p.out = (float*)d_out; p.ws = (unsigned char*)d_ws;
    (void)hipMemsetAsync((char*)d_ws + WS_CTL, 0, CTL_BYTES, stream);
    hipLaunchKernelGGL(mega_fwd, dim3(grid), dim3(NTHREADS), LDS_BYTES, stream, p);
}
```

```cpp
#include <hip/hip_runtime.h>
#include <cstdio>
#include <cstdint>

#define LAS __attribute__((address_space(3)))
typedef _Float16 f16;
typedef f16 f16x8 __attribute__((ext_vector_type(8)));
typedef f16 f16x4 __attribute__((ext_vector_type(4)));
typedef f16 f16x2 __attribute__((ext_vector_type(2)));
typedef float f32x4 __attribute__((ext_vector_type(4)));
typedef float f32x2 __attribute__((ext_vector_type(2)));
typedef unsigned u32x4 __attribute__((ext_vector_type(4)));
typedef unsigned u32x2 __attribute__((ext_vector_type(2)));
typedef short s16x4 __attribute__((ext_vector_type(4)));
typedef __bf16 bf16x8 __attribute__((ext_vector_type(8)));
typedef __bf16 bf16x2 __attribute__((ext_vector_type(2)));

constexpr int D = 1024, NB = 4, SEQ = 4096, TX = NB * SEQ, CL = 256, TC = NB * CL, M = TX + TC;
constexpr int DEPTH = 4, GW = 64;
constexpr int EVEN_IN = 4096, ODD_IN = 6144, FFN = 2816, NE = 8, EDIM = 3584;
constexpr float ALPHA = 1.681792830507429f;
constexpr float LN_EPS = 1e-5f, NORM_EPS = 1e-6f;
constexpr int NTHREADS = 512, NWAVES = 8;
constexpr int MOE_ROWS = 36864, MOE_TILES = MOE_ROWS / 256;

constexpr size_t MiB = 1u << 20;
constexpr size_t WS_CTL = 0, CTL_BYTES = 32768;
constexpr size_t WS_MOD = 1 * MiB;
constexpr size_t WS_ROUTE = 2 * MiB;
constexpr size_t WS_TILEX = 3 * MiB;
constexpr size_t WS_ROPET = 3 * MiB + 65536;
constexpr size_t WS_EWIN = 4 * MiB;
constexpr size_t WS_EWOUT = WS_EWIN + 16 * MiB;
constexpr size_t WS_FW13 = WS_EWOUT + 4 * MiB;
constexpr size_t WS_FW2 = WS_FW13 + 22 * MiB;
constexpr size_t WS_OWIN = WS_FW2 + 11 * MiB;
constexpr size_t WS_OWOUT = WS_OWIN + 24 * MiB;
constexpr size_t WS_MW13 = WS_OWOUT + 8 * MiB;
constexpr size_t WS_MW2 = WS_MW13 + 112 * MiB;
constexpr size_t WS_X = WS_MW2 + 56 * MiB;
constexpr size_t WS_V = WS_X + 68 * MiB;
constexpr size_t WS_H = WS_V + 68 * MiB;
constexpr size_t WS_BIG = WS_H + 34 * MiB;
constexpr size_t WS_P = WS_BIG;
constexpr size_t WS_MIX = WS_BIG + 204 * MiB;
constexpr size_t WS_OD = WS_BIG + 272 * MiB;
constexpr size_t WS_G = WS_BIG;
constexpr size_t WS_XP = WS_BIG;
constexpr size_t WS_GP = WS_BIG + 72 * MiB;
constexpr size_t WS_Y2P = WS_BIG + 324 * MiB;
constexpr size_t WS_HST = WS_BIG + 136 * MiB;
constexpr size_t WS_HGT = WS_BIG + 154 * MiB;
constexpr size_t WS_HQD = WS_BIG + 340 * MiB;
constexpr size_t WS_HUT = WS_BIG + 374 * MiB;
constexpr size_t WS_PM = WS_BIG + 408 * MiB;
constexpr size_t WS_MW13B = WS_BIG + 424 * MiB;
constexpr size_t WS_END = WS_BIG + 536 * MiB;

constexpr int CW_CNT = 1024;
constexpr int CW_BAR = 4096;

struct Params {
    const float *x, *c, *ctx, *c_ctx, *ada_w, *ada_b, *ln_g, *ln_b, *e_w_in, *e_w_out, *na_rpb, *hg_lb, *hg_norm_g,
        *ffn_w1, *ffn_w3, *ffn_w2, *o_w_in, *o_w_out, *ret_ld, *router_w, *router_b, *moe_w1, *moe_w3, *moe_w2;
    float* out;
    unsigned char* ws;
};

#define LDS_BARRIER() do { asm volatile("s_waitcnt lgkmcnt(0)" ::: "memory"); __builtin_amdgcn_s_barrier(); asm volatile("" ::: "memory"); } while (0)
__device__ __forceinline__ int tid_fresh() { int t = threadIdx.x; asm volatile("" : "+v"(t)); return t; }
__device__ __forceinline__ float swiglu_pre(float g, float u) { return g * __builtin_amdgcn_rcpf(1.0f + __builtin_amdgcn_exp2f(-g)) * u; }
__device__ __forceinline__ float silu_f(float v) { return v * __builtin_amdgcn_rcpf(1.0f + __expf(-v)); }
__device__ __forceinline__ int row_vec(int row) { return row < TX ? (row >> 12) : 4; }
__device__ __forceinline__ float wave_sum(float v) {
#pragma unroll
    for (int o = 1; o < 64; o <<= 1) v += __shfl_xor(v, o);
    return v;
}

namespace pg8 {
constexpr int BM = 256, BK = 64, HALF = 128, HTB = HALF * BK * 2, STAGE_BYTES = 8 * HTB, NXCD = 8, WGM = 8;
__host__ __device__ __forceinline__ int lds_byte(int r, int c) { const int st = (r >> 4) * 2 + (c >> 5), rr = r & 15, cc = c & 31, ob = rr * 64 + cc * 2; return st * 1024 + (ob ^ (((ob >> 9) & 1) << 5)); }
__host__ __device__ __forceinline__ void stage_rc(int b, int& R, int& C) { const int st = b / 1024, sb = b % 1024, swz = sb ^ (((sb >> 9) & 1) << 5); R = (st >> 1) * 16 + swz / 64; C = (st & 1) * 32 + (swz % 64) / 2; }
__host__ __device__ __forceinline__ int perm32(int rho) { const int n = rho >> 4, i = rho & 15; return 8 * (i >> 2) + 4 * n + (i & 3); }

struct Unit { int pm, pn; };
struct Gemm { const f16* A; const f16* Bt; int M, N, K; };

struct StaticOrder {
    int nM, nN, nwg, G, c;
    __host__ __device__ void init(int M_, int N_, int G_, int c_) { nM = M_ / BM; nN = N_ / BM; nwg = nM * nN; G = G_; c = c_; }
    __host__ __device__ bool next(int i, Unit& u) const {
        const long L = (long)i * G + c; if (L >= nwg) return false;
        int wgid = (int)L; { const int q = nwg / NXCD, r = nwg % NXCD, xcd = wgid % NXCD, off = wgid / NXCD; wgid = (xcd < r ? xcd * (q + 1) : r * (q + 1) + (xcd - r) * q) + off; }
        const int nig = WGM * nN, gid = wgid / nig, fm = gid * WGM, gsz = (nM - fm) < WGM ? (nM - fm) : WGM;
        u.pm = fm + ((wgid % nig) % gsz); u.pn = (wgid % nig) / gsz; return true;
    }
    __device__ __forceinline__ void a_ready(const Unit&) const {}
    __device__ __forceinline__ void done(const Unit&) const {}
};
struct GroupedOrder {
    const int* tile_expert; int ntiles, nN, G, c;
    __device__ bool next(int i, Unit& u) const {
        const long L = (long)i * G + c; if (L >= (long)ntiles * nN) return false;
        const int pm = (int)(L / nN), pl = (int)(L % nN);
        u.pm = pm; u.pn = __builtin_amdgcn_readfirstlane(__hip_atomic_load(tile_expert + pm, __ATOMIC_RELAXED, __HIP_MEMORY_SCOPE_AGENT)) * nN + pl; return true;
    }
    __device__ __forceinline__ void a_ready(const Unit&) const {}
    __device__ __forceinline__ void done(const Unit&) const {}
};

template <class Epi, class Sched, bool ALIGN_EPI = false, bool SP2 = false>
__device__ __forceinline__ void gemm_phase(LAS unsigned char* lds, const Gemm g, const Sched& S, const Epi& E) {
    const int tid = tid_fresh(), wid = __builtin_amdgcn_readfirstlane(tid >> 6), lane = tid & 63, wr = wid >> 2, wc = wid & 3, fr = lane & 15, fq = lane >> 4;
    const int K = g.K, nt = K / BK;
    unsigned voffA[2], voffB[2];
#pragma unroll
    for (int i = 0; i < 2; ++i) { int R, C; stage_rc(tid * 16 + i * 8192, R, C); const int Rb = Epi::PERM ? ((R & ~31) + perm32(R & 31)) : R;
        voffA[i] = (unsigned)(R * K + C) * 2u; voffB[i] = (unsigned)(Rb * K + C) * 2u; }
    const size_t kstep = (size_t)(BK * 2);
    const size_t hstep = (size_t)HALF * K * 2;
    const size_t tstep = 2 * hstep;
    const unsigned ldsw = (unsigned)wid * 1024u;
    const int aoff = lds_byte(wr * 64 + fr, fq * 8), boff = lds_byte(wc * 32 + fr, fq * 8);
#define PG8_SA(b, h) (((b) * 2 + (h)) * HTB)
#define PG8_SB(b, h) ((4 + (b) * 2 + (h)) * HTB)
#define PG8_STAGE(bufoff, gbase, voff) do { _Pragma("unroll") for (int _i = 0; _i < 2; ++_i) \
        __builtin_amdgcn_global_load_lds((const unsigned*)((const char*)(gbase) + (voff)[_i]), (LAS unsigned*)(lds + (bufoff) + ldsw + _i * 8192), 16, 0, 0); } while (0)
#define PG8_LDA(dst, b, h) do { _Pragma("unroll") for (int m = 0; m < 4; ++m) _Pragma("unroll") for (int k = 0; k < 2; ++k) dst[m][k] = *(const LAS f16x8*)(lds + PG8_SA(b, h) + aoff + m * 2048 + k * 1024); } while (0)
#define PG8_LDB(dst, b, h) do { _Pragma("unroll") for (int n = 0; n < 2; ++n) _Pragma("unroll") for (int k = 0; k < 2; ++k) dst[n][k] = *(const LAS f16x8*)(lds + PG8_SB(b, h) + boff + n * 2048 + k * 1024); } while (0)
#define PG8_MMA(ai, bj, At, Bt) do { __builtin_amdgcn_s_setprio(1); _Pragma("unroll") for (int m = 0; m < 4; ++m) _Pragma("unroll") for (int n = 0; n < 2; ++n) _Pragma("unroll") for (int k = 0; k < 2; ++k) \
        acc[ai][bj][m][n] = __builtin_amdgcn_mfma_f32_16x16x32_f16(Bt[n][k], At[m][k], acc[ai][bj][m][n], 0, 0, 0); __builtin_amdgcn_s_setprio(0); } while (0)
#define PG8_WAIT_V(n) asm volatile("s_waitcnt vmcnt(" #n ")" ::: "memory")
#define PG8_WAIT_L(n) asm volatile("s_waitcnt lgkmcnt(" #n ")" ::: "memory")
#define PG8_BAR __builtin_amdgcn_s_barrier()
#define PG8_SCHED __builtin_amdgcn_sched_barrier(0)
    Unit cur, nxt; int ui = 0;
    if (!S.next(0, cur)) return;
    f32x4 acc[2][2][4][2];
#pragma unroll
    for (int a = 0; a < 2; ++a)
#pragma unroll
        for (int b = 0; b < 2; ++b)
#pragma unroll
            for (int m = 0; m < 4; ++m)
#pragma unroll
                for (int n = 0; n < 2; ++n) acc[a][b][m][n] = (f32x4){0.f, 0.f, 0.f, 0.f};
    f16x8 At[4][2], B0[2][2], B1[2][2];
    const char* cA = (const char*)g.A + (size_t)cur.pm * tstep; const char* cB = (const char*)g.Bt + (size_t)cur.pn * tstep;
    S.a_ready(cur);
    if constexpr (SP2) {
        PG8_STAGE(PG8_SB(0, 0), cB, voffB); PG8_STAGE(PG8_SB(0, 1), cB + hstep, voffB); PG8_STAGE(PG8_SA(0, 0), cA, voffA); PG8_STAGE(PG8_SA(0, 1), cA + hstep, voffA);
        if (wr == 1) PG8_BAR;
        PG8_WAIT_V(2); PG8_BAR;
        PG8_STAGE(PG8_SB(1, 0), cB + kstep, voffB); PG8_STAGE(PG8_SA(1, 0), cA + kstep, voffA); PG8_STAGE(PG8_SB(1, 1), cB + hstep + kstep, voffB);
        PG8_WAIT_V(6); PG8_BAR;
    } else {
        PG8_STAGE(PG8_SB(0, 0), cB, voffB); PG8_STAGE(PG8_SA(0, 0), cA, voffA); PG8_STAGE(PG8_SB(0, 1), cB + hstep, voffB); PG8_STAGE(PG8_SA(0, 1), cA + hstep, voffA);
        if (wr == 1) PG8_BAR;
        PG8_WAIT_V(4); PG8_BAR;
        PG8_STAGE(PG8_SB(1, 0), cB + kstep, voffB); PG8_STAGE(PG8_SA(1, 0), cA + kstep, voffA); PG8_STAGE(PG8_SB(1, 1), cB + hstep + kstep, voffB);
        PG8_WAIT_V(6); PG8_BAR;
    }
    for (;;) {
        const bool has_next = S.next(ui + 1, nxt);
        const char* nA = has_next ? (const char*)g.A + (size_t)nxt.pm * tstep : cA; const char* nB = has_next ? (const char*)g.Bt + (size_t)nxt.pn * tstep : cB;
        for (int t = 0; t < nt; t += 2) {
            const bool last = (t == nt - 2);
            const char* a1 = cA + (size_t)(t + 1) * kstep;
            const char* a2 = last ? nA : cA + (size_t)(t + 2) * kstep; const char* b2 = last ? nB : cB + (size_t)(t + 2) * kstep;
            const char* a3 = a2 + kstep; const char* b3 = b2 + kstep;
            if (last && has_next) S.a_ready(nxt);
            if constexpr (SP2) {
            PG8_LDB(B0, 0, 0); PG8_LDB(B1, 0, 1); PG8_SCHED; PG8_LDA(At, 0, 0); PG8_STAGE(PG8_SA(1, 1), a1 + hstep, voffA);
            PG8_WAIT_V(8); PG8_WAIT_L(0); PG8_BAR; PG8_MMA(0, 0, At, B0); PG8_MMA(0, 1, At, B1); PG8_BAR; PG8_SCHED;
            PG8_LDA(At, 0, 1); PG8_STAGE(PG8_SB(0, 0), b2, voffB); PG8_STAGE(PG8_SB(0, 1), b2 + hstep, voffB); PG8_STAGE(PG8_SA(0, 0), a2, voffA);
            PG8_WAIT_V(8); PG8_WAIT_L(0); PG8_BAR; PG8_MMA(1, 0, At, B0); PG8_MMA(1, 1, At, B1); PG8_BAR; PG8_SCHED;
            PG8_LDB(B0, 1, 0); PG8_LDB(B1, 1, 1); PG8_SCHED; PG8_LDA(At, 1, 0); PG8_STAGE(PG8_SA(0, 1), a2 + hstep, voffA);
            PG8_WAIT_V(8); PG8_WAIT_L(0); PG8_BAR; PG8_MMA(0, 0, At, B0); PG8_MMA(0, 1, At, B1); PG8_BAR; PG8_SCHED;
            PG8_LDA(At, 1, 1); PG8_STAGE(PG8_SB(1, 0), b3, voffB); PG8_STAGE(PG8_SB(1, 1), b3 + hstep, voffB); PG8_STAGE(PG8_SA(1, 0), a3, voffA);
            PG8_WAIT_V(8); PG8_WAIT_L(0); PG8_BAR; PG8_MMA(1, 0, At, B0); PG8_MMA(1, 1, At, B1); PG8_BAR; PG8_SCHED;
            } else {
            PG8_LDB(B0, 0, 0); PG8_SCHED; PG8_LDA(At, 0, 0); PG8_STAGE(PG8_SA(1, 1), a1 + hstep, voffA);
            PG8_WAIT_L(8); PG8_BAR; PG8_WAIT_L(0); PG8_MMA(0, 0, At, B0); PG8_BAR; PG8_SCHED;
            PG8_LDB(B1, 0, 1); PG8_STAGE(PG8_SB(0, 0), b2, voffB);
            PG8_BAR; PG8_WAIT_L(0); PG8_MMA(0, 1, At, B1); PG8_BAR;
            PG8_LDA(At, 0, 1); PG8_STAGE(PG8_SA(0, 0), a2, voffA);
            PG8_BAR; PG8_WAIT_L(0); PG8_MMA(1, 0, At, B0); PG8_BAR; PG8_SCHED;
            PG8_STAGE(PG8_SB(0, 1), b2 + hstep, voffB);
            PG8_WAIT_V(6); PG8_BAR; PG8_MMA(1, 1, At, B1); PG8_BAR;
            PG8_LDB(B0, 1, 0); PG8_SCHED; PG8_LDA(At, 1, 0); PG8_STAGE(PG8_SA(0, 1), a2 + hstep, voffA);
            PG8_WAIT_L(8); PG8_BAR; PG8_WAIT_L(0); PG8_MMA(0, 0, At, B0); PG8_BAR; PG8_SCHED;
            PG8_LDB(B1, 1, 1); PG8_STAGE(PG8_SB(1, 0), b3, voffB);
            PG8_BAR; PG8_WAIT_L(0); PG8_MMA(0, 1, At, B1); PG8_BAR;
            PG8_LDA(At, 1, 1); PG8_STAGE(PG8_SA(1, 0), a3, voffA);
            PG8_BAR; PG8_WAIT_L(0); PG8_MMA(1, 0, At, B0); PG8_BAR; PG8_SCHED;
            PG8_STAGE(PG8_SB(1, 1), b3 + hstep, voffB);
            PG8_WAIT_V(6); PG8_BAR; PG8_MMA(1, 1, At, B1); PG8_BAR;
            }
        }
        if constexpr (ALIGN_EPI) { if (wr == 0) PG8_BAR; }
        E(acc, cur, wr, wc, fr, fq); S.done(cur);
        if (!has_next) break;
#pragma unroll
        for (int a = 0; a < 2; ++a)
#pragma unroll
            for (int b = 0; b < 2; ++b)
#pragma unroll
                for (int m = 0; m < 4; ++m)
#pragma unroll
                    for (int n = 0; n < 2; ++n) acc[a][b][m][n] = (f32x4){0.f, 0.f, 0.f, 0.f};
        cur = nxt; cA = nA; cB = nB; ++ui;
        if constexpr (ALIGN_EPI) { if (wr == 1) PG8_BAR; }
    }
    PG8_WAIT_V(0);
    if constexpr (!ALIGN_EPI) { if (wr == 0) PG8_BAR; }
    PG8_BAR;
#undef PG8_SA
#undef PG8_SB
#undef PG8_STAGE
#undef PG8_LDA
#undef PG8_LDB
#undef PG8_MMA
#undef PG8_WAIT_V
#undef PG8_WAIT_L
#undef PG8_BAR
#undef PG8_SCHED
}

__device__ __forceinline__ u32x4 pack8(const f32x4 a, const f32x4 b) {
    f16x8 h; h[0] = (f16)a[0]; h[1] = (f16)a[1]; h[2] = (f16)a[2]; h[3] = (f16)a[3]; h[4] = (f16)b[0]; h[5] = (f16)b[1]; h[6] = (f16)b[2]; h[7] = (f16)b[3];
    return __builtin_bit_cast(u32x4, h);
}
struct EpiF16 {
    static constexpr bool PERM = true;
    f16* O; int ldc; int nN_local;
    __device__ __forceinline__ void operator()(const f32x4 (&acc)[2][2][4][2], const Unit& u, int wr, int wc, int fr, int fq) const {
        const int row0 = u.pm * BM + wr * 64 + fr; const int col0 = (u.pn % nN_local) * BM + wc * 32 + 8 * fq;
#pragma unroll
        for (int ai = 0; ai < 2; ++ai)
#pragma unroll
            for (int m = 0; m < 4; ++m) { f16* rowp = O + (size_t)(row0 + ai * HALF + m * 16) * ldc + col0;
#pragma unroll
                for (int bj = 0; bj < 2; ++bj) *(u32x4*)(rowp + bj * HALF) = pack8(acc[ai][bj][m][0], acc[ai][bj][m][1]); }
    }
};
struct EpiRope {
    static constexpr bool PERM = true;
    f16* O; const float* T;
    __device__ __forceinline__ void operator()(const f32x4 (&acc)[2][2][4][2], const Unit& u, int wr, int wc, int fr, int fq) const {
        const int row0 = u.pm * BM + wr * 64 + fr; const int col0 = u.pn * BM + wc * 32 + 8 * fq;
        const bool isq = u.pn < 4, isk = u.pn >= 4 && u.pn < 8, latent = u.pm < TX / BM;
#pragma unroll
        for (int ai = 0; ai < 2; ++ai)
#pragma unroll
            for (int m = 0; m < 4; ++m) { const int row = row0 + ai * HALF + m * 16; f16* rowp = O + (size_t)row * ODD_IN + col0; const int n = row & (SEQ - 1);
#pragma unroll
                for (int bj = 0; bj < 2; ++bj) { f32x4 v0 = acc[ai][bj][m][0], v1 = acc[ai][bj][m][1];
                    if (isq || isk) {
                        if (latent) { const int c = col0 + bj * HALF; const int pos = ((c >> 7) & 1) ? (n & 63) : (n >> 6); const float* tp = T + ((size_t)pos * 64 + ((c & 127) >> 1)) * 2;
                            const f32x4 t0 = *(const f32x4*)tp, t1 = *(const f32x4*)(tp + 4);
                            const f32x4 a = v0, b2 = v1;
                            v0[0] = a[0] * t0[0] - a[1] * t0[1]; v0[1] = a[1] * t0[0] + a[0] * t0[1]; v0[2] = a[2] * t0[2] - a[3] * t0[3]; v0[3] = a[3] * t0[2] + a[2] * t0[3];
                            v1[0] = b2[0] * t1[0] - b2[1] * t1[1]; v1[1] = b2[1] * t1[0] + b2[0] * t1[1]; v1[2] = b2[2] * t1[2] - b2[3] * t1[3]; v1[3] = b2[3] * t1[2] + b2[2] * t1[3]; }
                        if (isk) { v0 = v0 * 0.0625f; v1 = v1 * 0.0625f; }
                    }
                    *(u32x4*)(rowp + bj * HALF) = pack8(v0, v1); } }
    }
};
struct EpiSwiglu {
    static constexpr bool PERM = true;
    f16* O; int ldc; int nN_local;
    __device__ __forceinline__ void operator()(const f32x4 (&acc)[2][2][4][2], const Unit& u, int wr, int wc, int fr, int fq) const {
        const int row0 = u.pm * BM + wr * 64 + fr; const int col0 = (u.pn % nN_local) * HALF + wc * 32 + 8 * fq;
#pragma unroll
        for (int ai = 0; ai < 2; ++ai)
#pragma unroll
            for (int m = 0; m < 4; ++m) { f16* rowp = O + (size_t)(row0 + ai * HALF + m * 16) * ldc + col0;
                f32x4 r0, r1;
#pragma unroll
                for (int j = 0; j < 4; ++j) { r0[j] = swiglu_pre(acc[ai][0][m][0][j], acc[ai][1][m][0][j]); r1[j] = swiglu_pre(acc[ai][0][m][1][j], acc[ai][1][m][1][j]); }
                *(u32x4*)rowp = pack8(r0, r1); }
    }
};
struct EpiResid {
    static constexpr bool PERM = false;
    const f16* X; f16* V; const float* modl; int gate;
    __device__ __forceinline__ void operator()(const f32x4 (&acc)[2][2][4][2], const Unit& u, int wr, int wc, int fr, int fq) const {
        const int row0 = u.pm * BM + wr * 64 + fr, col0 = u.pn * BM + wc * 32 + 4 * fq;
#pragma unroll
        for (int ai = 0; ai < 2; ++ai)
#pragma unroll
            for (int m = 0; m < 4; ++m) { const int row = row0 + ai * HALF + m * 16; const size_t off = (size_t)row * D + col0;
                const float* mrow = modl + row_vec(row) * 6144 + gate + col0;
#pragma unroll
                for (int bj = 0; bj < 2; ++bj)
#pragma unroll
                    for (int n = 0; n < 2; ++n) { const f16x4 xh = *(const f16x4*)(X + off + bj * HALF + n * 16); const f32x4 xs = (f32x4){(float)xh[0], (float)xh[1], (float)xh[2], (float)xh[3]}; const f32x4 mg = *(const f32x4*)(mrow + bj * HALF + n * 16);
                        const f32x4 vv = xs * ALPHA + mg * acc[ai][bj][m][n]; f16x4 hv; hv[0] = (f16)vv[0]; hv[1] = (f16)vv[1]; hv[2] = (f16)vv[2]; hv[3] = (f16)vv[3];
                        *(f16x4*)(V + off + bj * HALF + n * 16) = hv; } }
    }
};
}

constexpr int CG_P = 144;
__device__ __forceinline__ void gemm_ctx64(LAS unsigned char* lds, const f16* A, const f16* Bt, int K, const f16* X, f16* V, const float* modctx_gate, int bid, int nblk) {
    const int tid = tid_fresh(); const int wave = __builtin_amdgcn_readfirstlane(tid >> 6), lane = tid & 63, li = lane & 15, g = lane >> 4;
    const int wm = wave & 3, wn = wave >> 2, pr = tid >> 3, pc = tid & 7, nk = K / 64;
    for (int tile = bid; tile < 256; tile += nblk) {
        const int row0 = TX + 64 * (tile >> 4), col0 = 64 * (tile & 15);
        const f16* ap = A + (size_t)(row0 + pr) * K + pc * 8; const f16* bp = Bt + (size_t)(col0 + pr) * K + pc * 8;
        f32x4 acc[2]; acc[0] = (f32x4){0.f, 0.f, 0.f, 0.f}; acc[1] = (f32x4){0.f, 0.f, 0.f, 0.f};
        u32x4 ra = *(const u32x4*)ap, rb = *(const u32x4*)bp;
        __syncthreads();
        *(LAS u32x4*)(lds + pr * CG_P + pc * 16) = ra; *(LAS u32x4*)(lds + 2 * 64 * CG_P + pr * CG_P + pc * 16) = rb;
        __syncthreads();
        for (int ks = 0; ks < nk; ++ks) {
            const int cur = ks & 1;
            if (ks + 1 < nk) { ra = *(const u32x4*)(ap + 64 * (ks + 1)); rb = *(const u32x4*)(bp + 64 * (ks + 1)); }
            LAS unsigned char* As = lds + cur * 64 * CG_P; LAS unsigned char* Bs = lds + (2 + cur) * 64 * CG_P;
            f16x8 af[2], bf[2][2];
#pragma unroll
            for (int kk = 0; kk < 2; ++kk) { af[kk] = *(LAS f16x8*)(As + (16 * wm + li) * CG_P + (32 * kk + 8 * g) * 2);
#pragma unroll
                for (int nb = 0; nb < 2; ++nb) bf[nb][kk] = *(LAS f16x8*)(Bs + (32 * wn + 16 * nb + li) * CG_P + (32 * kk + 8 * g) * 2); }
#pragma unroll
            for (int kk = 0; kk < 2; ++kk)
#pragma unroll
                for (int nb = 0; nb < 2; ++nb) acc[nb] = __builtin_amdgcn_mfma_f32_16x16x32_f16(bf[nb][kk], af[kk], acc[nb], 0, 0, 0);
            if (ks + 1 < nk) { *(LAS u32x4*)(lds + (cur ^ 1) * 64 * CG_P + pr * CG_P + pc * 16) = ra; *(LAS u32x4*)(lds + (2 + (cur ^ 1)) * 64 * CG_P + pr * CG_P + pc * 16) = rb; }
            __syncthreads();
        }
        const size_t row = (size_t)(row0 + 16 * wm + li);
#pragma unroll
        for (int nb = 0; nb < 2; ++nb) { const int col = col0 + 32 * wn + 16 * nb + 4 * g;
            const f16x4 xh = *(const f16x4*)(X + row * D + col); const f32x4 xs = (f32x4){(float)xh[0], (float)xh[1], (float)xh[2], (float)xh[3]}, mg = *(const f32x4*)(modctx_gate + col);
            const f32x4 vv = xs * ALPHA + mg * acc[nb]; f16x4 hv; hv[0] = (f16)vv[0]; hv[1] = (f16)vv[1]; hv[2] = (f16)vv[2]; hv[3] = (f16)vv[3];
            *(f16x4*)(V + row * D + col) = hv; }
    }
}

__device__ __forceinline__ void ph_mod(const Params& P, LAS unsigned char* lds, int bid, int nblk) {
    const int tid = tid_fresh(); const int wave = tid >> 6, lane = tid & 63;
    float* mod = (float*)(P.ws + WS_MOD);
    LAS float* sv = (LAS float*)lds;
    LAS float* part = (LAS float*)(lds + 20480);
    for (int i = tid; i < 5 * D; i += NTHREADS) { const int v = i >> 10, k = i & 1023; sv[i] = silu_f(v < 4 ? P.c[v * D + k] : P.c_ctx[k]); }
    __syncthreads();
    for (int item = bid; item < DEPTH * 96; item += nblk) {
        const int l = item / 96, n = (item % 96) * 64 + lane;
        const float* w = P.ada_w + (size_t)l * D * 6144 + (size_t)(wave * 128) * 6144 + n;
        float a0 = 0.f, a1 = 0.f, a2 = 0.f, a3 = 0.f, a4 = 0.f;
        for (int k0 = 0; k0 < 128; k0 += 32) {
            float wv[32];
#pragma unroll
            for (int u = 0; u < 32; ++u) wv[u] = w[(size_t)(k0 + u) * 6144];
#pragma unroll
            for (int u = 0; u < 32; ++u) { const int kk = wave * 128 + k0 + u;
                a0 += sv[kk] * wv[u]; a1 += sv[D + kk] * wv[u]; a2 += sv[2 * D + kk] * wv[u]; a3 += sv[3 * D + kk] * wv[u]; a4 += sv[4 * D + kk] * wv[u]; }
        }
        LAS float* pw = part + wave * 320 + lane;
        pw[0] = a0; pw[64] = a1; pw[128] = a2; pw[192] = a3; pw[256] = a4;
        __syncthreads();
        if (tid < 320) { const int v = tid >> 6, ln = tid & 63; float t = 0.f;
#pragma unroll
            for (int wv = 0; wv < 8; ++wv) t += part[wv * 320 + v * 64 + ln];
            const int nn = (item % 96) * 64 + ln;
            mod[((size_t)l * 5 + v) * 6144 + nn] = t + P.ada_b[l * 6144 + nn]; }
        __syncthreads();
    }
}

constexpr int CV_P = 144;
__device__ __forceinline__ f16x4 tr_read_cv(LAS unsigned char* p) { const s16x4 v = __builtin_amdgcn_ds_read_tr16_b64_v4i16((LAS s16x4*)p); return __builtin_bit_cast(f16x4, v); }
__device__ __forceinline__ void convert_matrix(const float* W, int K, int N, f16* WT, int il, int half, LAS unsigned char* scr, int gw, int ngw, int lane, int& off) {
    const int items = (K / 64) * (N / 64), nblk = N / 64;
    const int li = lane & 15, g = lane >> 4;
    const float wscl = il == 1 ? (half ? 0.6931471805599453f : 1.4426950408889634f) : 1.0f;
    f32x4 r[16];
    auto load_item = [&](int item) { const int kb = item / nblk, nb = item % nblk; const float* src = W + (size_t)(64 * kb + g) * N + 64 * nb + 4 * li;
#pragma unroll
        for (int i = 0; i < 16; ++i) r[i] = *(const f32x4*)(src + (size_t)(4 * i) * N); };
    int it = gw - off; if (it < 0) it += ngw;
    off = (off + items) % ngw;
    if (it < items) load_item(it);
    for (; it < items; it += ngw) {
        const int kb = it / nblk, nb = it % nblk, k0 = 64 * kb, n0 = 64 * nb;
#pragma unroll
        for (int i = 0; i < 16; ++i) { const f32x4 rv = r[i] * wscl; f16x4 hv; hv[0] = (f16)rv[0]; hv[1] = (f16)rv[1]; hv[2] = (f16)rv[2]; hv[3] = (f16)rv[3];
            *(LAS f16x4*)(scr + (4 * i + g) * CV_P + li * 8) = hv; }
        if (it + ngw < items) load_item(it + ngw);
        f16x8 o[4][2];
#pragma unroll
        for (int nq = 0; nq < 4; ++nq)
#pragma unroll
            for (int ko = 0; ko < 2; ++ko) { LAS unsigned char* p = scr + (32 * ko + 8 * g + (li >> 2)) * CV_P + (16 * nq + 4 * (li & 3)) * 2;
                o[nq][ko] = __builtin_shufflevector(tr_read_cv(p), tr_read_cv(p + 4 * CV_P), 0, 1, 2, 3, 4, 5, 6, 7); }
#pragma unroll
        for (int nq = 0; nq < 4; ++nq) { const int n = n0 + 16 * nq + li;
            const int row = il == 1 ? ((n >> 7) * 256 + half * 128 + (n & 127)) : (il == 2 && n < 2048 ? ((n & ~127) + 2 * (n & 63) + ((n >> 6) & 1)) : n);
#pragma unroll
            for (int ko = 0; ko < 2; ++ko) *(f16x8*)(WT + (size_t)row * K + k0 + 32 * ko + 8 * g) = o[nq][ko]; }
    }
}
__device__ __forceinline__ void ph_convert_static(const Params& P, LAS unsigned char* lds, int bid, int nblk) {
    const int tidf = tid_fresh(); const int wave = tidf >> 6, lane = tidf & 63, gw = bid * NWAVES + wave, ngw = nblk * NWAVES;
    LAS unsigned char* scr = lds + wave * 16384; int off = 0;
    for (int j = 0; j < 2; ++j) {
        convert_matrix(P.e_w_in + (size_t)j * D * EVEN_IN, D, EVEN_IN, (f16*)(P.ws + WS_EWIN) + (size_t)j * EVEN_IN * D, 0, 0, scr, gw, ngw, lane, off);
        convert_matrix(P.e_w_out + (size_t)j * D * D, D, D, (f16*)(P.ws + WS_EWOUT) + (size_t)j * D * D, 0, 0, scr, gw, ngw, lane, off);
        convert_matrix(P.ffn_w1 + (size_t)j * D * FFN, D, FFN, (f16*)(P.ws + WS_FW13) + (size_t)j * 2 * FFN * D, 1, 0, scr, gw, ngw, lane, off);
        convert_matrix(P.ffn_w3 + (size_t)j * D * FFN, D, FFN, (f16*)(P.ws + WS_FW13) + (size_t)j * 2 * FFN * D, 1, 1, scr, gw, ngw, lane, off);
        convert_matrix(P.ffn_w2 + (size_t)j * FFN * D, FFN, D, (f16*)(P.ws + WS_FW2) + (size_t)j * D * FFN, 0, 0, scr, gw, ngw, lane, off);
        convert_matrix(P.o_w_in + (size_t)j * D * ODD_IN, D, ODD_IN, (f16*)(P.ws + WS_OWIN) + (size_t)j * ODD_IN * D, 2, 0, scr, gw, ngw, lane, off);
        convert_matrix(P.o_w_out + (size_t)j * 2048 * D, 2048, D, (f16*)(P.ws + WS_OWOUT) + (size_t)j * D * 2048, 0, 0, scr, gw, ngw, lane, off);
    }
}
__device__ __forceinline__ void convert_tile_plain(const float* W, int K, int N, f16* WT, LAS unsigned char* scr, int item, int lane) {
    const int nblk = N / 64, kb = item / nblk, nb = item % nblk, k0 = 64 * kb, n0 = 64 * nb, li = lane & 15, g = lane >> 4;
    const float* src = W + (size_t)(k0 + g) * N + n0 + 4 * li;
    f32x4 r[16];
#pragma unroll
    for (int i = 0; i < 16; ++i) r[i] = *(const f32x4*)(src + (size_t)(4 * i) * N);
#pragma unroll
    for (int i = 0; i < 16; ++i) { f16x4 hv; hv[0] = (f16)r[i][0]; hv[1] = (f16)r[i][1]; hv[2] = (f16)r[i][2]; hv[3] = (f16)r[i][3]; *(LAS f16x4*)(scr + (4 * i + g) * CV_P + li * 8) = hv; }
#pragma unroll
    for (int nq = 0; nq < 4; ++nq)
#pragma unroll
        for (int ko = 0; ko < 2; ++ko) { LAS unsigned char* p = scr + (32 * ko + 8 * g + (li >> 2)) * CV_P + (16 * nq + 4 * (li & 3)) * 2;
            const f16x8 o = __builtin_shufflevector(tr_read_cv(p), tr_read_cv(p + 4 * CV_P), 0, 1, 2, 3, 4, 5, 6, 7);
            *(f16x8*)(WT + (size_t)(n0 + 16 * nq + li) * K + k0 + 32 * ko + 8 * g) = o; }
}
__device__ __forceinline__ void convert_tile_il(const float* W, int K, int N, f16* WT, int half, LAS unsigned char* scr, int item, int lane) {
    const int nblk = N / 64, kb = item / nblk, nb = item % nblk, k0 = 64 * kb, n0 = 64 * nb, li = lane & 15, g = lane >> 4;
    const float* src = W + (size_t)(k0 + g) * N + n0 + 4 * li;
    f32x4 r[16];
#pragma unroll
    for (int i = 0; i < 16; ++i) r[i] = *(const f32x4*)(src + (size_t)(4 * i) * N);
    const float wscl = half ? 0.6931471805599453f : 1.4426950408889634f;
#pragma unroll
    for (int i = 0; i < 16; ++i) { const f32x4 rv = r[i] * wscl; f16x4 hv; hv[0] = (f16)rv[0]; hv[1] = (f16)rv[1]; hv[2] = (f16)rv[2]; hv[3] = (f16)rv[3]; *(LAS f16x4*)(scr + (4 * i + g) * CV_P + li * 8) = hv; }
#pragma unroll
    for (int nq = 0; nq < 4; ++nq)
#pragma unroll
        for (int ko = 0; ko < 2; ++ko) { LAS unsigned char* p = scr + (32 * ko + 8 * g + (li >> 2)) * CV_P + (16 * nq + 4 * (li & 3)) * 2;
            const f16x8 o = __builtin_shufflevector(tr_read_cv(p), tr_read_cv(p + 4 * CV_P), 0, 1, 2, 3, 4, 5, 6, 7);
            const int n = n0 + 16 * nq + li;
            *(f16x8*)(WT + (size_t)((n >> 7) * 256 + half * 128 + (n & 127)) * K + k0 + 32 * ko + 8 * g) = o; }
}
constexpr int W13_TILES = (D / 64) * (EDIM / 64);
constexpr int W13_PRO = 5632;
__device__ __forceinline__ void bg_convert_w13(const Params& P, int j, int a, int b, int w0, f16* dst, LAS unsigned char* lds, int bid, int nblk) {
    if (bid < w0) return;
    const int nw = nblk - w0;
    const int tidf = tid_fresh(); const int wave = tidf >> 6, lane = tidf & 63;
    LAS unsigned char* scr = lds + wave * 16384;
    for (int gi = a + (bid - w0) * NWAVES + wave; gi < b; gi += nw * NWAVES) {
        const int e = gi / (2 * W13_TILES), r = gi % (2 * W13_TILES), half = r / W13_TILES, it = r % W13_TILES;
        const float* W = (half ? P.moe_w3 : P.moe_w1) + ((size_t)j * NE + e) * D * EDIM;
        convert_tile_il(W, D, EDIM, dst + (size_t)e * 2 * EDIM * D, half, scr, it, lane);
    }
}
constexpr int W2_TILES = (EDIM / 64) * (D / 64);
__device__ __forceinline__ void bg_convert_w2(const Params& P, int j, int a, int b, int heavy, LAS unsigned char* lds, int bid, int nblk) {
    const int w0 = heavy % nblk, nw = nblk - w0;
    if (bid < w0) return;
    const int tidf = tid_fresh(); const int wave = tidf >> 6, lane = tidf & 63;
    LAS unsigned char* scr = lds + wave * 16384;
    for (int gi = a + (bid - w0) * NWAVES + wave; gi < b; gi += nw * NWAVES) {
        const int e = gi / W2_TILES, it = gi % W2_TILES;
        convert_tile_plain(P.moe_w2 + ((size_t)j * NE + e) * D * EDIM, EDIM, D, (f16*)(P.ws + WS_MW2) + (size_t)e * D * EDIM, scr, it, lane);
    }
}
__device__ __forceinline__ void ph_convert_moe(const Params& P, int j, LAS unsigned char* lds, int bid, int nblk, int which = 3) {
    const int tidf = tid_fresh(); const int wave = tidf >> 6, lane = tidf & 63, gw = bid * NWAVES + wave, ngw = nblk * NWAVES;
    LAS unsigned char* scr = lds + wave * 16384; int off = 0;
    for (int e = 0; e < NE; ++e) {
        const size_t wo = ((size_t)j * NE + e) * D * EDIM;
        if (which & 1) {
            convert_matrix(P.moe_w1 + wo, D, EDIM, (f16*)(P.ws + WS_MW13) + (size_t)e * 2 * EDIM * D, 1, 0, scr, gw, ngw, lane, off);
            convert_matrix(P.moe_w3 + wo, D, EDIM, (f16*)(P.ws + WS_MW13) + (size_t)e * 2 * EDIM * D, 1, 1, scr, gw, ngw, lane, off);
        }
        if (which & 2) convert_matrix(P.moe_w2 + wo, EDIM, D, (f16*)(P.ws + WS_MW2) + (size_t)e * D * EDIM, 0, 0, scr, gw, ngw, lane, off);
    }
}

__device__ __forceinline__ void ph_prep0(const Params& P, int bid, int nblk) {
    const int tidf = tid_fresh(); const int wave = tidf >> 6, lane = tidf & 63, gw = bid * NWAVES + wave, ngw = nblk * NWAVES;
    const float* mod = (const float*)(P.ws + WS_MOD);
    f16* X = (f16*)(P.ws + WS_X); f16* H = (f16*)(P.ws + WS_H);
    for (int row0 = gw; row0 < M; row0 += 3 * ngw) {
        f32x4 v[3][4];
#pragma unroll
        for (int i = 0; i < 3; ++i) { const int row = row0 + i * ngw;
            if (row < M) { const float* src = row < TX ? P.x + (size_t)row * D : P.ctx + (size_t)(row - TX) * D;
#pragma unroll
                for (int j = 0; j < 4; ++j) v[i][j] = *(const f32x4*)(src + 4 * lane + 256 * j); } }
#pragma unroll
        for (int i = 0; i < 3; ++i) { const int row = row0 + i * ngw;
            if (row < M) { const float* mv = mod + (size_t)row_vec(row) * 6144;
#pragma unroll
                for (int j = 0; j < 4; ++j) { const int col = 4 * lane + 256 * j; const f32x4 vv = v[i][j];
                    { f16x4 xh; xh[0] = (f16)vv[0]; xh[1] = (f16)vv[1]; xh[2] = (f16)vv[2]; xh[3] = (f16)vv[3]; *(f16x4*)(X + (size_t)row * D + col) = xh; }
                    const f32x4 sh = *(const f32x4*)(mv + col), sc = *(const f32x4*)(mv + D + col);
                    const f32x4 h = vv * (sc + 1.0f) + sh; f16x4 hh; hh[0] = (f16)h[0]; hh[1] = (f16)h[1]; hh[2] = (f16)h[2]; hh[3] = (f16)h[3];
                    *(f16x4*)(H + (size_t)row * D + col) = hh; } } }
    }
}

template <int MODE>
__device__ __forceinline__ void ph_ln(const Params& P, int layer, int which, int bid, int nblk, bool last, LAS unsigned char* lds = nullptr, int mrows = M) {
    const int tidf = tid_fresh(); const int wave = tidf >> 6, lane = tidf & 63, gw = bid * NWAVES + wave, ngw = nblk * NWAVES;
    const float* mod = (const float*)(P.ws + WS_MOD);
    f16* X = (f16*)(P.ws + WS_X); const f16* V = (const f16*)(P.ws + WS_V); f16* H = (f16*)(P.ws + WS_H);
    const float* lg = P.ln_g + ((size_t)layer * 2 + which) * D; const float* lb = P.ln_b + ((size_t)layer * 2 + which) * D;
    const int ml = which == 0 ? layer : layer + 1; const int sh_off = which == 0 ? 3 * D : 0, sc_off = which == 0 ? 4 * D : D;
    const int j = layer >> 1;
    int* route = (int*)(P.ws + WS_ROUTE);
    const f16* Y2p = (const f16*)(P.ws + WS_Y2P);
    LAS unsigned* lcnt = (LAS unsigned*)lds;
    if (MODE == 1) { if (tidf < 16) lcnt[tidf] = 0u; __syncthreads(); }
    const int r_begin = (int)(((long)gw * mrows) / ngw), r_end = (int)(((long)(gw + 1) * mrows) / ngw);
    const bool has_next_mod = !(which == 1 && layer == DEPTH - 1);
    f32x4 pgg[4], pbb[4], psh[4], psc[4], pm5[4]; int curvec = -1;
#pragma unroll
    for (int q = 0; q < 4; ++q) { const int col = 4 * lane + 256 * q; pgg[q] = *(const f32x4*)(lg + col); pbb[q] = *(const f32x4*)(lb + col); }
    for (int row = r_begin; row < r_end; ++row) {
        const int vec = row_vec(row);
        if (vec != curvec) { curvec = vec;
            const float* mv = mod + ((size_t)(has_next_mod ? ml : layer) * 5 + vec) * 6144; const float* m5 = mod + ((size_t)layer * 5 + vec) * 6144 + 5 * D;
#pragma unroll
            for (int q = 0; q < 4; ++q) { const int col = 4 * lane + 256 * q; psh[q] = *(const f32x4*)(mv + sh_off + col); psc[q] = *(const f32x4*)(mv + sc_off + col); if (MODE == 2) pm5[q] = *(const f32x4*)(m5 + col); } }
        f32x4 v[4]; float s = 0.f;
        if (MODE == 2) {
            const int rtv = route[(size_t)row * 8 + (lane & 7)];
            const float g0 = __int_as_float(__shfl(rtv, 2)), g1 = __int_as_float(__shfl(rtv, 3)); const int p0 = __shfl(rtv, 6), p1 = __shfl(rtv, 7);
#pragma unroll
            for (int q = 0; q < 4; ++q) { const int col = 4 * lane + 256 * q; const f16x4 xh = *(const f16x4*)(X + (size_t)row * D + col); const f32x4 xs = (f32x4){(float)xh[0], (float)xh[1], (float)xh[2], (float)xh[3]};
                const f16x4 ya = *(const f16x4*)(Y2p + (size_t)p0 * D + col), yb = *(const f16x4*)(Y2p + (size_t)p1 * D + col); const f32x4 mg = pm5[q];
                f32x4 y;
#pragma unroll
                for (int e = 0; e < 4; ++e) y[e] = g0 * (float)ya[e] + g1 * (float)yb[e];
                v[q] = xs * ALPHA + mg * y; }
        } else {
#pragma unroll
            for (int q = 0; q < 4; ++q) { const f16x4 hv = *(const f16x4*)(V + (size_t)row * D + 4 * lane + 256 * q); v[q] = (f32x4){(float)hv[0], (float)hv[1], (float)hv[2], (float)hv[3]}; }
        }
#pragma unroll
        for (int q = 0; q < 4; ++q) s += (v[q][0] + v[q][1]) + (v[q][2] + v[q][3]);
        const float mean = wave_sum(s) * (1.f / D); float s2 = 0.f;
#pragma unroll
        for (int q = 0; q < 4; ++q) { v[q] = v[q] - mean; s2 += (v[q][0] * v[q][0] + v[q][1] * v[q][1]) + (v[q][2] * v[q][2] + v[q][3] * v[q][3]); }
        const float rstd = 1.0f / sqrtf(wave_sum(s2) * (1.f / D) + LN_EPS);
        float lg8[NE];
#pragma unroll
        for (int e = 0; e < NE; ++e) lg8[e] = 0.f;
#pragma unroll
        for (int q = 0; q < 4; ++q) { const int col = 4 * lane + 256 * q;
            const f32x4 gg = pgg[q], bb = pbb[q];
            const f32x4 y = v[q] * rstd * gg + bb;
            if (last) { if (row < TX) *(f32x4*)(P.out + (size_t)row * D + col) = y; }
            else {
                { f16x4 xh; xh[0] = (f16)y[0]; xh[1] = (f16)y[1]; xh[2] = (f16)y[2]; xh[3] = (f16)y[3]; *(f16x4*)(X + (size_t)row * D + col) = xh; }
                const f32x4 sh = psh[q], sc = psc[q];
                const f32x4 h = y * (sc + 1.0f) + sh; f16x4 hh; hh[0] = (f16)h[0]; hh[1] = (f16)h[1]; hh[2] = (f16)h[2]; hh[3] = (f16)h[3];
                *(f16x4*)(H + (size_t)row * D + col) = hh;
                if (MODE == 1) {
                    const float* rw = P.router_w + (size_t)j * D * NE + (size_t)col * NE;
#pragma unroll
                    for (int e4 = 0; e4 < 4; ++e4) {
                        const f32x4 w0 = *(const f32x4*)(rw + e4 * NE), w1 = *(const f32x4*)(rw + e4 * NE + 4);
                        lg8[0] += h[e4] * w0[0]; lg8[1] += h[e4] * w0[1]; lg8[2] += h[e4] * w0[2]; lg8[3] += h[e4] * w0[3];
                        lg8[4] += h[e4] * w1[0]; lg8[5] += h[e4] * w1[1]; lg8[6] += h[e4] * w1[2]; lg8[7] += h[e4] * w1[3];
                    }
                }
            }
        }
        if (MODE == 1) {
#pragma unroll
            for (int e = 0; e < NE; ++e) lg8[e] = wave_sum(lg8[e]) + P.router_b[j * NE + e];
            int e0 = 0; float v0 = lg8[0];
#pragma unroll
            for (int e = 1; e < NE; ++e) if (lg8[e] > v0) { v0 = lg8[e]; e0 = e; }
            int e1 = -1; float v1 = -3.0e38f;
#pragma unroll
            for (int e = 0; e < NE; ++e) if (e != e0 && lg8[e] > v1) { v1 = lg8[e]; e1 = e; }
            const float ex = __expf(v1 - v0), g0 = 1.0f / (1.0f + ex), g1 = ex / (1.0f + ex);
            if (lane == 0) {
                const int s0 = (int)__hip_atomic_fetch_add(lcnt + e0, 1u, __ATOMIC_RELAXED, __HIP_MEMORY_SCOPE_WORKGROUP), s1 = (int)__hip_atomic_fetch_add(lcnt + e1, 1u, __ATOMIC_RELAXED, __HIP_MEMORY_SCOPE_WORKGROUP);
                int* rt = route + (size_t)row * 8; rt[0] = e0; rt[1] = e1; rt[2] = __float_as_int(g0); rt[3] = __float_as_int(g1); rt[4] = s0; rt[5] = s1;
            }
        }
    }
    if (MODE == 1) {
        __syncthreads();
        if (tidf < NE) { unsigned* cnt = (unsigned*)(P.ws + WS_CTL) + CW_CNT + 64 * j; lcnt[8 + tidf] = atomicAdd(cnt + tidf, lcnt[tidf]); }
        __syncthreads();
        { const int row = r_begin + lane; if (row < r_end) { int* rt = route + (size_t)row * 8; const int e0 = rt[0], e1 = rt[1]; rt[4] += (int)lcnt[8 + e0]; rt[5] += (int)lcnt[8 + e1]; } }
        if (lane == 0) for (int row = r_begin + 64; row < r_end; ++row) { int* rt = route + (size_t)row * 8; const int e0 = rt[0], e1 = rt[1]; rt[4] += (int)lcnt[8 + e0]; rt[5] += (int)lcnt[8 + e1]; }
    }
}

__device__ __forceinline__ void ph_moe_gather(const Params& P, int j, int bid, int nblk, int mrows) {
    const int tidf = tid_fresh(); const int wave = tidf >> 6, lane = tidf & 63, gw = bid * NWAVES + wave, ngw = nblk * NWAVES;
    const unsigned* cnt = (const unsigned*)(P.ws + WS_CTL) + CW_CNT + 64 * j;
    int off[NE], pad[NE]; int acc = 0;
#pragma unroll
    for (int e = 0; e < NE; ++e) { off[e] = acc; const int c = (int)__hip_atomic_load(cnt + e, __ATOMIC_RELAXED, __HIP_MEMORY_SCOPE_AGENT); pad[e] = ((c + 255) >> 8) << 8; acc += pad[e]; }
    int* tilex = (int*)(P.ws + WS_TILEX);
    if (bid == 0 && tidf < 256) {
        const int t = tidf;
        if (t == 255) tilex[255] = acc >> 8;
        else if (t < MOE_TILES) { int ex = 0;
#pragma unroll
            for (int e = 0; e < NE; ++e) if (t * 256 >= off[e] && t * 256 < off[e] + pad[e]) ex = e;
            tilex[t] = ex; }
    }
    int* route = (int*)(P.ws + WS_ROUTE);
    const f16* H = (const f16*)(P.ws + WS_H); f16* Xp = (f16*)(P.ws + WS_XP);
    for (int row = gw; row < mrows; row += ngw) {
        int* rt = route + (size_t)row * 8;
        const int rtv = rt[lane & 7];
        const int e0 = __shfl(rtv, 0), e1 = __shfl(rtv, 1), s0 = __shfl(rtv, 4), s1 = __shfl(rtv, 5);
        int o0 = 0, o1 = 0;
#pragma unroll
        for (int e = 0; e < NE; ++e) { if (e == e0) o0 = off[e]; if (e == e1) o1 = off[e]; }
        const int p0 = o0 + s0, p1 = o1 + s1;
        if (lane == 0) { rt[6] = p0; rt[7] = p1; }
        const u32x4* src = (const u32x4*)(H + (size_t)row * D);
        const u32x4 a = src[lane], b = src[lane + 64];
        u32x4* d0 = (u32x4*)(Xp + (size_t)p0 * D); u32x4* d1 = (u32x4*)(Xp + (size_t)p1 * D);
        d0[lane] = a; d0[lane + 64] = b; d1[lane] = a; d1[lane + 64] = b;
    }
}

__device__ __forceinline__ void ph_rope_table(const Params& P, int bid, int nblk) {
    float* T = (float*)(P.ws + WS_ROPET);
    for (int idx = bid * NTHREADS + tid_fresh(); idx < 64 * 64; idx += nblk * NTHREADS) {
        const int pos = idx >> 6, i = idx & 63;
        const float inv = exp2f(-(float)i * (13.287712379549449f / 64.0f));
        float sn, cs; sincosf((float)pos * inv, &sn, &cs);
        T[2 * idx] = cs; T[2 * idx + 1] = sn;
    }
}
__device__ __forceinline__ f16x4 tr_read(LAS unsigned char* p) { const s16x4 v = __builtin_amdgcn_ds_read_tr16_b64_v4i16((LAS s16x4*)p); return __builtin_bit_cast(f16x4, v); }
__device__ __forceinline__ f16x8 cat8(const f16x4 a, const f16x4 b) { return __builtin_shufflevector(a, b, 0, 1, 2, 3, 4, 5, 6, 7); }
constexpr int RC = 64, RNCH = (CL + SEQ) / RC;
constexpr int SC = 32, SNCH = (CL + SEQ) / SC;
__device__ __forceinline__ int chunk_row0(int b, int c) { return c < CL / RC ? TX + b * CL + c * RC : b * SEQ + (c - CL / RC) * RC; }
__device__ __forceinline__ int schunk_row0(int b, int c) { return c < CL / SC ? TX + b * CL + c * SC : b * SEQ + (c - CL / SC) * SC; }

__device__ __forceinline__ void ph_ret_pm(const Params& P, int j, int bid, int nblk) {
    const int tidf = tid_fresh(); const int wave = tidf >> 6, lane = tidf & 63, gw = bid * NWAVES + wave, ngw = nblk * NWAVES;
    const int li = lane & 15, g = lane >> 4;
    const f16* Pb = (const f16*)(P.ws + WS_P); f16* PM = (f16*)(P.ws + WS_PM);
    for (int item = gw; item < 16 * SNCH; item += ngw) {
        const int bh = item / SNCH, c = item % SNCH, b = bh >> 2, h = bh & 3;
        const int row0 = schunk_row0(b, c);
        const float l2f = P.ret_ld[(j * 2 + 0) * 4 + h] * 1.4426950408889634f, l2b = P.ret_ld[(j * 2 + 1) * 4 + h] * 1.4426950408889634f;
        f32x4 acc[2][2];
#pragma unroll
        for (int sb = 0; sb < 2; ++sb)
#pragma unroll
            for (int tb = 0; tb < 2; ++tb) acc[sb][tb] = (f32x4){0.f, 0.f, 0.f, 0.f};
        const f16* kbase = Pb + (size_t)(row0 + li) * ODD_IN + 1024 + h * 256 + 8 * g;
        const f16* qbase = Pb + (size_t)(row0 + li) * ODD_IN + h * 256 + 8 * g;
        f16x8 kf[8][2], qf[8][2];
#pragma unroll
        for (int kk = 0; kk < 8; ++kk)
#pragma unroll
            for (int x = 0; x < 2; ++x) { kf[kk][x] = *(const f16x8*)(kbase + (size_t)(16 * x) * ODD_IN + 32 * kk); qf[kk][x] = *(const f16x8*)(qbase + (size_t)(16 * x) * ODD_IN + 32 * kk); }
#pragma unroll
        for (int kk = 0; kk < 8; ++kk)
#pragma unroll
            for (int sb = 0; sb < 2; ++sb)
#pragma unroll
                for (int tb = 0; tb < 2; ++tb) acc[sb][tb] = __builtin_amdgcn_mfma_f32_16x16x32_f16(kf[kk][sb], qf[kk][tb], acc[sb][tb], 0, 0, 0);
        f16* out = PM + (size_t)item * SC * SC;
#pragma unroll
        for (int sb = 0; sb < 2; ++sb)
#pragma unroll
            for (int tb = 0; tb < 2; ++tb) { const int t = 16 * tb + li; f16x4 o;
#pragma unroll
                for (int r = 0; r < 4; ++r) { const int sidx = 16 * sb + 4 * g + r; const int df = t - sidx;
                    const float w = df == 0 ? 2.0f : (df > 0 ? exp2f((float)df * l2f) : exp2f((float)(-df) * l2b));
                    o[r] = (f16)(acc[sb][tb][r] * w); }
                *(f16x4*)(out + (size_t)t * SC + 16 * sb + 4 * g) = o; }
    }
}

constexpr int RS_PP = 1024, RS_VG = 1088;
constexpr int RS_Q = 0, RS_K = 16 * RS_PP, RS_V = 32 * RS_PP, RS_BUF = RS_V + 4 * RS_VG;
__device__ __forceinline__ void ph_ret_scan(const Params& P, int j, LAS unsigned char* lds, int bid, int nblk) {
    const int tid = tid_fresh(); const int wave = __builtin_amdgcn_readfirstlane(tid >> 6), lane = tid & 63, li = lane & 15, g = lane >> 4;
    const bool producer = wave >= 4; const int vb = wave & 3, pw = wave & 3;
    const f16* Pb = (const f16*)(P.ws + WS_P); f16* OD = (f16*)(P.ws + WS_OD);
    for (int it0 = bid; it0 < 256; it0 += nblk) {
        const int item = (nblk == 256) ? ((it0 & 7) * 32 + (it0 >> 3)) : it0;
        const int vs = item & 7, dir = (item >> 3) & 1, h = (item >> 4) & 3, b = item >> 6;
        const float l2 = P.ret_ld[(j * 2 + dir) * 4 + h] * 1.4426950408889634f;
        const float g32 = exp2f(32.0f * l2);
        f32x4 S[16];
#pragma unroll
        for (int x = 0; x < 16; ++x) S[x] = (f32x4){0.f, 0.f, 0.f, 0.f};
        f16x8 wv;
#pragma unroll
        for (int e = 0; e < 8; ++e) { const int sI = 8 * g + e; wv[e] = (f16)exp2f((float)(dir ? sI : 31 - sI) * l2); }
        auto chunk_of = [&](int ci) { return dir == 0 ? ci : (ci < 8 ? 7 - ci : 8 + (127 - (ci - 8))); };
        auto issue = [&](int ci) {
            const int row0 = schunk_row0(b, chunk_of(ci));
            LAS unsigned char* base = lds + (ci & 3) * RS_BUF;
#pragma unroll
            for (int x = 0; x < 4; ++x) { const int pr = 4 * pw + x; const f16* rowp = Pb + (size_t)(row0 + 2 * pr + (lane >> 5)) * ODD_IN + h * 256;
                const int rowi = 2 * pr + (lane >> 5);
                __builtin_amdgcn_global_load_lds((const unsigned*)(rowp + (((lane & 31) ^ (rowi & 15)) * 8)), (LAS unsigned*)(base + RS_Q + pr * RS_PP), 16, 0, 0);
                __builtin_amdgcn_global_load_lds((const unsigned*)(rowp + 1024 + (((lane & 31) ^ (4 * (rowi & 3))) * 8)), (LAS unsigned*)(base + RS_K + pr * RS_PP), 16, 0, 0); }
            __builtin_amdgcn_global_load_lds((const unsigned*)(Pb + (size_t)(row0 + 8 * pw + (lane >> 3)) * ODD_IN + 2048 + h * 512 + vs * 64 + (lane & 7) * 8), (LAS unsigned*)(base + RS_V + pw * RS_VG), 16, 0, 0);
        };
        asm volatile("s_waitcnt vmcnt(0) lgkmcnt(0)" ::: "memory"); __builtin_amdgcn_s_barrier(); asm volatile("" ::: "memory");
        if (producer) { issue(0); issue(1); issue(2); asm volatile("s_waitcnt vmcnt(18)" ::: "memory"); }
        if (producer) {
            for (int ci = 0; ci < SNCH; ++ci) {
                asm volatile("" ::: "memory"); __builtin_amdgcn_s_barrier(); asm volatile("" ::: "memory");
                if (ci + 3 < SNCH) { issue(ci + 3); asm volatile("s_waitcnt vmcnt(18)" ::: "memory"); }
                else if (ci + 2 < SNCH) asm volatile("s_waitcnt vmcnt(9)" ::: "memory");
                else asm volatile("s_waitcnt vmcnt(0)" ::: "memory");
            }
        } else {
            for (int ci = 0; ci < SNCH; ++ci) {
                asm volatile("" ::: "memory"); __builtin_amdgcn_s_barrier(); asm volatile("" ::: "memory");
                LAS unsigned char* base = lds + (ci & 3) * RS_BUF;
                const int row0 = schunk_row0(b, chunk_of(ci));
                f16x8 qfr[8][2];
#pragma unroll
                for (int kk = 0; kk < 8; ++kk)
#pragma unroll
                    for (int tb = 0; tb < 2; ++tb) { const int t = 16 * tb + li;
                        qfr[kk][tb] = *(LAS f16x8*)(base + RS_Q + t * 512 + (((4 * kk + g) ^ (t & 15)) * 16)); }
                const int sr = 8 * g + (li >> 2);
                LAS unsigned char* vp = base + RS_V + (sr >> 3) * RS_VG + (sr & 7) * 128 + (vb * 16 + 4 * (li & 3)) * 2;
                f16x8 vf = cat8(tr_read(vp), tr_read(vp + 4 * 128));
                __builtin_amdgcn_sched_barrier(0);
                f32x4 o[2];
                o[0] = (f32x4){0.f, 0.f, 0.f, 0.f}; o[1] = (f32x4){0.f, 0.f, 0.f, 0.f};
#pragma unroll
                for (int kk = 0; kk < 8; ++kk) {
                    f16x8 sf;
#pragma unroll
                    for (int r = 0; r < 4; ++r) { sf[r] = (f16)S[2 * kk][r]; sf[4 + r] = (f16)S[2 * kk + 1][r]; }
#pragma unroll
                    for (int tb = 0; tb < 2; ++tb) o[tb] = __builtin_amdgcn_mfma_f32_16x16x32_f16(sf, qfr[kk][tb], o[tb], 0, 0, 0);
                }
                LAS unsigned char* kp0 = base + RS_K + sr * 512 + (8 * (li & 3)) * 2;
                const int ksw = sr & 3;
                f16x8 kfr[16];
#pragma unroll
                for (int db = 0; db < 16; ++db) { LAS unsigned char* kp = kp0 + 64 * ((db >> 1) ^ ksw) + 8 * (db & 1); kfr[db] = cat8(tr_read(kp), tr_read(kp + 4 * 512)); }
                __builtin_amdgcn_sched_barrier(0);
#pragma unroll
                for (int tb = 0; tb < 2; ++tb) { const int t = 16 * tb + li; const float sc = exp2f((float)((dir ? 31 - t : t) + 1) * l2);
                    f16x4 ov; ov[0] = (f16)(o[tb][0] * sc); ov[1] = (f16)(o[tb][1] * sc); ov[2] = (f16)(o[tb][2] * sc); ov[3] = (f16)(o[tb][3] * sc);
                    const f16* optr = OD + ((size_t)dir * M + row0 + t) * 2048 + h * 512 + vs * 64 + vb * 16 + 4 * g; const u32x2 od = __builtin_bit_cast(u32x2, ov);
                    asm volatile("global_store_dwordx2 %0, %1, off\n\ts_nop 1" :: "v"(optr), "v"(od) : "memory"); }
                vf = vf * wv;
#pragma unroll
                for (int db = 0; db < 16; ++db) S[db] = __builtin_amdgcn_mfma_f32_16x16x32_f16(kfr[db], vf, S[db] * g32, 0, 0, 0);
                asm volatile("s_waitcnt lgkmcnt(0)" ::: "memory");
            }
        }
    }
    asm volatile("s_waitcnt vmcnt(0) lgkmcnt(0)" ::: "memory"); __syncthreads();
}

constexpr int RF_VP = 1040, RF_PP = 80;
constexpr int RF_V = 0, RF_P = RC * RF_VP, RF_ST = RF_P + RC * RF_PP;
__device__ __forceinline__ void ph_ret_final(const Params& P, LAS unsigned char* lds, int bid, int nblk) {
    const int tid = tid_fresh(); const int wave = __builtin_amdgcn_readfirstlane(tid >> 6), lane = tid & 63, li = lane & 15, g = lane >> 4;
    const f16* Pb = (const f16*)(P.ws + WS_P); const f16* OD = (const f16*)(P.ws + WS_OD); const f16* PM = (const f16*)(P.ws + WS_PM); f16* MIX = (f16*)(P.ws + WS_MIX);
    u32x4 pv[8]; u32x2 pp;
    auto prefetch = [&](int item) {
        const int bh = item / RNCH, c = item % RNCH, b = bh >> 2, h = bh & 3; const int row0 = chunk_row0(b, c);
#pragma unroll
        for (int x = 0; x < 8; ++x) { const int p = tid + 512 * x; pv[x] = *(const u32x4*)(Pb + (size_t)(row0 + (p >> 6)) * ODD_IN + 2048 + h * 512 + (p & 63) * 8); }
        pp = *(const u32x2*)(PM + ((size_t)(bh * SNCH + 2 * c) * SC + (tid >> 3)) * SC + (tid & 7) * 4);
    };
    if (bid < 16 * RNCH) prefetch(bid);
    for (int item = bid; item < 16 * RNCH; item += nblk) {
        const int bh = item / RNCH, c = item % RNCH, b = bh >> 2, h = bh & 3;
        const int row0 = chunk_row0(b, c);
        LDS_BARRIER();
#pragma unroll
        for (int x = 0; x < 8; ++x) { const int p = tid + 512 * x; *(LAS u32x4*)(lds + RF_V + (p >> 6) * RF_VP + (p & 63) * 16) = pv[x]; }
        *(LAS u32x2*)(lds + RF_P + (tid >> 3) * RF_PP + (tid & 7) * 8) = pp;
        f16x8 oda[4][2], odb[4][2];
#pragma unroll
        for (int tb = 0; tb < 4; ++tb) { const size_t rr = (size_t)(row0 + 16 * tb + li) * 2048 + h * 512 + 64 * wave + 16 * g;
            oda[tb][0] = *(const f16x8*)(OD + rr); oda[tb][1] = *(const f16x8*)(OD + rr + 8); odb[tb][0] = *(const f16x8*)(OD + (size_t)M * 2048 + rr); odb[tb][1] = *(const f16x8*)(OD + (size_t)M * 2048 + rr + 8); }
        if (item + nblk < 16 * RNCH) prefetch(item + nblk);
        LDS_BARRIER();
        f32x4 acc[4][4];
        {
            f16x8 pf[4];
#pragma unroll
            for (int tb = 0; tb < 4; ++tb) pf[tb] = *(LAS f16x8*)(lds + RF_P + (16 * tb + li) * RF_PP + (8 * g) * 2);
#pragma unroll
            for (int vb = 0; vb < 4; ++vb) {
#pragma unroll
                for (int hf = 0; hf < 2; ++hf) {
                    LAS unsigned char* vp = lds + RF_V + (32 * hf + 8 * g + (li >> 2)) * RF_VP + (64 * wave + 16 * (li & 3) + 4 * vb) * 2;
                    const f16x8 vf = cat8(tr_read(vp), tr_read(vp + 4 * RF_VP));
#pragma unroll
                    for (int t2 = 0; t2 < 2; ++t2) acc[vb][2 * hf + t2] = __builtin_amdgcn_mfma_f32_16x16x32_f16(vf, pf[2 * hf + t2], (f32x4){0.f, 0.f, 0.f, 0.f}, 0, 0, 0);
                }
            }
        }
        float sum[4];
#pragma unroll
        for (int tb = 0; tb < 4; ++tb) { sum[tb] = 0.f;
            const f16x8 a0 = oda[tb][0], a1 = oda[tb][1], b0 = odb[tb][0], b1 = odb[tb][1];
#pragma unroll
            for (int vb = 0; vb < 4; ++vb)
#pragma unroll
                for (int r = 0; r < 4; ++r) { const int e = 4 * (vb & 1) + r; acc[vb][tb][r] += vb < 2 ? (float)a0[e] + (float)b0[e] : (float)a1[e] + (float)b1[e]; sum[tb] += acc[vb][tb][r]; } }
        LAS float* st = (LAS float*)(lds + RF_ST);
#pragma unroll
        for (int tb = 0; tb < 4; ++tb) { sum[tb] += __shfl_xor(sum[tb], 16); sum[tb] += __shfl_xor(sum[tb], 32); if (g == 0) st[(16 * tb + li) * 8 + wave] = sum[tb]; }
        LDS_BARRIER();
        float mean[4], var[4];
#pragma unroll
        for (int tb = 0; tb < 4; ++tb) { const f32x4 s0 = *(const LAS f32x4*)(st + (16 * tb + li) * 8), s1 = *(const LAS f32x4*)(st + (16 * tb + li) * 8 + 4);
            mean[tb] = ((s0[0] + s0[1]) + (s0[2] + s0[3]) + (s1[0] + s1[1]) + (s1[2] + s1[3])) * (1.f / 512.f); var[tb] = 0.f;
#pragma unroll
            for (int vb = 0; vb < 4; ++vb)
#pragma unroll
                for (int r = 0; r < 4; ++r) { acc[vb][tb][r] -= mean[tb]; var[tb] += acc[vb][tb][r] * acc[vb][tb][r]; } }
        LDS_BARRIER();
#pragma unroll
        for (int tb = 0; tb < 4; ++tb) { var[tb] += __shfl_xor(var[tb], 16); var[tb] += __shfl_xor(var[tb], 32); if (g == 0) st[(16 * tb + li) * 8 + wave] = var[tb]; }
        LDS_BARRIER();
#pragma unroll
        for (int tb = 0; tb < 4; ++tb) { const f32x4 s0 = *(const LAS f32x4*)(st + (16 * tb + li) * 8), s1 = *(const LAS f32x4*)(st + (16 * tb + li) * 8 + 4);
            const float vv = ((s0[0] + s0[1]) + (s0[2] + s0[3]) + (s1[0] + s1[1]) + (s1[2] + s1[3])) * (1.f / 512.f);
            const float rstd = 1.0f / sqrtf(vv + LN_EPS);
            const size_t prow = (size_t)(row0 + 16 * tb + li);
            { const int col = h * 512 + 64 * wave + 16 * g;
              const f16x8 g0 = *(const f16x8*)(Pb + prow * ODD_IN + 4096 + col), g1 = *(const f16x8*)(Pb + prow * ODD_IN + 4096 + col + 8); f16x8 o0, o1;
#pragma unroll
              for (int vb = 0; vb < 4; ++vb)
#pragma unroll
                  for (int r = 0; r < 4; ++r) { const int e = 4 * (vb & 1) + r; const float gq = vb < 2 ? (float)g0[e] : (float)g1[e]; const f16 y = (f16)(acc[vb][tb][r] * rstd * silu_f(gq)); if (vb < 2) o0[e] = y; else o1[e] = y; }
              *(f16x8*)(MIX + prow * 2048 + col) = o0; *(f16x8*)(MIX + prow * 2048 + col + 8) = o1; } }
    }
    __syncthreads();
}

constexpr int HC = 32, HNSEG = 16, HP = 272;
__device__ __forceinline__ int hseg_c0(int s) { return (17 * s) >> 1; }
constexpr int H_QB = 0, H_KB = HC * HP, H_Q16 = 2 * HC * HP, H_KE = 3 * HC * HP, H_V = 4 * HC * HP, H_GC = 5 * HC * HP, H_TOT = H_GC + 512;
__device__ __forceinline__ int hchunk_row0(int b, int dir, int p) { return p < 8 ? TX + b * CL + HC * (dir ? 7 - p : p) : b * SEQ + HC * (dir ? 135 - p : p - 8); }

__device__ __forceinline__ void ph_hgrn_local(const Params& P, int j, LAS unsigned char* lds, int bid, int nblk) {
    const int tid = tid_fresh(); const int wave = __builtin_amdgcn_readfirstlane(tid >> 6), lane = tid & 63, li = lane & 15, g = lane >> 4;
    const f16* Pb = (const f16*)(P.ws + WS_P); f16* OD = (f16*)(P.ws + WS_OD); f16* QD = (f16*)(P.ws + WS_HQD);
    float* UT = (float*)(P.ws + WS_HUT); float* GT = (float*)(P.ws + WS_HGT);
    for (int item = bid; item < 32 * HNSEG; item += nblk) {
        const int sidx = (item + (item >> 8)) & 15, bhd = item >> 4, dir = bhd & 1, h = (bhd >> 1) & 3, b = bhd >> 3;
        const int p0 = hseg_c0(sidx), nch = hseg_c0(sidx + 1) - p0; const int it = bhd * HNSEG + sidx;
        float lbv[2];
#pragma unroll
        for (int e = 0; e < 2; ++e) { const int cidx = h * 128 + 2 * lane + e;
            if (j == 0) lbv[e] = 0.f; else { const float l0 = P.hg_lb[(dir * 2 + 0) * 512 + cidx], l1 = P.hg_lb[(dir * 2 + 1) * 512 + cidx]; lbv[e] = 1.0f / (1.0f + __expf(l0 - l1)); } }
        float eseg[2] = {1.f, 1.f};
        f32x4 S[8];
#pragma unroll
        for (int x = 0; x < 8; ++x) S[x] = (f32x4){0.f, 0.f, 0.f, 0.f};
        f16x2 zc[4], qc[4]; u32x4 vc;
        auto load_chunk = [&](int cc) {
            const int row0 = hchunk_row0(b, dir, p0 + cc);
#pragma unroll
            for (int xs = 0; xs < 4; ++xs) { const int x = dir ? 3 - xs : xs; const f16* pr = Pb + (size_t)(row0 + 4 * wave + x) * EVEN_IN + h * 128 + 2 * lane;
                zc[xs] = *(const f16x2*)(pr + 2048 + dir * 512); qc[xs] = *(const f16x2*)(pr + 1536); }
            vc = *(const u32x4*)(Pb + (size_t)(row0 + (tid >> 4)) * EVEN_IN + 3072 + h * 128 + (tid & 15) * 8);
        };
        load_chunk(0);
        for (int cc = 0; cc < nch; ++cc) {
            const int row0 = hchunk_row0(b, dir, p0 + cc);
            LDS_BARRIER();
            *(LAS u32x4*)(lds + H_V + (tid >> 4) * HP + (tid & 15) * 16) = vc;
            float lc[4][2], kv[4][2], qv[4][2]; float run[2] = {0.f, 0.f};
#pragma unroll
            for (int xs = 0; xs < 4; ++xs) { const f16x2 z2 = zc[xs], q2 = qc[xs];
#pragma unroll
                for (int e = 0; e < 2; ++e) { const float z = (float)z2[e]; const float sg = __builtin_amdgcn_rcpf(1.0f + __expf(-z)); const float f = lbv[e] + (1.0f - lbv[e]) * sg;
                    run[e] += __logf(f); lc[xs][e] = run[e]; kv[xs][e] = (1.0f - lbv[e]) * (1.0f - sg); qv[xs][e] = silu_f((float)q2[e]); } }
            *(LAS f32x2*)(lds + H_TOT + (wave * 128 + 2 * lane) * 4) = (f32x2){run[0], run[1]};
            if (cc + 1 < nch) load_chunk(cc + 1);
            LDS_BARRIER();
            float offs[2] = {0.f, 0.f}, cl[2] = {0.f, 0.f};
#pragma unroll
            for (int gq = 0; gq < 8; ++gq) { const f32x2 t2 = *(const LAS f32x2*)(lds + H_TOT + (gq * 128 + 2 * lane) * 4); const bool before = dir ? (gq > wave) : (gq < wave);
                cl[0] += t2[0]; cl[1] += t2[1]; if (before) { offs[0] += t2[0]; offs[1] += t2[1]; } }
            const float gc0 = __expf(cl[0]), gc1 = __expf(cl[1]);
#pragma unroll
            for (int xs = 0; xs < 4; ++xs) { const int x = dir ? 3 - xs : xs; const int i = 4 * wave + x;
                float qs[2], ks[2], ke[2], qd[2];
#pragma unroll
                for (int e = 0; e < 2; ++e) { const float cum = offs[e] + lc[xs][e]; const float cumc = fmaxf(cum, -80.0f); const float e1 = __expf(cumc);
                    qs[e] = qv[xs][e] * e1; ks[e] = kv[xs][e] * __expf(-cumc); ke[e] = kv[xs][e] * __expf(cl[e] - cum); qd[e] = qs[e] * eseg[e]; }
                bf16x2 qb, kb; qb[0] = (__bf16)qs[0]; qb[1] = (__bf16)qs[1]; kb[0] = (__bf16)ks[0]; kb[1] = (__bf16)ks[1];
                f16x2 q16, k16, qd16; q16[0] = (f16)qs[0]; q16[1] = (f16)qs[1]; k16[0] = (f16)ke[0]; k16[1] = (f16)ke[1]; qd16[0] = (f16)qd[0]; qd16[1] = (f16)qd[1];
                *(LAS bf16x2*)(lds + H_QB + i * HP + lane * 4) = qb; *(LAS bf16x2*)(lds + H_KB + i * HP + lane * 4) = kb;
                *(LAS f16x2*)(lds + H_Q16 + i * HP + lane * 4) = q16; *(LAS f16x2*)(lds + H_KE + i * HP + lane * 4) = k16;
                *(f16x2*)(QD + ((size_t)dir * M + row0 + i) * 512 + h * 128 + 2 * lane) = qd16; }
            if (wave == 0) *(LAS f32x2*)(lds + H_GC + lane * 8) = (f32x2){gc0, gc1};
            eseg[0] *= gc0; eseg[1] *= gc1;
            LDS_BARRIER();
            bf16x8 kf[2][4], qf[2][4];
#pragma unroll
            for (int kk = 0; kk < 4; ++kk)
#pragma unroll
                for (int x = 0; x < 2; ++x) { kf[x][kk] = *(const LAS bf16x8*)(lds + H_KB + (16 * x + li) * HP + (32 * kk + 8 * g) * 2); qf[x][kk] = *(const LAS bf16x8*)(lds + H_QB + (16 * x + li) * HP + (32 * kk + 8 * g) * 2); }
            __builtin_amdgcn_sched_barrier(0);
            f32x4 at[2][2];
#pragma unroll
            for (int sb = 0; sb < 2; ++sb)
#pragma unroll
                for (int tb = 0; tb < 2; ++tb) at[sb][tb] = (f32x4){0.f, 0.f, 0.f, 0.f};
#pragma unroll
            for (int kk = 0; kk < 4; ++kk)
#pragma unroll
                for (int sb = 0; sb < 2; ++sb)
#pragma unroll
                    for (int tb = 0; tb < 2; ++tb) at[sb][tb] = __builtin_amdgcn_mfma_f32_16x16x32_bf16(kf[sb][kk], qf[tb][kk], at[sb][tb], 0, 0, 0);
            f16x8 vfp, vfn, af[2][4], kef[8]; f32x4 gcv[8];
            { LAS unsigned char* vp = lds + H_V + (4 * g + (li >> 2)) * HP + (16 * wave + 4 * (li & 3)) * 2; vfp = cat8(tr_read(vp), tr_read(vp + 16 * HP));
              LAS unsigned char* vp2 = lds + H_V + (8 * g + (li >> 2)) * HP + (16 * wave + 4 * (li & 3)) * 2; vfn = cat8(tr_read(vp2), tr_read(vp2 + 4 * HP)); }
#pragma unroll
            for (int kk = 0; kk < 4; ++kk)
#pragma unroll
                for (int tb = 0; tb < 2; ++tb) af[tb][kk] = *(const LAS f16x8*)(lds + H_Q16 + (16 * tb + li) * HP + (32 * kk + 8 * g) * 2);
#pragma unroll
            for (int db = 0; db < 8; ++db) { LAS unsigned char* kp = lds + H_KE + (8 * g + (li >> 2)) * HP + (32 * (db >> 1) + 8 * (li & 3) + 4 * (db & 1)) * 2;
                kef[db] = cat8(tr_read(kp), tr_read(kp + 4 * HP)); gcv[db] = *(const LAS f32x4*)(lds + H_GC + (32 * (db >> 1) + 8 * g + 4 * (db & 1)) * 4); }
            __builtin_amdgcn_sched_barrier(0);
            f16x8 pa[2];
#pragma unroll
            for (int tb = 0; tb < 2; ++tb)
#pragma unroll
                for (int sb = 0; sb < 2; ++sb)
#pragma unroll
                    for (int r = 0; r < 4; ++r) { const int si = 16 * sb + 4 * g + r, ti = 16 * tb + li; const bool keep = dir ? (si >= ti) : (si <= ti);
                        pa[tb][4 * sb + r] = (f16)(keep ? at[sb][tb][r] : 0.f); }
            f32x4 o[2];
#pragma unroll
            for (int tb = 0; tb < 2; ++tb) o[tb] = __builtin_amdgcn_mfma_f32_16x16x32_f16(vfp, pa[tb], (f32x4){0.f, 0.f, 0.f, 0.f}, 0, 0, 0);
#pragma unroll
            for (int kk = 0; kk < 4; ++kk) {
                f16x8 sf;
#pragma unroll
                for (int r = 0; r < 4; ++r) { sf[r] = (f16)S[2 * kk][r]; sf[4 + r] = (f16)S[2 * kk + 1][r]; }
#pragma unroll
                for (int tb = 0; tb < 2; ++tb) o[tb] = __builtin_amdgcn_mfma_f32_16x16x32_f16(sf, af[tb][kk], o[tb], 0, 0, 0);
            }
#pragma unroll
            for (int tb = 0; tb < 2; ++tb) { f16x4 ov; ov[0] = (f16)o[tb][0]; ov[1] = (f16)o[tb][1]; ov[2] = (f16)o[tb][2]; ov[3] = (f16)o[tb][3];
                *(f16x4*)(OD + ((size_t)dir * M + row0 + 16 * tb + li) * 512 + h * 128 + 16 * wave + 4 * g) = ov; }
#pragma unroll
            for (int db = 0; db < 8; ++db) S[db] = __builtin_amdgcn_mfma_f32_16x16x32_f16(kef[db], vfn, S[db] * gcv[db], 0, 0, 0);
        }
#pragma unroll
        for (int db = 0; db < 8; ++db) *(f32x4*)(UT + ((size_t)it * 128 + 16 * wave + li) * 128 + 32 * (db >> 1) + 8 * g + 4 * (db & 1)) = S[db];
        if (wave == 0) *(f32x2*)(GT + (size_t)it * 128 + 2 * lane) = (f32x2){eseg[0], eseg[1]};
    }
    __syncthreads();
}
__device__ __forceinline__ void ph_hgrn_carry(const Params& P, int bid, int nblk) {
    const float* UT = (const float*)(P.ws + WS_HUT); const float* GT = (const float*)(P.ws + WS_HGT); f16* ST = (f16*)(P.ws + WS_HST);
    for (int idx = bid * NTHREADS + tid_fresh(); idx < 32 * 128 * 32; idx += nblk * NTHREADS) {
        const int d4 = idx & 31, v = (idx >> 5) & 127, bhd = idx >> 12;
        f32x4 Sv = *(const f32x4*)(UT + ((size_t)(bhd * HNSEG) * 128 + v) * 128 + 4 * d4);
#pragma unroll
        for (int s0 = 1; s0 < HNSEG; s0 += 8) {
            f32x4 Gs[8], Us[8];
#pragma unroll
            for (int x = 0; x < 8; ++x) if (s0 + x < HNSEG) { const size_t it = (size_t)bhd * HNSEG + s0 + x; Gs[x] = *(const f32x4*)(GT + it * 128 + 4 * d4); Us[x] = *(const f32x4*)(UT + (it * 128 + v) * 128 + 4 * d4); }
#pragma unroll
            for (int x = 0; x < 8; ++x) if (s0 + x < HNSEG) { const size_t it = (size_t)bhd * HNSEG + s0 + x;
                f16x4 hv; hv[0] = (f16)Sv[0]; hv[1] = (f16)Sv[1]; hv[2] = (f16)Sv[2]; hv[3] = (f16)Sv[3];
                *(f16x4*)(ST + (it * 128 + v) * 128 + 4 * d4) = hv;
                Sv = Gs[x] * Sv + Us[x]; }
        }
    }
}
constexpr int HF_P = 256;
__device__ __forceinline__ void ph_hgrn_final(const Params& P, int j, LAS unsigned char* lds, int bid, int nblk) {
    const int tid = tid_fresh(); const int wave = __builtin_amdgcn_readfirstlane(tid >> 6), lane = tid & 63, li = lane & 15, g = lane >> 4;
    const f16* Pb = (const f16*)(P.ws + WS_P); const f16* OD = (const f16*)(P.ws + WS_OD); const f16* QD = (const f16*)(P.ws + WS_HQD); const f16* ST = (const f16*)(P.ws + WS_HST);
    f16* MIX = (f16*)(P.ws + WS_MIX); const float* ng = P.hg_norm_g + j * 128;
    for (int item = bid; item < 16 * HNSEG; item += nblk) {
        const int k = item & 15, bh = item >> 4, b = bh >> 2, h = bh & 3;
        const int c0 = hseg_c0(k), ntok = (hseg_c0(k + 1) - c0) * HC;
        const int blockrow0 = k == 0 ? TX + b * CL : b * SEQ + HC * (c0 - 8);
        u32x4 st[2][4]; f16x8 bq[2][4];
        f16x4 oa[8], ob[8], gv[8];
        if (k > 0) {
#pragma unroll
            for (int dir = 0; dir < 2; ++dir) { const int sidx = dir ? 16 - k : k; const size_t it = (size_t)(bh * 2 + dir) * HNSEG + sidx;
#pragma unroll
                for (int x = 0; x < 4; ++x) { const int p = tid + 512 * x; st[dir][x] = *(const u32x4*)(ST + (it * 128 + (p >> 4)) * 128 + (p & 15) * 8); } }
        }
        auto req = [&](int t0) {
            const size_t row = (size_t)(blockrow0 + t0 + li);
            if (k > 0) {
#pragma unroll
                for (int dir = 0; dir < 2; ++dir)
#pragma unroll
                    for (int kk = 0; kk < 4; ++kk) bq[dir][kk] = *(const f16x8*)(QD + ((size_t)dir * M + row) * 512 + h * 128 + 32 * kk + 8 * g); }
#pragma unroll
            for (int vb = 0; vb < 8; ++vb) { oa[vb] = *(const f16x4*)(OD + row * 512 + h * 128 + 32 * g + 4 * vb); ob[vb] = *(const f16x4*)(OD + ((size_t)M + row) * 512 + h * 128 + 32 * g + 4 * vb);
                gv[vb] = *(const f16x4*)(Pb + row * EVEN_IN + 3584 + h * 128 + 32 * g + 4 * vb); }
        };
        int t0 = 16 * wave;
        req(t0);
        __syncthreads();
        if (k > 0) {
#pragma unroll
            for (int dir = 0; dir < 2; ++dir)
#pragma unroll
                for (int x = 0; x < 4; ++x) { const int p = tid + 512 * x, v = p >> 4; *(LAS u32x4*)(lds + (dir * 128 + v) * HF_P + (((p & 15) ^ (4 * ((v >> 5) & 3) + (v & 3))) * 16)) = st[dir][x]; }
        }
        LDS_BARRIER();
        for (;;) {
            const size_t row = (size_t)(blockrow0 + t0 + li);
            f32x4 acc[8];
#pragma unroll
            for (int vb = 0; vb < 8; ++vb) acc[vb] = (f32x4){0.f, 0.f, 0.f, 0.f};
            if (k > 0) {
#pragma unroll
                for (int dir = 0; dir < 2; ++dir)
#pragma unroll
                    for (int kk = 0; kk < 4; ++kk) {
                        f16x8 af[8];
#pragma unroll
                        for (int vb = 0; vb < 8; ++vb) af[vb] = *(LAS f16x8*)(lds + (dir * 128 + 32 * (li >> 2) + 4 * vb + (li & 3)) * HF_P + (((4 * kk + g) ^ li) * 16));
#pragma unroll
                        for (int vb = 0; vb < 8; ++vb) acc[vb] = __builtin_amdgcn_mfma_f32_16x16x32_f16(af[vb], bq[dir][kk], acc[vb], 0, 0, 0);
                    }
            }
            float ss = 0.f;
#pragma unroll
            for (int vb = 0; vb < 8; ++vb) { const f16x4 a = oa[vb], bb = ob[vb];
                acc[vb] = acc[vb] + (f32x4){(float)a[0] + (float)bb[0], (float)a[1] + (float)bb[1], (float)a[2] + (float)bb[2], (float)a[3] + (float)bb[3]};
#pragma unroll
                for (int r = 0; r < 4; ++r) ss += acc[vb][r] * acc[vb][r]; }
            ss += __shfl_xor(ss, 16); ss += __shfl_xor(ss, 32);
            const float rr = 1.0f / sqrtf(ss * (1.f / 128.f) + NORM_EPS);
#pragma unroll
            for (int vb = 0; vb < 8; ++vb) { const int vc = 32 * g + 4 * vb; const f32x4 nv = *(const f32x4*)(ng + vc); f16x4 ov;
#pragma unroll
                for (int r = 0; r < 4; ++r) ov[r] = (f16)(acc[vb][r] * rr * nv[r] * silu_f((float)gv[vb][r]));
                *(f16x4*)(MIX + row * D + 512 + h * 128 + vc) = ov; }
            t0 += 128; if (t0 >= ntok) break;
            req(t0);
        }
    }
    __syncthreads();
}

constexpr int NA_P = 144;
constexpr int NA_CK = 0, NA_CV = 256 * NA_P, NA_BK = 2 * 256 * NA_P, NA_BV = NA_BK + 2 * 64 * NA_P, NA_BT = NA_BV + 2 * 64 * NA_P;
__device__ __forceinline__ void ph_na(const Params& P, int j, LAS unsigned char* lds, int bid, int nblk) {
    const int tid = tid_fresh(); const int wave = __builtin_amdgcn_readfirstlane(tid >> 6), lane = tid & 63, li = lane & 15, g = lane >> 4;
    const int wq = wave & 3, half = wave >> 2;
    const f16* Pb = (const f16*)(P.ws + WS_P); f16* MIX = (f16*)(P.ws + WS_MIX);
    LAS float* btab = (LAS float*)(lds + NA_BT + wave * 1024);
    constexpr int NX = NB * 8 * GW, NITEMS = NX + NB * 8 * (CL / 64);
    const bool xmap = (nblk == 256);
    const int npairs = NITEMS / 2, pstart = xmap ? (bid >> 3) : bid, pstep = xmap ? 32 : nblk, pend = xmap ? 136 : npairs;
    for (int lp = pstart; lp < pend; lp += pstep) {
        const int bhq = xmap ? ((bid & 7) * 4 + lp / 34) : (lp / 34), t0 = 2 * (lp % 34), t = t0 + half;
        const bool isx = t0 < 64;
        const int b = bhq >> 3, h = bhq & 7;
        int qrow, r = 0;
        if (isx) { r = t; qrow = b * SEQ + r * GW + 16 * wq + li; }
        else { qrow = TX + b * CL + 64 * (t - 64) + 16 * wq + li; }
        const int c = 16 * wq + li, cs = min(max(c - 8, 0), 48), rs = min(max(r - 4, 0), 56);
        const int rsA = min(max(t0 - 4, 0), 56), rsB = min(max(t0 + 1 - 4, 0), 56), nrows = isx ? rsB + 8 - rsA : 0;
        const int kc0 = wq == 0 ? 0 : (wq == 1 ? 8 : (wq == 2 ? 24 : 32));
        const float* rpbh = P.na_rpb + ((size_t)j * 8 + h) * 15 * 31;
        u32x4 ck[4], cv[4], bk[9], bv[9];
        { const f16* cb = Pb + (size_t)(TX + b * CL) * EVEN_IN + h * 64;
#pragma unroll
          for (int x = 0; x < 4; ++x) { const int p = tid + 512 * x; const f16* src = cb + (size_t)(p >> 3) * EVEN_IN + (p & 7) * 8; ck[x] = *(const u32x4*)(src + 512); cv[x] = *(const u32x4*)(src + 1024); } }
#pragma unroll
        for (int i = 0; i < 9; ++i) if (i < nrows) { const f16* src = Pb + (size_t)(b * SEQ + (rsA + i) * GW + (tid >> 3)) * EVEN_IN + h * 64 + (tid & 7) * 8; bk[i] = *(const u32x4*)(src + 512); bv[i] = *(const u32x4*)(src + 1024); }
        if (isx) {
#pragma unroll
            for (int x = 0; x < 4; ++x) { const int e = lane + 64 * x, bi = e >> 5, cc = e & 31; btab[e] = cc < 31 ? rpbh[(rs + bi - r + 7) * 31 + cc] : 0.f; }
        }
        f16x8 qf[2];
#pragma unroll
        for (int kk = 0; kk < 2; ++kk) { const f16x8 tq = *(const f16x8*)(Pb + (size_t)qrow * EVEN_IN + h * 64 + 32 * kk + 8 * g);
#pragma unroll
            for (int e = 0; e < 8; ++e) qf[kk][e] = (f16)((float)tq[e] * 0.125f); }
        unsigned vmask = 0u;
        const int bix0 = kc0 + 4 * g - c + 15;
#pragma unroll
        for (int jj = 0; jj < 8; ++jj) { const int mcol = kc0 + (jj < 4 ? 4 * g + jj : 16 + 4 * g + jj - 4); vmask |= ((mcol >= cs) && (mcol < cs + 16)) ? (1u << jj) : 0u; }
        f32x4 O[4];
#pragma unroll
        for (int x = 0; x < 4; ++x) O[x] = (f32x4){0.f, 0.f, 0.f, 0.f};
        float mrun = -1.0e30f, lsum = 0.f;
        auto process = [&](LAS unsigned char* kt, LAS unsigned char* vtl, int krow, int bi) {
            f16x8 kf[2][2], vf[4];
#pragma unroll
            for (int db = 0; db < 2; ++db)
#pragma unroll
                for (int kk = 0; kk < 2; ++kk) kf[db][kk] = *(LAS f16x8*)(kt + (krow + 16 * db + li) * NA_P + (32 * kk + 8 * g) * 2);
#pragma unroll
            for (int dvb = 0; dvb < 4; ++dvb) { LAS unsigned char* vp = vtl + (krow + 4 * g + (li >> 2)) * NA_P + (16 * dvb + 4 * (li & 3)) * 2; vf[dvb] = cat8(tr_read(vp), tr_read(vp + 16 * NA_P)); }
            f32x4 d1 = (f32x4){0.f, 0.f, 0.f, 0.f}, d2 = (f32x4){0.f, 0.f, 0.f, 0.f};
#pragma unroll
            for (int kk = 0; kk < 2; ++kk) { d1 = __builtin_amdgcn_mfma_f32_16x16x32_f16(kf[0][kk], qf[kk], d1, 0, 0, 0); d2 = __builtin_amdgcn_mfma_f32_16x16x32_f16(kf[1][kk], qf[kk], d2, 0, 0, 0); }
            float sc[8];
#pragma unroll
            for (int rr = 0; rr < 4; ++rr) { sc[rr] = d1[rr]; sc[4 + rr] = d2[rr]; }
            if (bi >= 0) {
                const LAS float* brow = btab + bi * 32;
                float bvv[8];
#pragma unroll
                for (int jj = 0; jj < 8; ++jj) bvv[jj] = brow[min(max(bix0 + (jj < 4 ? jj : 12 + jj), 0), 30)];
#pragma unroll
                for (int jj = 0; jj < 8; ++jj) asm volatile("" : "+v"(bvv[jj]));
#pragma unroll
                for (int jj = 0; jj < 8; ++jj) sc[jj] = ((vmask >> jj) & 1) ? sc[jj] + bvv[jj] : -1.0e30f;
            }
            float bm = fmaxf(fmaxf(fmaxf(sc[0], sc[1]), fmaxf(sc[2], sc[3])), fmaxf(fmaxf(sc[4], sc[5]), fmaxf(sc[6], sc[7])));
            bm = fmaxf(bm, __shfl_xor(bm, 16)); bm = fmaxf(bm, __shfl_xor(bm, 32));
            const float mn = fmaxf(mrun, bm), alpha = __expf(mrun - mn);
            float ps = 0.f; f16x8 pf;
#pragma unroll
            for (int jj = 0; jj < 8; ++jj) { const float pv = __expf(sc[jj] - mn); ps += pv; pf[jj] = (f16)pv; }
            lsum = lsum * alpha + ps; mrun = mn;
#pragma unroll
            for (int x = 0; x < 4; ++x) O[x] = O[x] * alpha;
#pragma unroll
            for (int dvb = 0; dvb < 4; ++dvb) O[dvb] = __builtin_amdgcn_mfma_f32_16x16x32_f16(vf[dvb], pf, O[dvb], 0, 0, 0);
        };
        __syncthreads();
#pragma unroll
        for (int x = 0; x < 4; ++x) { const int p = tid + 512 * x; *(LAS u32x4*)(lds + NA_CK + (p >> 3) * NA_P + (p & 7) * 16) = ck[x]; *(LAS u32x4*)(lds + NA_CV + (p >> 3) * NA_P + (p & 7) * 16) = cv[x]; }
        if (nrows > 0) { *(LAS u32x4*)(lds + NA_BK + (tid >> 3) * NA_P + (tid & 7) * 16) = bk[0]; *(LAS u32x4*)(lds + NA_BV + (tid >> 3) * NA_P + (tid & 7) * 16) = bv[0]; }
        LDS_BARRIER();
#pragma unroll
        for (int i = 0; i < 9; ++i) {
            if (i < nrows) {
                const int R = rsA + i; const bool active = R >= rs && R < rs + 8;
                if (active) process(lds + NA_BK + (i & 1) * 64 * NA_P, lds + NA_BV + (i & 1) * 64 * NA_P, kc0, R - rs);
                if (i + 1 < 9 && i + 1 < nrows) { *(LAS u32x4*)(lds + NA_BK + ((i + 1) & 1) * 64 * NA_P + (tid >> 3) * NA_P + (tid & 7) * 16) = bk[i + 1 < 9 ? i + 1 : 8];
                    *(LAS u32x4*)(lds + NA_BV + ((i + 1) & 1) * 64 * NA_P + (tid >> 3) * NA_P + (tid & 7) * 16) = bv[i + 1 < 9 ? i + 1 : 8]; }
                LDS_BARRIER();
            }
        }
#pragma unroll 2
        for (int cbk = 0; cbk < 8; ++cbk) process(lds + NA_CK, lds + NA_CV, 32 * cbk, -1);
        lsum += __shfl_xor(lsum, 16); lsum += __shfl_xor(lsum, 32);
        const float inv = 1.0f / lsum;
#pragma unroll
        for (int dvb = 0; dvb < 4; ++dvb) { f16x4 ov;
#pragma unroll
            for (int rr = 0; rr < 4; ++rr) ov[rr] = (f16)(O[dvb][rr] * inv);
            *(f16x4*)(MIX + (size_t)qrow * D + h * 64 + 16 * dvb + 4 * g) = ov; }
    }
    __syncthreads();
}

#define XB_TMO      128
#define XB_XCNT(j)  (256  + 64 * (j))
#define XB_XSUB(j)  (1280 + 64 * (j))
#define XB_XGEN(j)  (2304 + 64 * (j))
#define XB_TOP      3328
#define XB_TOPGEN   3392
#define XCD_BAR_WORDS 3456
#define XB_SPIN_CAP (1u << 20)
__device__ __forceinline__ unsigned xb_ld(unsigned* p)              { return __hip_atomic_load(p, __ATOMIC_RELAXED, __HIP_MEMORY_SCOPE_AGENT); }
__device__ __forceinline__ unsigned xb_add(unsigned* p, unsigned v) { return __hip_atomic_fetch_add(p, v, __ATOMIC_RELAXED, __HIP_MEMORY_SCOPE_AGENT); }
__device__ __forceinline__ unsigned xb_xcc_id() { return (unsigned)__builtin_amdgcn_s_getreg((3 << 11) | 20) & 0xFu; }
#define XB_SPIN(cond, bar) do { unsigned _sp = 0; while (cond) { __builtin_amdgcn_s_sleep(1); \
    if ((++_sp & 255u) == 0u) { if (xb_ld(&(bar)[XB_TMO])) break; if (_sp > XB_SPIN_CAP) { atomicAdd(&(bar)[XB_TMO], 1u); break; } } } } while (0)
struct XcdBarrier { unsigned* bar; unsigned x; volatile LAS unsigned* st; };
__device__ __forceinline__ XcdBarrier xcd_barrier_post(unsigned* bar, volatile LAS unsigned* st) {
    XcdBarrier b; b.bar = bar; b.x = xb_xcc_id(); b.st = st;
    if (threadIdx.x == 0) (void)xb_add(&bar[XB_XCNT(b.x)], 1u);
    return b;
}
__device__ __forceinline__ void xcd_barrier_complete(unsigned* bar, unsigned x, unsigned& nloc, unsigned& nx) {
    const unsigned G = gridDim.x * gridDim.y * gridDim.z;
    unsigned sum, cnt, mine, sp = 0u;
    for (;;) {
        sum = 0u; cnt = 0u; mine = 0u;
#pragma unroll
        for (unsigned j = 0; j < 16; ++j) { const unsigned c = xb_ld(&bar[XB_XCNT(j)]); sum += c; cnt += (c > 0u) ? 1u : 0u; mine = (j == x) ? c : mine; }
        if (sum == G) break;
        __builtin_amdgcn_s_sleep(1);
        if ((++sp & 255u) == 0u) { if (xb_ld(&bar[XB_TMO])) break; if (sp > XB_SPIN_CAP) { atomicAdd(&bar[XB_TMO], 1u); break; } }
    }
    nloc = mine > 0u ? mine : 1u; nx = cnt > 0u ? cnt : 1u;
}
__device__ __forceinline__ void xcd_barrier(const XcdBarrier& b) {
    asm volatile("s_waitcnt vmcnt(0)" ::: "memory");
    __syncthreads();
    if (threadIdx.x == 0) {
        unsigned* bar = b.bar;
        __builtin_amdgcn_s_waitcnt(0);
        unsigned nloc = b.st[0], nx = b.st[1];
        if (nloc == 0u) { xcd_barrier_complete(bar, b.x, nloc, nx); b.st[0] = nloc; b.st[1] = nx; }
        const unsigned old = xb_add(&bar[XB_XSUB(b.x)], 1u);
        const unsigned gen = old / nloc;
        if (old + 1u == (gen + 1u) * nloc) {
            __builtin_amdgcn_fence(__ATOMIC_RELEASE, "agent");
            asm volatile("s_waitcnt vmcnt(0)" ::: "memory");
            const unsigned og = xb_add(&bar[XB_TOP], 1u);
            const unsigned tg = og / nx;
            if (og + 1u == (tg + 1u) * nx) xb_add(&bar[XB_TOPGEN], 1u);
            else XB_SPIN(xb_ld(&bar[XB_TOPGEN]) == tg, bar);
            __builtin_amdgcn_fence(__ATOMIC_ACQUIRE, "agent");
            xb_add(&bar[XB_XGEN(b.x)], 1u);
            asm volatile("s_waitcnt vmcnt(0)" ::: "memory");
        } else {
            XB_SPIN(xb_ld(&bar[XB_XGEN(b.x)]) == gen, bar);
            __builtin_amdgcn_fence(__ATOMIC_ACQUIRE, "agent");
            asm volatile("s_waitcnt vmcnt(0)" ::: "memory");
        }
    }
    __syncthreads();
}

constexpr int LDS_BYTES = 159744;
constexpr int LDS_MISC = 155648;

__global__ void __launch_bounds__(NTHREADS, 2) mega_fwd(Params P) {
    extern __shared__ __attribute__((aligned(16))) unsigned char lds_raw[];
    LAS unsigned char* lds = (LAS unsigned char*)lds_raw;
    const int bid0 = blockIdx.x, nblk0 = gridDim.x;
    if (threadIdx.x < 64) ((LAS unsigned*)(lds + LDS_MISC))[threadIdx.x] = 0u;
    __syncthreads();
    XcdBarrier bar = xcd_barrier_post((unsigned*)(P.ws + WS_CTL) + CW_BAR, (volatile LAS unsigned*)(lds + LDS_MISC));
#define GRID_BAR() xcd_barrier(bar)

    {
    const int bid = bid0, nblk = nblk0;
    ph_mod(P, lds, bid, nblk);
    ph_rope_table(P, bid, nblk);
    ph_convert_static(P, lds, bid, nblk);
    ph_convert_moe(P, 0, lds, bid, nblk, 1);
    GRID_BAR();
    ph_prep0(P, bid, nblk);
    GRID_BAR();
    }

    for (int jj = 0; jj < 2; ++jj) {
        int bid_l = bid0, nblk_l = nblk0; asm volatile("" : "+s"(bid_l), "+s"(nblk_l));
        const int bid = bid_l, nblk = nblk_l;
        {
            const int layer = 2 * jj, j = jj;
            const float* modl = (const float*)(P.ws + WS_MOD) + (size_t)layer * 5 * 6144;
            {
                pg8::Gemm g{(const f16*)(P.ws + WS_H), (const f16*)(P.ws + WS_EWIN) + (size_t)j * EVEN_IN * D, M, EVEN_IN, D}; pg8::StaticOrder S; S.init(M, EVEN_IN, nblk, bid);
                pg8::EpiF16 E{(f16*)(P.ws + WS_P), EVEN_IN, EVEN_IN / 256};
                pg8::gemm_phase<pg8::EpiF16, pg8::StaticOrder, true, true>(lds, g, S, E);
                bg_convert_w2(P, jj, 0, 3200, ((M / 256) * (EVEN_IN / 256)) % nblk, lds, bid, nblk);
            }
            GRID_BAR();
            ph_na(P, j, lds, bid, nblk);
            ph_hgrn_local(P, j, lds, bid, nblk);
            bg_convert_w13(P, 1, jj == 0 ? 0 : 3400, jj == 0 ? 1400 : 4700, nblk == 256 ? 64 : 0, (f16*)(P.ws + WS_MW13B), lds, bid, nblk);
            GRID_BAR();
            ph_hgrn_carry(P, bid, nblk);
            GRID_BAR();
            ph_hgrn_final(P, j, lds, bid, nblk);
            GRID_BAR();
            {
                pg8::Gemm g{(const f16*)(P.ws + WS_MIX), (const f16*)(P.ws + WS_EWOUT) + (size_t)j * D * D, TX, D, D}; pg8::StaticOrder S; S.init(TX, D, nblk, bid);
                pg8::EpiResid E{(const f16*)(P.ws + WS_X), (f16*)(P.ws + WS_V), modl, 2 * D};
                pg8::gemm_phase<pg8::EpiResid, pg8::StaticOrder, true, true>(lds, g, S, E);
                gemm_ctx64(lds, (const f16*)(P.ws + WS_MIX), (const f16*)(P.ws + WS_EWOUT) + (size_t)j * D * D, D, (const f16*)(P.ws + WS_X), (f16*)(P.ws + WS_V), modl + 4 * 6144 + 2 * D, bid, nblk);
            }
            GRID_BAR();
            ph_ln<0>(P, layer, 0, bid, nblk, false);
            GRID_BAR();
            {
                pg8::Gemm g{(const f16*)(P.ws + WS_H), (const f16*)(P.ws + WS_FW13) + (size_t)j * 2 * FFN * D, M, 2 * FFN, D}; pg8::StaticOrder S; S.init(M, 2 * FFN, nblk, bid);
                pg8::EpiSwiglu E{(f16*)(P.ws + WS_G), FFN, 2 * FFN / 256};
                pg8::gemm_phase<pg8::EpiSwiglu, pg8::StaticOrder, true, true>(lds, g, S, E);
                bg_convert_w2(P, jj, 3200, 3840, ((M / 256) * (2 * FFN / 256)) % nblk, lds, bid, nblk);
            }
            GRID_BAR();
            {
                pg8::Gemm g{(const f16*)(P.ws + WS_G), (const f16*)(P.ws + WS_FW2) + (size_t)j * D * FFN, TX, D, FFN}; pg8::StaticOrder S; S.init(TX, D, nblk, bid);
                pg8::EpiResid E{(const f16*)(P.ws + WS_X), (f16*)(P.ws + WS_V), modl, 5 * D};
                pg8::gemm_phase<pg8::EpiResid, pg8::StaticOrder, true, true>(lds, g, S, E);
                gemm_ctx64(lds, (const f16*)(P.ws + WS_G), (const f16*)(P.ws + WS_FW2) + (size_t)j * D * FFN, FFN, (const f16*)(P.ws + WS_X), (f16*)(P.ws + WS_V), modl + 4 * 6144 + 5 * D, bid, nblk);
            }
            GRID_BAR();
            ph_ln<0>(P, layer, 1, bid, nblk, false);
            GRID_BAR();
        }
        {
            const int layer = 2 * jj + 1, j = jj;
            const bool last = (layer == DEPTH - 1);
            const float* modl = (const float*)(P.ws + WS_MOD) + (size_t)layer * 5 * 6144;
            {
                pg8::Gemm g{(const f16*)(P.ws + WS_H), (const f16*)(P.ws + WS_OWIN) + (size_t)j * ODD_IN * D, M, ODD_IN, D}; pg8::StaticOrder S; S.init(M, ODD_IN, nblk, bid);
                pg8::EpiRope E{(f16*)(P.ws + WS_P), (const float*)(P.ws + WS_ROPET)};
                pg8::gemm_phase<pg8::EpiRope, pg8::StaticOrder, true, true>(lds, g, S, E);
                bg_convert_w2(P, jj, 3840, 6400, ((M / 256) * (ODD_IN / 256)) % nblk, lds, bid, nblk);
            }
            GRID_BAR();
            ph_ret_pm(P, j, bid, nblk);
            ph_ret_scan(P, j, lds, bid, nblk);
            GRID_BAR();
            ph_ret_final(P, lds, bid, nblk);
            bg_convert_w13(P, 1, jj == 0 ? 1400 : 4700, jj == 0 ? 3400 : W13_PRO, nblk == 256 ? 64 : 0, (f16*)(P.ws + WS_MW13B), lds, bid, nblk);
            GRID_BAR();
            {
                pg8::Gemm g{(const f16*)(P.ws + WS_MIX), (const f16*)(P.ws + WS_OWOUT) + (size_t)j * D * 2048, TX, D, 2048}; pg8::StaticOrder S; S.init(TX, D, nblk, bid);
                pg8::EpiResid E{(const f16*)(P.ws + WS_X), (f16*)(P.ws + WS_V), modl, 2 * D};
                pg8::gemm_phase<pg8::EpiResid, pg8::StaticOrder, true, true>(lds, g, S, E);
                if (!last)
                    gemm_ctx64(lds, (const f16*)(P.ws + WS_MIX), (const f16*)(P.ws + WS_OWOUT) + (size_t)j * D * 2048, 2048, (const f16*)(P.ws + WS_X), (f16*)(P.ws + WS_V), modl + 4 * 6144 + 2 * D, bid, nblk);
            }
            GRID_BAR();
            ph_ln<1>(P, layer, 0, bid, nblk, false, lds, last ? TX : M);
            GRID_BAR();
            ph_moe_gather(P, j, bid, nblk, last ? TX : M);
            GRID_BAR();
            {
                const int* tilex = (const int*)(P.ws + WS_TILEX);
                const int ntiles = __builtin_amdgcn_readfirstlane(__hip_atomic_load(tilex + 255, __ATOMIC_RELAXED, __HIP_MEMORY_SCOPE_AGENT));
                pg8::Gemm g{(const f16*)(P.ws + WS_XP), (const f16*)(P.ws + (jj == 0 ? WS_MW13 : WS_MW13B)), MOE_ROWS, NE * 2 * EDIM, D};
                pg8::GroupedOrder S{tilex, ntiles, 2 * EDIM / 256, nblk, bid};
                pg8::EpiSwiglu E{(f16*)(P.ws + WS_GP), EDIM, 2 * EDIM / 256};
                pg8::gemm_phase<pg8::EpiSwiglu, pg8::GroupedOrder, true, true>(lds, g, S, E);
                bg_convert_w2(P, jj, 6400, NE * W2_TILES, (ntiles * (2 * EDIM / 256)) % nblk, lds, bid, nblk);
            }
            GRID_BAR();
            {
                const int* tilex = (const int*)(P.ws + WS_TILEX);
                const int ntiles = __builtin_amdgcn_readfirstlane(__hip_atomic_load(tilex + 255, __ATOMIC_RELAXED, __HIP_MEMORY_SCOPE_AGENT));
                pg8::Gemm g{(const f16*)(P.ws + WS_GP), (const f16*)(P.ws + WS_MW2), MOE_ROWS, NE * D, EDIM};
                pg8::GroupedOrder S{tilex, ntiles, D / 256, nblk, bid};
                pg8::EpiF16 E{(f16*)(P.ws + WS_Y2P), D, D / 256};
                pg8::gemm_phase<pg8::EpiF16, pg8::GroupedOrder, true, true>(lds, g, S, E);
                if (jj == 0) {
                    const int U = ntiles * (D / 256), heavy = U % nblk;
                    const int w0 = heavy, nw = nblk - heavy;
                    __syncthreads();
                    bg_convert_w13(P, 1, W13_PRO, NE * 2 * W13_TILES, w0, (f16*)(P.ws + WS_MW13B), lds, bid, nblk); (void)nw;
                }
            }
            GRID_BAR();
            ph_ln<2>(P, layer, 1, bid, nblk, last, nullptr, last ? TX : M);
            if (!last) GRID_BAR();
        }
    }
}

extern "C" void kernel_launch(void* const* d_in, const int* in_sizes, int n_in, void* d_out, int out_size, void* d_ws, size_t ws_size, hipStream_t stream) {
    static int grid = 0;
    if (grid == 0) {
        if (n_in != 24 || ws_size < WS_END) { fprintf(stderr, "kernel_launch: unexpected n_in %d or ws_size %zu (need %zu)\n", n_in, ws_size, (size_t)WS_END); grid = -1; return; }
        int dev = 0, cus = 0;
        if (hipGetDevice(&dev) != hipSuccess || hipDeviceGetAttribute(&cus, hipDeviceAttributeMultiprocessorCount, dev) != hipSuccess) { grid = -1; return; }
        if (hipFuncSetAttribute((const void*)mega_fwd, hipFuncAttributeMaxDynamicSharedMemorySize, LDS_BYTES) != hipSuccess) { grid = -1; return; }
        int per_cu = 0;
        (void)hipOccupancyMaxActiveBlocksPerMultiprocessor(&per_cu, (const void*)mega_fwd, NTHREADS, LDS_BYTES);
        (void)hipGetLastError();
        grid = cus;
    }
    if (grid < 0) return;
    Params p{};
    const float** pp = (const float**)&p;
    for (int i = 0; i < 24; ++i) pp[i] = (const float*)d_in[i];
    p.out = (float*)d_out; p.ws = (unsigned char*)d_ws;
    (void)hipMemsetAsync((char*)d_ws + WS_CTL, 0, CTL_BYTES, stream);
    hipLaunchKernelGGL(mega_fwd, dim3(grid), dim3(NTHREADS), LDS_BYTES, stream, p);
}
```

```cpp
#include <hip/hip_runtime.h>
#include <cstdio>
#include <cstdint>

#define LAS __attribute__((address_space(3)))
typedef _Float16 f16;
typedef f16 f16x8 __attribute__((ext_vector_type(8)));
typedef f16 f16x4 __attribute__((ext_vector_type(4)));
typedef f16 f16x2 __attribute__((ext_vector_type(2)));
typedef float f32x4 __attribute__((ext_vector_type(4)));
typedef float f32x2 __attribute__((ext_vector_type(2)));
typedef unsigned u32x4 __attribute__((ext_vector_type(4)));
typedef unsigned u32x2 __attribute__((ext_vector_type(2)));
typedef short s16x4 __attribute__((ext_vector_type(4)));
typedef __bf16 bf16x8 __attribute__((ext_vector_type(8)));
typedef __bf16 bf16x2 __attribute__((ext_vector_type(2)));

constexpr int D = 1024, NB = 4, SEQ = 4096, TX = NB * SEQ, CL = 256, TC = NB * CL, M = TX + TC;
constexpr int DEPTH = 4, GW = 64;
constexpr int EVEN_IN = 4096, ODD_IN = 6144, FFN = 2816, NE = 8, EDIM = 3584;
constexpr float ALPHA = 1.681792830507429f;
constexpr float LN_EPS = 1e-5f, NORM_EPS = 1e-6f;
constexpr int NTHREADS = 512, NWAVES = 8;
constexpr int MOE_ROWS = 36864, MOE_TILES = MOE_ROWS / 256;

constexpr size_t MiB = 1u << 20;
constexpr size_t WS_CTL = 0, CTL_BYTES = 32768;
constexpr size_t WS_MOD = 1 * MiB;
constexpr size_t WS_ROUTE = 2 * MiB;
constexpr size_t WS_TILEX = 3 * MiB;
constexpr size_t WS_ROPET = 3 * MiB + 65536;
constexpr size_t WS_EWIN = 4 * MiB;
constexpr size_t WS_EWOUT = WS_EWIN + 16 * MiB;
constexpr size_t WS_FW13 = WS_EWOUT + 4 * MiB;
constexpr size_t WS_FW2 = WS_FW13 + 22 * MiB;
constexpr size_t WS_OWIN = WS_FW2 + 11 * MiB;
constexpr size_t WS_OWOUT = WS_OWIN + 24 * MiB;
constexpr size_t WS_MW13 = WS_OWOUT + 8 * MiB;
constexpr size_t WS_MW2 = WS_MW13 + 112 * MiB;
constexpr size_t WS_X = WS_MW2 + 56 * MiB;
constexpr size_t WS_V = WS_X + 68 * MiB;
constexpr size_t WS_H = WS_V + 68 * MiB;
constexpr size_t WS_BIG = WS_H + 34 * MiB;
constexpr size_t WS_P = WS_BIG;
constexpr size_t WS_MIX = WS_BIG + 204 * MiB;
constexpr size_t WS_OD = WS_BIG + 272 * MiB;
constexpr size_t WS_G = WS_BIG;
constexpr size_t WS_XP = WS_BIG;
constexpr size_t WS_GP = WS_BIG + 72 * MiB;
constexpr size_t WS_Y2P = WS_BIG + 324 * MiB;
constexpr size_t WS_HST = WS_BIG + 136 * MiB;
constexpr size_t WS_HGT = WS_BIG + 154 * MiB;
constexpr size_t WS_HQD = WS_BIG + 340 * MiB;
constexpr size_t WS_HUT = WS_BIG + 374 * MiB;
constexpr size_t WS_PM = WS_BIG + 408 * MiB;
constexpr size_t WS_MW13B = WS_BIG + 424 * MiB;
constexpr size_t WS_END = WS_BIG + 536 * MiB;

constexpr int CW_CNT = 1024;
constexpr int CW_BAR = 4096;

struct Params {
    const float *x, *c, *ctx, *c_ctx, *ada_w, *ada_b, *ln_g, *ln_b, *e_w_in, *e_w_out, *na_rpb, *hg_lb, *hg_norm_g,
        *ffn_w1, *ffn_w3, *ffn_w2, *o_w_in, *o_w_out, *ret_ld, *router_w, *router_b, *moe_w1, *moe_w3, *moe_w2;
    float* out;
    unsigned char* ws;
};

#define LDS_BARRIER() do { asm volatile("s_waitcnt lgkmcnt(0)" ::: "memory"); __builtin_amdgcn_s_barrier(); asm volatile("" ::: "memory"); } while (0)
__device__ __forceinline__ int tid_fresh() { int t = threadIdx.x; asm volatile("" : "+v"(t)); return t; }
__device__ __forceinline__ float silu_f(float v) { return v * __builtin_amdgcn_rcpf(1.0f + __expf(-v)); }
__device__ __forceinline__ int row_vec(int row) { return row < TX ? (row >> 12) : 4; }
__device__ __forceinline__ float wave_sum(float v) {
#pragma unroll
    for (int o = 1; o < 64; o <<= 1) v += __shfl_xor(v, o);
    return v;
}

namespace pg8 {
constexpr int BM = 256, BK = 64, HALF = 128, HTB = HALF * BK * 2, STAGE_BYTES = 8 * HTB, NXCD = 8, WGM = 8;
__host__ __device__ __forceinline__ int lds_byte(int r, int c) { const int st = (r >> 4) * 2 + (c >> 5), rr = r & 15, cc = c & 31, ob = rr * 64 + cc * 2; return st * 1024 + (ob ^ (((ob >> 9) & 1) << 5)); }
__host__ __device__ __forceinline__ void stage_rc(int b, int& R, int& C) { const int st = b / 1024, sb = b % 1024, swz = sb ^ (((sb >> 9) & 1) << 5); R = (st >> 1) * 16 + swz / 64; C = (st & 1) * 32 + (swz % 64) / 2; }
__host__ __device__ __forceinline__ int perm32(int rho) { const int n = rho >> 4, i = rho & 15; return 8 * (i >> 2) + 4 * n + (i & 3); }

struct Unit { int pm, pn; };
struct Gemm { const f16* A; const f16* Bt; int M, N, K; };

struct StaticOrder {
    int nM, nN, nwg, G, c;
    __host__ __device__ void init(int M_, int N_, int G_, int c_) { nM = M_ / BM; nN = N_ / BM; nwg = nM * nN; G = G_; c = c_; }
    __host__ __device__ bool next(int i, Unit& u) const {
        const long L = (long)i * G + c; if (L >= nwg) return false;
        int wgid = (int)L; { const int q = nwg / NXCD, r = nwg % NXCD, xcd = wgid % NXCD, off = wgid / NXCD; wgid = (xcd < r ? xcd * (q + 1) : r * (q + 1) + (xcd - r) * q) + off; }
        const int nig = WGM * nN, gid = wgid / nig, fm = gid * WGM, gsz = (nM - fm) < WGM ? (nM - fm) : WGM;
        u.pm = fm + ((wgid % nig) % gsz); u.pn = (wgid % nig) / gsz; return true;
    }
    __device__ __forceinline__ void a_ready(const Unit&) const {}
    __device__ __forceinline__ void done(const Unit&) const {}
};
struct GroupedOrder {
    const int* tile_expert; int ntiles, nN, G, c;
    __device__ bool next(int i, Unit& u) const {
        const long L = (long)i * G + c; if (L >= (long)ntiles * nN) return false;
        const int pm = (int)(L / nN), pl = (int)(L % nN);
        u.pm = pm; u.pn = __builtin_amdgcn_readfirstlane(__hip_atomic_load(tile_expert + pm, __ATOMIC_RELAXED, __HIP_MEMORY_SCOPE_AGENT)) * nN + pl; return true;
    }
    __device__ __forceinline__ void a_ready(const Unit&) const {}
    __device__ __forceinline__ void done(const Unit&) const {}
};

template <class Epi, class Sched, bool ALIGN_EPI = false, bool SP2 = false>
__device__ __forceinline__ void gemm_phase(LAS unsigned char* lds, const Gemm g, const Sched& S, const Epi& E) {
    const int tid = tid_fresh(), wid = __builtin_amdgcn_readfirstlane(tid >> 6), lane = tid & 63, wr = wid >> 2, wc = wid & 3, fr = lane & 15, fq = lane >> 4;
    const int K = g.K, nt = K / BK;
    unsigned voffA[2], voffB[2];
#pragma unroll
    for (int i = 0; i < 2; ++i) { int R, C; stage_rc(tid * 16 + i * 8192, R, C); const int Rb = Epi::PERM ? ((R & ~31) + perm32(R & 31)) : R;
        voffA[i] = (unsigned)(R * K + C) * 2u; voffB[i] = (unsigned)(Rb * K + C) * 2u; }
    const size_t kstep = (size_t)(BK * 2);
    const size_t hstep = (size_t)HALF * K * 2;
    const size_t tstep = 2 * hstep;
    const unsigned ldsw = (unsigned)wid * 1024u;
    const int aoff = lds_byte(wr * 64 + fr, fq * 8), boff = lds_byte(wc * 32 + fr, fq * 8);
#define PG8_SA(b, h) (((b) * 2 + (h)) * HTB)
#define PG8_SB(b, h) ((4 + (b) * 2 + (h)) * HTB)
#define PG8_STAGE(bufoff, gbase, voff) do { _Pragma("unroll") for (int _i = 0; _i < 2; ++_i) \
        __builtin_amdgcn_global_load_lds((const unsigned*)((const char*)(gbase) + (voff)[_i]), (LAS unsigned*)(lds + (bufoff) + ldsw + _i * 8192), 16, 0, 0); } while (0)
#define PG8_LDA(dst, b, h) do { _Pragma("unroll") for (int m = 0; m < 4; ++m) _Pragma("unroll") for (int k = 0; k < 2; ++k) dst[m][k] = *(const LAS f16x8*)(lds + PG8_SA(b, h) + aoff + m * 2048 + k * 1024); } while (0)
#define PG8_LDB(dst, b, h) do { _Pragma("unroll") for (int n = 0; n < 2; ++n) _Pragma("unroll") for (int k = 0; k < 2; ++k) dst[n][k] = *(const LAS f16x8*)(lds + PG8_SB(b, h) + boff + n * 2048 + k * 1024); } while (0)
#define PG8_MMA(ai, bj, At, Bt) do { __builtin_amdgcn_s_setprio(1); _Pragma("unroll") for (int m = 0; m < 4; ++m) _Pragma("unroll") for (int n = 0; n < 2; ++n) _Pragma("unroll") for (int k = 0; k < 2; ++k) \
        acc[ai][bj][m][n] = __builtin_amdgcn_mfma_f32_16x16x32_f16(Bt[n][k], At[m][k], acc[ai][bj][m][n], 0, 0, 0); __builtin_amdgcn_s_setprio(0); } while (0)
#define PG8_WAIT_V(n) asm volatile("s_waitcnt vmcnt(" #n ")" ::: "memory")
#define PG8_WAIT_L(n) asm volatile("s_waitcnt lgkmcnt(" #n ")" ::: "memory")
#define PG8_BAR __builtin_amdgcn_s_barrier()
#define PG8_SCHED __builtin_amdgcn_sched_barrier(0)
    Unit cur, nxt; int ui = 0;
    if (!S.next(0, cur)) return;
    f32x4 acc[2][2][4][2];
#pragma unroll
    for (int a = 0; a < 2; ++a)
#pragma unroll
        for (int b = 0; b < 2; ++b)
#pragma unroll
            for (int m = 0; m < 4; ++m)
#pragma unroll
                for (int n = 0; n < 2; ++n) acc[a][b][m][n] = (f32x4){0.f, 0.f, 0.f, 0.f};
    f16x8 At[4][2], B0[2][2], B1[2][2];
    const char* cA = (const char*)g.A + (size_t)cur.pm * tstep; const char* cB = (const char*)g.Bt + (size_t)cur.pn * tstep;
    S.a_ready(cur);
    if constexpr (SP2) {
        PG8_STAGE(PG8_SB(0, 0), cB, voffB); PG8_STAGE(PG8_SB(0, 1), cB + hstep, voffB); PG8_STAGE(PG8_SA(0, 0), cA, voffA); PG8_STAGE(PG8_SA(0, 1), cA + hstep, voffA);
        if (wr == 1) PG8_BAR;
        PG8_WAIT_V(2); PG8_BAR;
        PG8_STAGE(PG8_SB(1, 0), cB + kstep, voffB); PG8_STAGE(PG8_SA(1, 0), cA + kstep, voffA); PG8_STAGE(PG8_SB(1, 1), cB + hstep + kstep, voffB);
        PG8_WAIT_V(6); PG8_BAR;
    } else {
        PG8_STAGE(PG8_SB(0, 0), cB, voffB); PG8_STAGE(PG8_SA(0, 0), cA, voffA); PG8_STAGE(PG8_SB(0, 1), cB + hstep, voffB); PG8_STAGE(PG8_SA(0, 1), cA + hstep, voffA);
        if (wr == 1) PG8_BAR;
        PG8_WAIT_V(4); PG8_BAR;
        PG8_STAGE(PG8_SB(1, 0), cB + kstep, voffB); PG8_STAGE(PG8_SA(1, 0), cA + kstep, voffA); PG8_STAGE(PG8_SB(1, 1), cB + hstep + kstep, voffB);
        PG8_WAIT_V(6); PG8_BAR;
    }
    for (;;) {
        const bool has_next = S.next(ui + 1, nxt);
        const char* nA = has_next ? (const char*)g.A + (size_t)nxt.pm * tstep : cA; const char* nB = has_next ? (const char*)g.Bt + (size_t)nxt.pn * tstep : cB;
        for (int t = 0; t < nt; t += 2) {
            const bool last = (t == nt - 2);
            const char* a1 = cA + (size_t)(t + 1) * kstep;
            const char* a2 = last ? nA : cA + (size_t)(t + 2) * kstep; const char* b2 = last ? nB : cB + (size_t)(t + 2) * kstep;
            const char* a3 = a2 + kstep; const char* b3 = b2 + kstep;
            if (last && has_next) S.a_ready(nxt);
            if constexpr (SP2) {
            PG8_LDB(B0, 0, 0); PG8_LDB(B1, 0, 1); PG8_SCHED; PG8_LDA(At, 0, 0); PG8_STAGE(PG8_SA(1, 1), a1 + hstep, voffA);
            PG8_WAIT_V(8); PG8_WAIT_L(0); PG8_BAR; PG8_MMA(0, 0, At, B0); PG8_MMA(0, 1, At, B1); PG8_BAR; PG8_SCHED;
            PG8_LDA(At, 0, 1); PG8_STAGE(PG8_SB(0, 0), b2, voffB); PG8_STAGE(PG8_SB(0, 1), b2 + hstep, voffB); PG8_STAGE(PG8_SA(0, 0), a2, voffA);
            PG8_WAIT_V(8); PG8_WAIT_L(0); PG8_BAR; PG8_MMA(1, 0, At, B0); PG8_MMA(1, 1, At, B1); PG8_BAR; PG8_SCHED;
            PG8_LDB(B0, 1, 0); PG8_LDB(B1, 1, 1); PG8_SCHED; PG8_LDA(At, 1, 0); PG8_STAGE(PG8_SA(0, 1), a2 + hstep, voffA);
            PG8_WAIT_V(8); PG8_WAIT_L(0); PG8_BAR; PG8_MMA(0, 0, At, B0); PG8_MMA(0, 1, At, B1); PG8_BAR; PG8_SCHED;
            PG8_LDA(At, 1, 1); PG8_STAGE(PG8_SB(1, 0), b3, voffB); PG8_STAGE(PG8_SB(1, 1), b3 + hstep, voffB); PG8_STAGE(PG8_SA(1, 0), a3, voffA);
            PG8_WAIT_V(8); PG8_WAIT_L(0); PG8_BAR; PG8_MMA(1, 0, At, B0); PG8_MMA(1, 1, At, B1); PG8_BAR; PG8_SCHED;
            } else {
            PG8_LDB(B0, 0, 0); PG8_SCHED; PG8_LDA(At, 0, 0); PG8_STAGE(PG8_SA(1, 1), a1 + hstep, voffA);
            PG8_WAIT_L(8); PG8_BAR; PG8_WAIT_L(0); PG8_MMA(0, 0, At, B0); PG8_BAR; PG8_SCHED;
            PG8_LDB(B1, 0, 1); PG8_STAGE(PG8_SB(0, 0), b2, voffB);
            PG8_BAR; PG8_WAIT_L(0); PG8_MMA(0, 1, At, B1); PG8_BAR;
            PG8_LDA(At, 0, 1); PG8_STAGE(PG8_SA(0, 0), a2, voffA);
            PG8_BAR; PG8_WAIT_L(0); PG8_MMA(1, 0, At, B0); PG8_BAR; PG8_SCHED;
            PG8_STAGE(PG8_SB(0, 1), b2 + hstep, voffB);
            PG8_WAIT_V(6); PG8_BAR; PG8_MMA(1, 1, At, B1); PG8_BAR;
            PG8_LDB(B0, 1, 0); PG8_SCHED; PG8_LDA(At, 1, 0); PG8_STAGE(PG8_SA(0, 1), a2 + hstep, voffA);
            PG8_WAIT_L(8); PG8_BAR; PG8_WAIT_L(0); PG8_MMA(0, 0, At, B0); PG8_BAR; PG8_SCHED;
            PG8_LDB(B1, 1, 1); PG8_STAGE(PG8_SB(1, 0), b3, voffB);
            PG8_BAR; PG8_WAIT_L(0); PG8_MMA(0, 1, At, B1); PG8_BAR;
            PG8_LDA(At, 1, 1); PG8_STAGE(PG8_SA(1, 0), a3, voffA);
            PG8_BAR; PG8_WAIT_L(0); PG8_MMA(1, 0, At, B0); PG8_BAR; PG8_SCHED;
            PG8_STAGE(PG8_SB(1, 1), b3 + hstep, voffB);
            PG8_WAIT_V(6); PG8_BAR; PG8_MMA(1, 1, At, B1); PG8_BAR;
            }
        }
        if constexpr (ALIGN_EPI) { if (wr == 0) PG8_BAR; }
        E(acc, cur, wr, wc, fr, fq); S.done(cur);
        if (!has_next) break;
#pragma unroll
        for (int a = 0; a < 2; ++a)
#pragma unroll
            for (int b = 0; b < 2; ++b)
#pragma unroll
                for (int m = 0; m < 4; ++m)
#pragma unroll
                    for (int n = 0; n < 2; ++n) acc[a][b][m][n] = (f32x4){0.f, 0.f, 0.f, 0.f};
        cur = nxt; cA = nA; cB = nB; ++ui;
        if constexpr (ALIGN_EPI) { if (wr == 1) PG8_BAR; }
    }
    PG8_WAIT_V(0);
    if constexpr (!ALIGN_EPI) { if (wr == 0) PG8_BAR; }
    PG8_BAR;
#undef PG8_SA
#undef PG8_SB
#undef PG8_STAGE
#undef PG8_LDA
#undef PG8_LDB
#undef PG8_MMA
#undef PG8_WAIT_V
#undef PG8_WAIT_L
#undef PG8_BAR
#undef PG8_SCHED
}

__device__ __forceinline__ u32x4 pack8(const f32x4 a, const f32x4 b) {
    f16x8 h; h[0] = (f16)a[0]; h[1] = (f16)a[1]; h[2] = (f16)a[2]; h[3] = (f16)a[3]; h[4] = (f16)b[0]; h[5] = (f16)b[1]; h[6] = (f16)b[2]; h[7] = (f16)b[3];
    return __builtin_bit_cast(u32x4, h);
}
struct EpiF16 {
    static constexpr bool PERM = true;
    f16* O; int ldc; int nN_local;
    __device__ __forceinline__ void operator()(const f32x4 (&acc)[2][2][4][2], const Unit& u, int wr, int wc, int fr, int fq) const {
        const int row0 = u.pm * BM + wr * 64 + fr; const int col0 = (u.pn % nN_local) * BM + wc * 32 + 8 * fq;
#pragma unroll
        for (int ai = 0; ai < 2; ++ai)
#pragma unroll
            for (int m = 0; m < 4; ++m) { f16* rowp = O + (size_t)(row0 + ai * HALF + m * 16) * ldc + col0;
#pragma unroll
                for (int bj = 0; bj < 2; ++bj) *(u32x4*)(rowp + bj * HALF) = pack8(acc[ai][bj][m][0], acc[ai][bj][m][1]); }
    }
};
struct EpiRope {
    static constexpr bool PERM = true;
    f16* O; const float* T;
    __device__ __forceinline__ void operator()(const f32x4 (&acc)[2][2][4][2], const Unit& u, int wr, int wc, int fr, int fq) const {
        const int row0 = u.pm * BM + wr * 64 + fr; const int col0 = u.pn * BM + wc * 32 + 8 * fq;
        const bool isq = u.pn < 4, isk = u.pn >= 4 && u.pn < 8, latent = u.pm < TX / BM;
#pragma unroll
        for (int ai = 0; ai < 2; ++ai)
#pragma unroll
            for (int m = 0; m < 4; ++m) { const int row = row0 + ai * HALF + m * 16; f16* rowp = O + (size_t)row * ODD_IN + col0; const int n = row & (SEQ - 1);
#pragma unroll
                for (int bj = 0; bj < 2; ++bj) { f32x4 v0 = acc[ai][bj][m][0], v1 = acc[ai][bj][m][1];
                    if (isq || isk) {
                        if (latent) { const int c = col0 + bj * HALF; const int pos = ((c >> 7) & 1) ? (n & 63) : (n >> 6); const float* tp = T + ((size_t)pos * 64 + ((c & 127) >> 1)) * 2;
                            const f32x4 t0 = *(const f32x4*)tp, t1 = *(const f32x4*)(tp + 4);
                            const f32x4 a = v0, b2 = v1;
                            v0[0] = a[0] * t0[0] - a[1] * t0[1]; v0[1] = a[1] * t0[0] + a[0] * t0[1]; v0[2] = a[2] * t0[2] - a[3] * t0[3]; v0[3] = a[3] * t0[2] + a[2] * t0[3];
                            v1[0] = b2[0] * t1[0] - b2[1] * t1[1]; v1[1] = b2[1] * t1[0] + b2[0] * t1[1]; v1[2] = b2[2] * t1[2] - b2[3] * t1[3]; v1[3] = b2[3] * t1[2] + b2[2] * t1[3]; }
                        if (isk) { v0 = v0 * 0.0625f; v1 = v1 * 0.0625f; }
                    }
                    *(u32x4*)(rowp + bj * HALF) = pack8(v0, v1); } }
    }
};
struct EpiSwiglu {
    static constexpr bool PERM = true;
    f16* O; int ldc; int nN_local;
    __device__ __forceinline__ void operator()(const f32x4 (&acc)[2][2][4][2], const Unit& u, int wr, int wc, int fr, int fq) const {
        const int row0 = u.pm * BM + wr * 64 + fr; const int col0 = (u.pn % nN_local) * HALF + wc * 32 + 8 * fq;
#pragma unroll
        for (int ai = 0; ai < 2; ++ai)
#pragma unroll
            for (int m = 0; m < 4; ++m) { f16* rowp = O + (size_t)(row0 + ai * HALF + m * 16) * ldc + col0;
                f32x4 r0, r1;
#pragma unroll
                for (int j = 0; j < 4; ++j) { r0[j] = silu_f(acc[ai][0][m][0][j]) * acc[ai][1][m][0][j]; r1[j] = silu_f(acc[ai][0][m][1][j]) * acc[ai][1][m][1][j]; }
                *(u32x4*)rowp = pack8(r0, r1); }
    }
};
struct EpiResid {
    static constexpr bool PERM = false;
    const f16* X; f16* V; const float* modl; int gate;
    __device__ __forceinline__ void operator()(const f32x4 (&acc)[2][2][4][2], const Unit& u, int wr, int wc, int fr, int fq) const {
        const int row0 = u.pm * BM + wr * 64 + fr, col0 = u.pn * BM + wc * 32 + 4 * fq;
#pragma unroll
        for (int ai = 0; ai < 2; ++ai)
#pragma unroll
            for (int m = 0; m < 4; ++m) { const int row = row0 + ai * HALF + m * 16; const size_t off = (size_t)row * D + col0;
                const float* mrow = modl + row_vec(row) * 6144 + gate + col0;
#pragma unroll
                for (int bj = 0; bj < 2; ++bj)
#pragma unroll
                    for (int n = 0; n < 2; ++n) { const f16x4 xh = *(const f16x4*)(X + off + bj * HALF + n * 16); const f32x4 xs = (f32x4){(float)xh[0], (float)xh[1], (float)xh[2], (float)xh[3]}; const f32x4 mg = *(const f32x4*)(mrow + bj * HALF + n * 16);
                        const f32x4 vv = xs * ALPHA + mg * acc[ai][bj][m][n]; f16x4 hv; hv[0] = (f16)vv[0]; hv[1] = (f16)vv[1]; hv[2] = (f16)vv[2]; hv[3] = (f16)vv[3];
                        *(f16x4*)(V + off + bj * HALF + n * 16) = hv; } }
    }
};
}

constexpr int CG_P = 288, CG_T = 64 * CG_P;
__device__ __forceinline__ void gemm_ctx64(LAS unsigned char* lds, const f16* A, const f16* Bt, int K, const f16* X, f16* V, const float* modctx_gate, int bid, int nblk) {
    const int tid = tid_fresh(); const int wave = __builtin_amdgcn_readfirstlane(tid >> 6), lane = tid & 63, li = lane & 15, g = lane >> 4;
    const int wm = wave & 3, wn = wave >> 2, pr = tid >> 3, pc = tid & 7, nk = K / 128;
    for (int tile = bid; tile < 256; tile += nblk) {
        const int row0 = TX + 64 * (tile >> 4), col0 = 64 * (tile & 15);
        const f16* ap = A + (size_t)(row0 + pr) * K + pc * 8; const f16* bp = Bt + (size_t)(col0 + pr) * K + pc * 8;
        f32x4 acc[2]; acc[0] = (f32x4){0.f, 0.f, 0.f, 0.f}; acc[1] = (f32x4){0.f, 0.f, 0.f, 0.f};
        u32x4 rg[4][4];
#define CG_LD(ks, r) do { r[0] = *(const u32x4*)(ap + 128 * (ks)); r[1] = *(const u32x4*)(ap + 128 * (ks) + 64); r[2] = *(const u32x4*)(bp + 128 * (ks)); r[3] = *(const u32x4*)(bp + 128 * (ks) + 64); } while (0)
#define CG_ST(buf, r) do { LAS unsigned char* _a = lds + (buf) * 2 * CG_T + pr * CG_P + pc * 16; *(LAS u32x4*)_a = r[0]; *(LAS u32x4*)(_a + 128) = r[1]; *(LAS u32x4*)(_a + CG_T) = r[2]; *(LAS u32x4*)(_a + CG_T + 128) = r[3]; } while (0)
        CG_LD(0, rg[0]); CG_LD(1, rg[1]); CG_LD(2, rg[2]); CG_LD(3, rg[3]);
        LDS_BARRIER();
        CG_ST(0, rg[0]); CG_LD(4, rg[0]);
        LDS_BARRIER();
        for (int ks0 = 0; ks0 < nk; ks0 += 4) {
#pragma unroll
            for (int x = 0; x < 4; ++x) {
                const int ks = ks0 + x;
                if (ks < nk) {
                    LAS unsigned char* As = lds + (x & 1) * 2 * CG_T; LAS unsigned char* Bs = As + CG_T;
                    f16x8 af[4], bf[2][4];
#pragma unroll
                    for (int kk = 0; kk < 4; ++kk) { af[kk] = *(LAS f16x8*)(As + (16 * wm + li) * CG_P + (32 * kk + 8 * g) * 2);
#pragma unroll
                        for (int nb = 0; nb < 2; ++nb) bf[nb][kk] = *(LAS f16x8*)(Bs + (32 * wn + 16 * nb + li) * CG_P + (32 * kk + 8 * g) * 2); }
#pragma unroll
                    for (int kk = 0; kk < 4; ++kk)
#pragma unroll
                        for (int nb = 0; nb < 2; ++nb) acc[nb] = __builtin_amdgcn_mfma_f32_16x16x32_f16(bf[nb][kk], af[kk], acc[nb], 0, 0, 0);
                    if (ks + 1 < nk) { CG_ST((x + 1) & 1, rg[(x + 1) & 3]); if (ks + 5 < nk) CG_LD(ks + 5, rg[(x + 1) & 3]); }
                    LDS_BARRIER();
                }
            }
        }
#undef CG_LD
#undef CG_ST
        const size_t row = (size_t)(row0 + 16 * wm + li);
#pragma unroll
        for (int nb = 0; nb < 2; ++nb) { const int col = col0 + 32 * wn + 16 * nb + 4 * g;
            const f16x4 xh = *(const f16x4*)(X + row * D + col); const f32x4 xs = (f32x4){(float)xh[0], (float)xh[1], (float)xh[2], (float)xh[3]}, mg = *(const f32x4*)(modctx_gate + col);
            const f32x4 vv = xs * ALPHA + mg * acc[nb]; f16x4 hv; hv[0] = (f16)vv[0]; hv[1] = (f16)vv[1]; hv[2] = (f16)vv[2]; hv[3] = (f16)vv[3];
            *(f16x4*)(V + row * D + col) = hv; }
    }
}

__device__ __forceinline__ void ph_mod(const Params& P, LAS unsigned char* lds, int bid, int nblk) {
    const int tid = tid_fresh(); const int wave = tid >> 6, lane = tid & 63;
    float* mod = (float*)(P.ws + WS_MOD);
    LAS float* sv = (LAS float*)lds;
    LAS float* part = (LAS float*)(lds + 20480);
    for (int i = tid; i < 5 * D; i += NTHREADS) { const int v = i >> 10, k = i & 1023; sv[i] = silu_f(v < 4 ? P.c[v * D + k] : P.c_ctx[k]); }
    __syncthreads();
    for (int item = bid; item < DEPTH * 96; item += nblk) {
        const int l = item / 96, n = (item % 96) * 64 + lane;
        const float* w = P.ada_w + (size_t)l * D * 6144 + (size_t)(wave * 128) * 6144 + n;
        float a0 = 0.f, a1 = 0.f, a2 = 0.f, a3 = 0.f, a4 = 0.f;
        for (int k0 = 0; k0 < 128; k0 += 32) {
            float wv[32];
#pragma unroll
            for (int u = 0; u < 32; ++u) wv[u] = w[(size_t)(k0 + u) * 6144];
#pragma unroll
            for (int u = 0; u < 32; ++u) { const int kk = wave * 128 + k0 + u;
                a0 += sv[kk] * wv[u]; a1 += sv[D + kk] * wv[u]; a2 += sv[2 * D + kk] * wv[u]; a3 += sv[3 * D + kk] * wv[u]; a4 += sv[4 * D + kk] * wv[u]; }
        }
        LAS float* pw = part + wave * 320 + lane;
        pw[0] = a0; pw[64] = a1; pw[128] = a2; pw[192] = a3; pw[256] = a4;
        __syncthreads();
        if (tid < 320) { const int v = tid >> 6, ln = tid & 63; float t = 0.f;
#pragma unroll
            for (int wv = 0; wv < 8; ++wv) t += part[wv * 320 + v * 64 + ln];
            const int nn = (item % 96) * 64 + ln;
            mod[((size_t)l * 5 + v) * 6144 + nn] = t + P.ada_b[l * 6144 + nn]; }
        __syncthreads();
    }
}

constexpr int CV_P = 144;
__device__ __forceinline__ f16x4 tr_read_cv(LAS unsigned char* p) { const s16x4 v = __builtin_amdgcn_ds_read_tr16_b64_v4i16((LAS s16x4*)p); return __builtin_bit_cast(f16x4, v); }
__device__ __forceinline__ void convert_matrix(const float* W, int K, int N, f16* WT, int il, int half, LAS unsigned char* scr, int gw, int ngw, int lane, int& off) {
    const int items = (K / 64) * (N / 64), nblk = N / 64;
    const int li = lane & 15, g = lane >> 4;
    f32x4 r[16];
    auto load_item = [&](int item) { const int kb = item / nblk, nb = item % nblk; const float* src = W + (size_t)(64 * kb + g) * N + 64 * nb + 4 * li;
#pragma unroll
        for (int i = 0; i < 16; ++i) r[i] = *(const f32x4*)(src + (size_t)(4 * i) * N); };
    int it = gw - off; if (it < 0) it += ngw;
    off = (off + items) % ngw;
    if (it < items) load_item(it);
    for (; it < items; it += ngw) {
        const int kb = it / nblk, nb = it % nblk, k0 = 64 * kb, n0 = 64 * nb;
#pragma unroll
        for (int i = 0; i < 16; ++i) { f16x4 hv; hv[0] = (f16)r[i][0]; hv[1] = (f16)r[i][1]; hv[2] = (f16)r[i][2]; hv[3] = (f16)r[i][3];
            *(LAS f16x4*)(scr + (4 * i + g) * CV_P + li * 8) = hv; }
        if (it + ngw < items) load_item(it + ngw);
        f16x8 o[4][2];
#pragma unroll
        for (int nq = 0; nq < 4; ++nq)
#pragma unroll
            for (int ko = 0; ko < 2; ++ko) { LAS unsigned char* p = scr + (32 * ko + 8 * g + (li >> 2)) * CV_P + (16 * nq + 4 * (li & 3)) * 2;
                o[nq][ko] = __builtin_shufflevector(tr_read_cv(p), tr_read_cv(p + 4 * CV_P), 0, 1, 2, 3, 4, 5, 6, 7); }
#pragma unroll
        for (int nq = 0; nq < 4; ++nq) { const int n = n0 + 16 * nq + li;
            const int row = il == 1 ? ((n >> 7) * 256 + half * 128 + (n & 127)) : (il == 2 && n < 2048 ? ((n & ~127) + 2 * (n & 63) + ((n >> 6) & 1)) : n);
#pragma unroll
            for (int ko = 0; ko < 2; ++ko) *(f16x8*)(WT + (size_t)row * K + k0 + 32 * ko + 8 * g) = o[nq][ko]; }
    }
}
__device__ __forceinline__ void ph_convert_static(const Params& P, LAS unsigned char* lds, int bid, int nblk) {
    const int tidf = tid_fresh(); const int wave = tidf >> 6, lane = tidf & 63, gw = bid * NWAVES + wave, ngw = nblk * NWAVES;
    LAS unsigned char* scr = lds + wave * 16384; int off = 0;
    for (int j = 0; j < 2; ++j) {
        convert_matrix(P.e_w_in + (size_t)j * D * EVEN_IN, D, EVEN_IN, (f16*)(P.ws + WS_EWIN) + (size_t)j * EVEN_IN * D, 0, 0, scr, gw, ngw, lane, off);
        convert_matrix(P.e_w_out + (size_t)j * D * D, D, D, (f16*)(P.ws + WS_EWOUT) + (size_t)j * D * D, 0, 0, scr, gw, ngw, lane, off);
        convert_matrix(P.ffn_w1 + (size_t)j * D * FFN, D, FFN, (f16*)(P.ws + WS_FW13) + (size_t)j * 2 * FFN * D, 1, 0, scr, gw, ngw, lane, off);
        convert_matrix(P.ffn_w3 + (size_t)j * D * FFN, D, FFN, (f16*)(P.ws + WS_FW13) + (size_t)j * 2 * FFN * D, 1, 1, scr, gw, ngw, lane, off);
        convert_matrix(P.ffn_w2 + (size_t)j * FFN * D, FFN, D, (f16*)(P.ws + WS_FW2) + (size_t)j * D * FFN, 0, 0, scr, gw, ngw, lane, off);
        convert_matrix(P.o_w_in + (size_t)j * D * ODD_IN, D, ODD_IN, (f16*)(P.ws + WS_OWIN) + (size_t)j * ODD_IN * D, 2, 0, scr, gw, ngw, lane, off);
        convert_matrix(P.o_w_out + (size_t)j * 2048 * D, 2048, D, (f16*)(P.ws + WS_OWOUT) + (size_t)j * D * 2048, 0, 0, scr, gw, ngw, lane, off);
    }
}
__device__ __forceinline__ void convert_tile_plain(const float* W, int K, int N, f16* WT, LAS unsigned char* scr, int item, int lane) {
    const int nblk = N / 64, kb = item / nblk, nb = item % nblk, k0 = 64 * kb, n0 = 64 * nb, li = lane & 15, g = lane >> 4;
    const float* src = W + (size_t)(k0 + g) * N + n0 + 4 * li;
    f32x4 r[16];
#pragma unroll
    for (int i = 0; i < 16; ++i) r[i] = *(const f32x4*)(src + (size_t)(4 * i) * N);
#pragma unroll
    for (int i = 0; i < 16; ++i) { f16x4 hv; hv[0] = (f16)r[i][0]; hv[1] = (f16)r[i][1]; hv[2] = (f16)r[i][2]; hv[3] = (f16)r[i][3]; *(LAS f16x4*)(scr + (4 * i + g) * CV_P + li * 8) = hv; }
#pragma unroll
    for (int nq = 0; nq < 4; ++nq)
#pragma unroll
        for (int ko = 0; ko < 2; ++ko) { LAS unsigned char* p = scr + (32 * ko + 8 * g + (li >> 2)) * CV_P + (16 * nq + 4 * (li & 3)) * 2;
            const f16x8 o = __builtin_shufflevector(tr_read_cv(p), tr_read_cv(p + 4 * CV_P), 0, 1, 2, 3, 4, 5, 6, 7);
            *(f16x8*)(WT + (size_t)(n0 + 16 * nq + li) * K + k0 + 32 * ko + 8 * g) = o; }
}
__device__ __forceinline__ void convert_tile_il(const float* W, int K, int N, f16* WT, int half, LAS unsigned char* scr, int item, int lane) {
    const int nblk = N / 64, kb = item / nblk, nb = item % nblk, k0 = 64 * kb, n0 = 64 * nb, li = lane & 15, g = lane >> 4;
    const float* src = W + (size_t)(k0 + g) * N + n0 + 4 * li;
    f32x4 r[16];
#pragma unroll
    for (int i = 0; i < 16; ++i) r[i] = *(const f32x4*)(src + (size_t)(4 * i) * N);
#pragma unroll
    for (int i = 0; i < 16; ++i) { f16x4 hv; hv[0] = (f16)r[i][0]; hv[1] = (f16)r[i][1]; hv[2] = (f16)r[i][2]; hv[3] = (f16)r[i][3]; *(LAS f16x4*)(scr + (4 * i + g) * CV_P + li * 8) = hv; }
#pragma unroll
    for (int nq = 0; nq < 4; ++nq)
#pragma unroll
        for (int ko = 0; ko < 2; ++ko) { LAS unsigned char* p = scr + (32 * ko + 8 * g + (li >> 2)) * CV_P + (16 * nq + 4 * (li & 3)) * 2;
            const f16x8 o = __builtin_shufflevector(tr_read_cv(p), tr_read_cv(p + 4 * CV_P), 0, 1, 2, 3, 4, 5, 6, 7);
            const int n = n0 + 16 * nq + li;
            *(f16x8*)(WT + (size_t)((n >> 7) * 256 + half * 128 + (n & 127)) * K + k0 + 32 * ko + 8 * g) = o; }
}
constexpr int W13_TILES = (D / 64) * (EDIM / 64);
constexpr int W13_PRO = 5632;
__device__ __forceinline__ void bg_convert_w13(const Params& P, int j, int a, int b, int w0, f16* dst, LAS unsigned char* lds, int bid, int nblk) {
    if (bid < w0) return;
    const int nw = nblk - w0;
    const int tidf = tid_fresh(); const int wave = tidf >> 6, lane = tidf & 63;
    LAS unsigned char* scr = lds + wave * 16384;
    for (int gi = a + (bid - w0) * NWAVES + wave; gi < b; gi += nw * NWAVES) {
        const int e = gi / (2 * W13_TILES), r = gi % (2 * W13_TILES), half = r / W13_TILES, it = r % W13_TILES;
        const float* W = (half ? P.moe_w3 : P.moe_w1) + ((size_t)j * NE + e) * D * EDIM;
        convert_tile_il(W, D, EDIM, dst + (size_t)e * 2 * EDIM * D, half, scr, it, lane);
    }
}
constexpr int W2_TILES = (EDIM / 64) * (D / 64);
__device__ __forceinline__ void bg_convert_w2(const Params& P, int j, int a, int b, int heavy, LAS unsigned char* lds, int bid, int nblk) {
    const int w0 = heavy % nblk, nw = nblk - w0;
    if (bid < w0) return;
    const int tidf = tid_fresh(); const int wave = tidf >> 6, lane = tidf & 63;
    LAS unsigned char* scr = lds + wave * 16384;
    for (int gi = a + (bid - w0) * NWAVES + wave; gi < b; gi += nw * NWAVES) {
        const int e = gi / W2_TILES, it = gi % W2_TILES;
        convert_tile_plain(P.moe_w2 + ((size_t)j * NE + e) * D * EDIM, EDIM, D, (f16*)(P.ws + WS_MW2) + (size_t)e * D * EDIM, scr, it, lane);
    }
}
__device__ __forceinline__ void ph_convert_moe(const Params& P, int j, LAS unsigned char* lds, int bid, int nblk, int which = 3) {
    const int tidf = tid_fresh(); const int wave = tidf >> 6, lane = tidf & 63, gw = bid * NWAVES + wave, ngw = nblk * NWAVES;
    LAS unsigned char* scr = lds + wave * 16384; int off = 0;
    for (int e = 0; e < NE; ++e) {
        const size_t wo = ((size_t)j * NE + e) * D * EDIM;
        if (which & 1) {
            convert_matrix(P.moe_w1 + wo, D, EDIM, (f16*)(P.ws + WS_MW13) + (size_t)e * 2 * EDIM * D, 1, 0, scr, gw, ngw, lane, off);
            convert_matrix(P.moe_w3 + wo, D, EDIM, (f16*)(P.ws + WS_MW13) + (size_t)e * 2 * EDIM * D, 1, 1, scr, gw, ngw, lane, off);
        }
        if (which & 2) convert_matrix(P.moe_w2 + wo, EDIM, D, (f16*)(P.ws + WS_MW2) + (size_t)e * D * EDIM, 0, 0, scr, gw, ngw, lane, off);
    }
}

__device__ __forceinline__ void ph_prep0(const Params& P, int bid, int nblk) {
    const int tidf = tid_fresh(); const int wave = tidf >> 6, lane = tidf & 63, gw = bid * NWAVES + wave, ngw = nblk * NWAVES;
    const float* mod = (const float*)(P.ws + WS_MOD);
    f16* X = (f16*)(P.ws + WS_X); f16* H = (f16*)(P.ws + WS_H);
    for (int row0 = gw; row0 < M; row0 += 3 * ngw) {
        f32x4 v[3][4];
#pragma unroll
        for (int i = 0; i < 3; ++i) { const int row = row0 + i * ngw;
            if (row < M) { const float* src = row < TX ? P.x + (size_t)row * D : P.ctx + (size_t)(row - TX) * D;
#pragma unroll
                for (int j = 0; j < 4; ++j) v[i][j] = *(const f32x4*)(src + 4 * lane + 256 * j); } }
#pragma unroll
        for (int i = 0; i < 3; ++i) { const int row = row0 + i * ngw;
            if (row < M) { const float* mv = mod + (size_t)row_vec(row) * 6144;
#pragma unroll
                for (int j = 0; j < 4; ++j) { const int col = 4 * lane + 256 * j; const f32x4 vv = v[i][j];
                    { f16x4 xh; xh[0] = (f16)vv[0]; xh[1] = (f16)vv[1]; xh[2] = (f16)vv[2]; xh[3] = (f16)vv[3]; *(f16x4*)(X + (size_t)row * D + col) = xh; }
                    const f32x4 sh = *(const f32x4*)(mv + col), sc = *(const f32x4*)(mv + D + col);
                    const f32x4 h = vv * (sc + 1.0f) + sh; f16x4 hh; hh[0] = (f16)h[0]; hh[1] = (f16)h[1]; hh[2] = (f16)h[2]; hh[3] = (f16)h[3];
                    *(f16x4*)(H + (size_t)row * D + col) = hh; } } }
    }
}

template <int MODE>
__device__ __forceinline__ void ph_ln(const Params& P, int layer, int which, int bid, int nblk, bool last, LAS unsigned char* lds = nullptr, int mrows = M) {
    const int tidf = tid_fresh(); const int wave = tidf >> 6, lane = tidf & 63, gw = bid * NWAVES + wave, ngw = nblk * NWAVES;
    const float* mod = (const float*)(P.ws + WS_MOD);
    f16* X = (f16*)(P.ws + WS_X); const f16* V = (const f16*)(P.ws + WS_V); f16* H = (f16*)(P.ws + WS_H);
    const float* lg = P.ln_g + ((size_t)layer * 2 + which) * D; const float* lb = P.ln_b + ((size_t)layer * 2 + which) * D;
    const int ml = which == 0 ? layer : layer + 1; const int sh_off = which == 0 ? 3 * D : 0, sc_off = which == 0 ? 4 * D : D;
    const int j = layer >> 1;
    int* route = (int*)(P.ws + WS_ROUTE);
    const f16* Y2p = (const f16*)(P.ws + WS_Y2P);
    LAS unsigned* lcnt = (LAS unsigned*)lds;
    if (MODE == 1) { if (tidf < 16) lcnt[tidf] = 0u; __syncthreads(); }
    const int r_begin = (int)(((long)gw * mrows) / ngw), r_end = (int)(((long)(gw + 1) * mrows) / ngw);
    const bool has_next_mod = !(which == 1 && layer == DEPTH - 1);
    f32x4 pgg[4], pbb[4], psh[4], psc[4], pm5[4]; int curvec = -1;
#pragma unroll
    for (int q = 0; q < 4; ++q) { const int col = 4 * lane + 256 * q; pgg[q] = *(const f32x4*)(lg + col); pbb[q] = *(const f32x4*)(lb + col); }
    for (int row = r_begin; row < r_end; ++row) {
        const int vec = row_vec(row);
        if (vec != curvec) { curvec = vec;
            const float* mv = mod + ((size_t)(has_next_mod ? ml : layer) * 5 + vec) * 6144; const float* m5 = mod + ((size_t)layer * 5 + vec) * 6144 + 5 * D;
#pragma unroll
            for (int q = 0; q < 4; ++q) { const int col = 4 * lane + 256 * q; psh[q] = *(const f32x4*)(mv + sh_off + col); psc[q] = *(const f32x4*)(mv + sc_off + col); if (MODE == 2) pm5[q] = *(const f32x4*)(m5 + col); } }
        f32x4 v[4]; float s = 0.f;
        if (MODE == 2) {
            const int rtv = route[(size_t)row * 8 + (lane & 7)];
            const float g0 = __int_as_float(__shfl(rtv, 2)), g1 = __int_as_float(__shfl(rtv, 3)); const int p0 = __shfl(rtv, 6), p1 = __shfl(rtv, 7);
#pragma unroll
            for (int q = 0; q < 4; ++q) { const int col = 4 * lane + 256 * q; const f16x4 xh = *(const f16x4*)(X + (size_t)row * D + col); const f32x4 xs = (f32x4){(float)xh[0], (float)xh[1], (float)xh[2], (float)xh[3]};
                const f16x4 ya = *(const f16x4*)(Y2p + (size_t)p0 * D + col), yb = *(const f16x4*)(Y2p + (size_t)p1 * D + col); const f32x4 mg = pm5[q];
                f32x4 y;
#pragma unroll
                for (int e = 0; e < 4; ++e) y[e] = g0 * (float)ya[e] + g1 * (float)yb[e];
                v[q] = xs * ALPHA + mg * y; }
        } else {
#pragma unroll
            for (int q = 0; q < 4; ++q) { const f16x4 hv = *(const f16x4*)(V + (size_t)row * D + 4 * lane + 256 * q); v[q] = (f32x4){(float)hv[0], (float)hv[1], (float)hv[2], (float)hv[3]}; }
        }
#pragma unroll
        for (int q = 0; q < 4; ++q) s += (v[q][0] + v[q][1]) + (v[q][2] + v[q][3]);
        const float mean = wave_sum(s) * (1.f / D); float s2 = 0.f;
#pragma unroll
        for (int q = 0; q < 4; ++q) { v[q] = v[q] - mean; s2 += (v[q][0] * v[q][0] + v[q][1] * v[q][1]) + (v[q][2] * v[q][2] + v[q][3] * v[q][3]); }
        const float rstd = 1.0f / sqrtf(wave_sum(s2) * (1.f / D) + LN_EPS);
        float lg8[NE];
#pragma unroll
        for (int e = 0; e < NE; ++e) lg8[e] = 0.f;
#pragma unroll
        for (int q = 0; q < 4; ++q) { const int col = 4 * lane + 256 * q;
            const f32x4 gg = pgg[q], bb = pbb[q];
            const f32x4 y = v[q] * rstd * gg + bb;
            if (last) { if (row < TX) *(f32x4*)(P.out + (size_t)row * D + col) = y; }
            else {
                { f16x4 xh; xh[0] = (f16)y[0]; xh[1] = (f16)y[1]; xh[2] = (f16)y[2]; xh[3] = (f16)y[3]; *(f16x4*)(X + (size_t)row * D + col) = xh; }
                const f32x4 sh = psh[q], sc = psc[q];
                const f32x4 h = y * (sc + 1.0f) + sh; f16x4 hh; hh[0] = (f16)h[0]; hh[1] = (f16)h[1]; hh[2] = (f16)h[2]; hh[3] = (f16)h[3];
                *(f16x4*)(H + (size_t)row * D + col) = hh;
                if (MODE == 1) {
                    const float* rw = P.router_w + (size_t)j * D * NE + (size_t)col * NE;
#pragma unroll
                    for (int e4 = 0; e4 < 4; ++e4) {
                        const f32x4 w0 = *(const f32x4*)(rw + e4 * NE), w1 = *(const f32x4*)(rw + e4 * NE + 4);
                        lg8[0] += h[e4] * w0[0]; lg8[1] += h[e4] * w0[1]; lg8[2] += h[e4] * w0[2]; lg8[3] += h[e4] * w0[3];
                        lg8[4] += h[e4] * w1[0]; lg8[5] += h[e4] * w1[1]; lg8[6] += h[e4] * w1[2]; lg8[7] += h[e4] * w1[3];
                    }
                }
            }
        }
        if (MODE == 1) {
#pragma unroll
            for (int e = 0; e < NE; ++e) lg8[e] = wave_sum(lg8[e]) + P.router_b[j * NE + e];
            int e0 = 0; float v0 = lg8[0];
#pragma unroll
            for (int e = 1; e < NE; ++e) if (lg8[e] > v0) { v0 = lg8[e]; e0 = e; }
            int e1 = -1; float v1 = -3.0e38f;
#pragma unroll
            for (int e = 0; e < NE; ++e) if (e != e0 && lg8[e] > v1) { v1 = lg8[e]; e1 = e; }
            const float ex = __expf(v1 - v0), g0 = 1.0f / (1.0f + ex), g1 = ex / (1.0f + ex);
            if (lane == 0) {
                const int s0 = (int)__hip_atomic_fetch_add(lcnt + e0, 1u, __ATOMIC_RELAXED, __HIP_MEMORY_SCOPE_WORKGROUP), s1 = (int)__hip_atomic_fetch_add(lcnt + e1, 1u, __ATOMIC_RELAXED, __HIP_MEMORY_SCOPE_WORKGROUP);
                int* rt = route + (size_t)row * 8; rt[0] = e0; rt[1] = e1; rt[2] = __float_as_int(g0); rt[3] = __float_as_int(g1); rt[4] = s0; rt[5] = s1;
            }
        }
    }
    if (MODE == 1) {
        __syncthreads();
        if (tidf < NE) { unsigned* cnt = (unsigned*)(P.ws + WS_CTL) + CW_CNT + 64 * j; lcnt[8 + tidf] = atomicAdd(cnt + tidf, lcnt[tidf]); }
        __syncthreads();
        { const int row = r_begin + lane; if (row < r_end) { int* rt = route + (size_t)row * 8; const int e0 = rt[0], e1 = rt[1]; rt[4] += (int)lcnt[8 + e0]; rt[5] += (int)lcnt[8 + e1]; } }
        if (lane == 0) for (int row = r_begin + 64; row < r_end; ++row) { int* rt = route + (size_t)row * 8; const int e0 = rt[0], e1 = rt[1]; rt[4] += (int)lcnt[8 + e0]; rt[5] += (int)lcnt[8 + e1]; }
    }
}

__device__ __forceinline__ void ph_moe_gather(const Params& P, int j, int bid, int nblk, int mrows) {
    const int tidf = tid_fresh(); const int wave = tidf >> 6, lane = tidf & 63, gw = bid * NWAVES + wave, ngw = nblk * NWAVES;
    const unsigned* cnt = (const unsigned*)(P.ws + WS_CTL) + CW_CNT + 64 * j;
    int off[NE], pad[NE]; int acc = 0;
#pragma unroll
    for (int e = 0; e < NE; ++e) { off[e] = acc; const int c = (int)__hip_atomic_load(cnt + e, __ATOMIC_RELAXED, __HIP_MEMORY_SCOPE_AGENT); pad[e] = ((c + 255) >> 8) << 8; acc += pad[e]; }
    int* tilex = (int*)(P.ws + WS_TILEX);
    if (bid == 0 && tidf < 256) {
        const int t = tidf;
        if (t == 255) tilex[255] = acc >> 8;
        else if (t < MOE_TILES) { int ex = 0;
#pragma unroll
            for (int e = 0; e < NE; ++e) if (t * 256 >= off[e] && t * 256 < off[e] + pad[e]) ex = e;
            tilex[t] = ex; }
    }
    int* route = (int*)(P.ws + WS_ROUTE);
    const f16* H = (const f16*)(P.ws + WS_H); f16* Xp = (f16*)(P.ws + WS_XP);
    for (int row = gw; row < mrows; row += ngw) {
        int* rt = route + (size_t)row * 8;
        const int rtv = rt[lane & 7];
        const int e0 = __shfl(rtv, 0), e1 = __shfl(rtv, 1), s0 = __shfl(rtv, 4), s1 = __shfl(rtv, 5);
        int o0 = 0, o1 = 0;
#pragma unroll
        for (int e = 0; e < NE; ++e) { if (e == e0) o0 = off[e]; if (e == e1) o1 = off[e]; }
        const int p0 = o0 + s0, p1 = o1 + s1;
        if (lane == 0) { rt[6] = p0; rt[7] = p1; }
        const u32x4* src = (const u32x4*)(H + (size_t)row * D);
        const u32x4 a = src[lane], b = src[lane + 64];
        u32x4* d0 = (u32x4*)(Xp + (size_t)p0 * D); u32x4* d1 = (u32x4*)(Xp + (size_t)p1 * D);
        d0[lane] = a; d0[lane + 64] = b; d1[lane] = a; d1[lane + 64] = b;
    }
}

__device__ __forceinline__ void ph_rope_table(const Params& P, int bid, int nblk) {
    float* T = (float*)(P.ws + WS_ROPET);
    for (int idx = bid * NTHREADS + tid_fresh(); idx < 64 * 64; idx += nblk * NTHREADS) {
        const int pos = idx >> 6, i = idx & 63;
        const float inv = exp2f(-(float)i * (13.287712379549449f / 64.0f));
        float sn, cs; sincosf((float)pos * inv, &sn, &cs);
        T[2 * idx] = cs; T[2 * idx + 1] = sn;
    }
}
__device__ __forceinline__ f16x4 tr_read(LAS unsigned char* p) { const s16x4 v = __builtin_amdgcn_ds_read_tr16_b64_v4i16((LAS s16x4*)p); return __builtin_bit_cast(f16x4, v); }
__device__ __forceinline__ f16x8 cat8(const f16x4 a, const f16x4 b) { return __builtin_shufflevector(a, b, 0, 1, 2, 3, 4, 5, 6, 7); }
constexpr int RC = 64, RNCH = (CL + SEQ) / RC;
constexpr int SC = 32, SNCH = (CL + SEQ) / SC;
__device__ __forceinline__ int chunk_row0(int b, int c) { return c < CL / RC ? TX + b * CL + c * RC : b * SEQ + (c - CL / RC) * RC; }
__device__ __forceinline__ int schunk_row0(int b, int c) { return c < CL / SC ? TX + b * CL + c * SC : b * SEQ + (c - CL / SC) * SC; }

__device__ __forceinline__ void ph_ret_pm(const Params& P, int j, int bid, int nblk) {
    const int tidf = tid_fresh(); const int wave = tidf >> 6, lane = tidf & 63, gw = bid * NWAVES + wave, ngw = nblk * NWAVES;
    const int li = lane & 15, g = lane >> 4;
    const f16* Pb = (const f16*)(P.ws + WS_P); f16* PM = (f16*)(P.ws + WS_PM);
    for (int item = gw; item < 16 * SNCH; item += ngw) {
        const int bh = item / SNCH, c = item % SNCH, b = bh >> 2, h = bh & 3;
        const int row0 = schunk_row0(b, c);
        const float l2f = P.ret_ld[(j * 2 + 0) * 4 + h] * 1.4426950408889634f, l2b = P.ret_ld[(j * 2 + 1) * 4 + h] * 1.4426950408889634f;
        f32x4 acc[2][2];
#pragma unroll
        for (int sb = 0; sb < 2; ++sb)
#pragma unroll
            for (int tb = 0; tb < 2; ++tb) acc[sb][tb] = (f32x4){0.f, 0.f, 0.f, 0.f};
        const f16* kbase = Pb + (size_t)(row0 + li) * ODD_IN + 1024 + h * 256 + 8 * g;
        const f16* qbase = Pb + (size_t)(row0 + li) * ODD_IN + h * 256 + 8 * g;
        f16x8 kf[8][2], qf[8][2];
#pragma unroll
        for (int kk = 0; kk < 8; ++kk)
#pragma unroll
            for (int x = 0; x < 2; ++x) { kf[kk][x] = *(const f16x8*)(kbase + (size_t)(16 * x) * ODD_IN + 32 * kk); qf[kk][x] = *(const f16x8*)(qbase + (size_t)(16 * x) * ODD_IN + 32 * kk); }
#pragma unroll
        for (int kk = 0; kk < 8; ++kk)
#pragma unroll
            for (int sb = 0; sb < 2; ++sb)
#pragma unroll
                for (int tb = 0; tb < 2; ++tb) acc[sb][tb] = __builtin_amdgcn_mfma_f32_16x16x32_f16(kf[kk][sb], qf[kk][tb], acc[sb][tb], 0, 0, 0);
        f16* out = PM + (size_t)item * SC * SC;
#pragma unroll
        for (int sb = 0; sb < 2; ++sb)
#pragma unroll
            for (int tb = 0; tb < 2; ++tb) { const int t = 16 * tb + li; f16x4 o;
#pragma unroll
                for (int r = 0; r < 4; ++r) { const int sidx = 16 * sb + 4 * g + r; const int df = t - sidx;
                    const float w = df == 0 ? 2.0f : (df > 0 ? exp2f((float)df * l2f) : exp2f((float)(-df) * l2b));
                    o[r] = (f16)(acc[sb][tb][r] * w); }
                *(f16x4*)(out + (size_t)t * SC + 16 * sb + 4 * g) = o; }
    }
}

constexpr int RS_PP = 1024, RS_VG = 1088;
constexpr int RS_Q = 0, RS_K = 16 * RS_PP, RS_V = 32 * RS_PP, RS_BUF = RS_V + 4 * RS_VG;
__device__ __forceinline__ void ph_ret_scan(const Params& P, int j, LAS unsigned char* lds, int bid, int nblk) {
    const int tid = tid_fresh(); const int wave = __builtin_amdgcn_readfirstlane(tid >> 6), lane = tid & 63, li = lane & 15, g = lane >> 4;
    const bool producer = wave >= 4; const int vb = wave & 3, pw = wave & 3;
    const f16* Pb = (const f16*)(P.ws + WS_P); f16* OD = (f16*)(P.ws + WS_OD);
    for (int it0 = bid; it0 < 256; it0 += nblk) {
        const int item = (nblk == 256) ? ((it0 & 7) * 32 + (it0 >> 3)) : it0;
        const int vs = item & 7, dir = (item >> 3) & 1, h = (item >> 4) & 3, b = item >> 6;
        const float l2 = P.ret_ld[(j * 2 + dir) * 4 + h] * 1.4426950408889634f;
        const float g32 = exp2f(32.0f * l2);
        f32x4 S[16];
#pragma unroll
        for (int x = 0; x < 16; ++x) S[x] = (f32x4){0.f, 0.f, 0.f, 0.f};
        f16x8 wv;
#pragma unroll
        for (int e = 0; e < 8; ++e) { const int sI = 8 * g + e; wv[e] = (f16)exp2f((float)(dir ? sI : 31 - sI) * l2); }
        auto chunk_of = [&](int ci) { return dir == 0 ? ci : (ci < 8 ? 7 - ci : 8 + (127 - (ci - 8))); };
        auto issue = [&](int ci) {
            const int row0 = schunk_row0(b, chunk_of(ci));
            LAS unsigned char* base = lds + (ci & 3) * RS_BUF;
#pragma unroll
            for (int x = 0; x < 4; ++x) { const int pr = 4 * pw + x; const f16* rowp = Pb + (size_t)(row0 + 2 * pr + (lane >> 5)) * ODD_IN + h * 256;
                const int rowi = 2 * pr + (lane >> 5);
                __builtin_amdgcn_global_load_lds((const unsigned*)(rowp + (((lane & 31) ^ (rowi & 15)) * 8)), (LAS unsigned*)(base + RS_Q + pr * RS_PP), 16, 0, 0);
                __builtin_amdgcn_global_load_lds((const unsigned*)(rowp + 1024 + (((lane & 31) ^ (4 * (rowi & 3))) * 8)), (LAS unsigned*)(base + RS_K + pr * RS_PP), 16, 0, 0); }
            __builtin_amdgcn_global_load_lds((const unsigned*)(Pb + (size_t)(row0 + 8 * pw + (lane >> 3)) * ODD_IN + 2048 + h * 512 + vs * 64 + (lane & 7) * 8), (LAS unsigned*)(base + RS_V + pw * RS_VG), 16, 0, 0);
        };
        asm volatile("s_waitcnt vmcnt(0) lgkmcnt(0)" ::: "memory"); __builtin_amdgcn_s_barrier(); asm volatile("" ::: "memory");
        if (producer) { issue(0); issue(1); issue(2); asm volatile("s_waitcnt vmcnt(18)" ::: "memory"); }
        if (producer) {
            for (int ci = 0; ci < SNCH; ++ci) {
                asm volatile("" ::: "memory"); __builtin_amdgcn_s_barrier(); asm volatile("" ::: "memory");
                if (ci + 3 < SNCH) { issue(ci + 3); asm volatile("s_waitcnt vmcnt(18)" ::: "memory"); }
                else if (ci + 2 < SNCH) asm volatile("s_waitcnt vmcnt(9)" ::: "memory");
                else asm volatile("s_waitcnt vmcnt(0)" ::: "memory");
            }
        } else {
            for (int ci = 0; ci < SNCH; ++ci) {
                asm volatile("" ::: "memory"); __builtin_amdgcn_s_barrier(); asm volatile("" ::: "memory");
                LAS unsigned char* base = lds + (ci & 3) * RS_BUF;
                const int row0 = schunk_row0(b, chunk_of(ci));
                f16x8 qfr[8][2];
#pragma unroll
                for (int kk = 0; kk < 8; ++kk)
#pragma unroll
                    for (int tb = 0; tb < 2; ++tb) { const int t = 16 * tb + li;
                        qfr[kk][tb] = *(LAS f16x8*)(base + RS_Q + t * 512 + (((4 * kk + g) ^ (t & 15)) * 16)); }
                const int sr = 8 * g + (li >> 2);
                LAS unsigned char* vp = base + RS_V + (sr >> 3) * RS_VG + (sr & 7) * 128 + (vb * 16 + 4 * (li & 3)) * 2;
                f16x8 vf = cat8(tr_read(vp), tr_read(vp + 4 * 128));
                __builtin_amdgcn_sched_barrier(0);
                f32x4 o[2];
                o[0] = (f32x4){0.f, 0.f, 0.f, 0.f}; o[1] = (f32x4){0.f, 0.f, 0.f, 0.f};
#pragma unroll
                for (int kk = 0; kk < 8; ++kk) {
                    f16x8 sf;
#pragma unroll
                    for (int r = 0; r < 4; ++r) { sf[r] = (f16)S[2 * kk][r]; sf[4 + r] = (f16)S[2 * kk + 1][r]; }
#pragma unroll
                    for (int tb = 0; tb < 2; ++tb) o[tb] = __builtin_amdgcn_mfma_f32_16x16x32_f16(sf, qfr[kk][tb], o[tb], 0, 0, 0);
                }
                LAS unsigned char* kp0 = base + RS_K + sr * 512 + (8 * (li & 3)) * 2;
                const int ksw = sr & 3;
                f16x8 kfr[16];
#pragma unroll
                for (int db = 0; db < 16; ++db) { LAS unsigned char* kp = kp0 + 64 * ((db >> 1) ^ ksw) + 8 * (db & 1); kfr[db] = cat8(tr_read(kp), tr_read(kp + 4 * 512)); }
                __builtin_amdgcn_sched_barrier(0);
#pragma unroll
                for (int tb = 0; tb < 2; ++tb) { const int t = 16 * tb + li; const float sc = exp2f((float)((dir ? 31 - t : t) + 1) * l2);
                    f16x4 ov; ov[0] = (f16)(o[tb][0] * sc); ov[1] = (f16)(o[tb][1] * sc); ov[2] = (f16)(o[tb][2] * sc); ov[3] = (f16)(o[tb][3] * sc);
                    const f16* optr = OD + ((size_t)dir * M + row0 + t) * 2048 + h * 512 + vs * 64 + vb * 16 + 4 * g; const u32x2 od = __builtin_bit_cast(u32x2, ov);
                    asm volatile("global_store_dwordx2 %0, %1, off\n\ts_nop 1" :: "v"(optr), "v"(od) : "memory"); }
                vf = vf * wv;
#pragma unroll
                for (int db = 0; db < 16; ++db) S[db] = __builtin_amdgcn_mfma_f32_16x16x32_f16(kfr[db], vf, S[db] * g32, 0, 0, 0);
                asm volatile("s_waitcnt lgkmcnt(0)" ::: "memory");
            }
        }
    }
    asm volatile("s_waitcnt vmcnt(0) lgkmcnt(0)" ::: "memory"); __syncthreads();
}

constexpr int RF_VP = 1040, RF_PP = 80;
constexpr int RF_V = 0, RF_P = RC * RF_VP, RF_ST = RF_P + RC * RF_PP;
__device__ __forceinline__ void ph_ret_final(const Params& P, LAS unsigned char* lds, int bid, int nblk) {
    const int tid = tid_fresh(); const int wave = __builtin_amdgcn_readfirstlane(tid >> 6), lane = tid & 63, li = lane & 15, g = lane >> 4;
    const f16* Pb = (const f16*)(P.ws + WS_P); const f16* OD = (const f16*)(P.ws + WS_OD); const f16* PM = (const f16*)(P.ws + WS_PM); f16* MIX = (f16*)(P.ws + WS_MIX);
    u32x4 pv[8]; u32x2 pp;
    auto prefetch = [&](int item) {
        const int bh = item / RNCH, c = item % RNCH, b = bh >> 2, h = bh & 3; const int row0 = chunk_row0(b, c);
#pragma unroll
        for (int x = 0; x < 8; ++x) { const int p = tid + 512 * x; pv[x] = *(const u32x4*)(Pb + (size_t)(row0 + (p >> 6)) * ODD_IN + 2048 + h * 512 + (p & 63) * 8); }
        pp = *(const u32x2*)(PM + ((size_t)(bh * SNCH + 2 * c) * SC + (tid >> 3)) * SC + (tid & 7) * 4);
    };
    if (bid < 16 * RNCH) prefetch(bid);
    for (int item = bid; item < 16 * RNCH; item += nblk) {
        const int bh = item / RNCH, c = item % RNCH, b = bh >> 2, h = bh & 3;
        const int row0 = chunk_row0(b, c);
        LDS_BARRIER();
#pragma unroll
        for (int x = 0; x < 8; ++x) { const int p = tid + 512 * x; *(LAS u32x4*)(lds + RF_V + (p >> 6) * RF_VP + (p & 63) * 16) = pv[x]; }
        *(LAS u32x2*)(lds + RF_P + (tid >> 3) * RF_PP + (tid & 7) * 8) = pp;
        f16x8 oda[4][2], odb[4][2];
#pragma unroll
        for (int tb = 0; tb < 4; ++tb) { const size_t rr = (size_t)(row0 + 16 * tb + li) * 2048 + h * 512 + 64 * wave + 16 * g;
            oda[tb][0] = *(const f16x8*)(OD + rr); oda[tb][1] = *(const f16x8*)(OD + rr + 8); odb[tb][0] = *(const f16x8*)(OD + (size_t)M * 2048 + rr); odb[tb][1] = *(const f16x8*)(OD + (size_t)M * 2048 + rr + 8); }
        if (item + nblk < 16 * RNCH) prefetch(item + nblk);
        LDS_BARRIER();
        f32x4 acc[4][4];
        {
            f16x8 pf[4];
#pragma unroll
            for (int tb = 0; tb < 4; ++tb) pf[tb] = *(LAS f16x8*)(lds + RF_P + (16 * tb + li) * RF_PP + (8 * g) * 2);
#pragma unroll
            for (int vb = 0; vb < 4; ++vb) {
#pragma unroll
                for (int hf = 0; hf < 2; ++hf) {
                    LAS unsigned char* vp = lds + RF_V + (32 * hf + 8 * g + (li >> 2)) * RF_VP + (64 * wave + 16 * (li & 3) + 4 * vb) * 2;
                    const f16x8 vf = cat8(tr_read(vp), tr_read(vp + 4 * RF_VP));
#pragma unroll
                    for (int t2 = 0; t2 < 2; ++t2) acc[vb][2 * hf + t2] = __builtin_amdgcn_mfma_f32_16x16x32_f16(vf, pf[2 * hf + t2], (f32x4){0.f, 0.f, 0.f, 0.f}, 0, 0, 0);
                }
            }
        }
        float sum[4];
#pragma unroll
        for (int tb = 0; tb < 4; ++tb) { sum[tb] = 0.f;
            const f16x8 a0 = oda[tb][0], a1 = oda[tb][1], b0 = odb[tb][0], b1 = odb[tb][1];
#pragma unroll
            for (int vb = 0; vb < 4; ++vb)
#pragma unroll
                for (int r = 0; r < 4; ++r) { const int e = 4 * (vb & 1) + r; acc[vb][tb][r] += vb < 2 ? (float)a0[e] + (float)b0[e] : (float)a1[e] + (float)b1[e]; sum[tb] += acc[vb][tb][r]; } }
        LAS float* st = (LAS float*)(lds + RF_ST);
#pragma unroll
        for (int tb = 0; tb < 4; ++tb) { sum[tb] += __shfl_xor(sum[tb], 16); sum[tb] += __shfl_xor(sum[tb], 32); if (g == 0) st[(16 * tb + li) * 8 + wave] = sum[tb]; }
        LDS_BARRIER();
        float mean[4], var[4];
#pragma unroll
        for (int tb = 0; tb < 4; ++tb) { const f32x4 s0 = *(const LAS f32x4*)(st + (16 * tb + li) * 8), s1 = *(const LAS f32x4*)(st + (16 * tb + li) * 8 + 4);
            mean[tb] = ((s0[0] + s0[1]) + (s0[2] + s0[3]) + (s1[0] + s1[1]) + (s1[2] + s1[3])) * (1.f / 512.f); var[tb] = 0.f;
#pragma unroll
            for (int vb = 0; vb < 4; ++vb)
#pragma unroll
                for (int r = 0; r < 4; ++r) { acc[vb][tb][r] -= mean[tb]; var[tb] += acc[vb][tb][r] * acc[vb][tb][r]; } }
        LDS_BARRIER();
#pragma unroll
        for (int tb = 0; tb < 4; ++tb) { var[tb] += __shfl_xor(var[tb], 16); var[tb] += __shfl_xor(var[tb], 32); if (g == 0) st[(16 * tb + li) * 8 + wave] = var[tb]; }
        LDS_BARRIER();
#pragma unroll
        for (int tb = 0; tb < 4; ++tb) { const f32x4 s0 = *(const LAS f32x4*)(st + (16 * tb + li) * 8), s1 = *(const LAS f32x4*)(st + (16 * tb + li) * 8 + 4);
            const float vv = ((s0[0] + s0[1]) + (s0[2] + s0[3]) + (s1[0] + s1[1]) + (s1[2] + s1[3])) * (1.f / 512.f);
            const float rstd = 1.0f / sqrtf(vv + LN_EPS);
            const size_t prow = (size_t)(row0 + 16 * tb + li);
            { const int col = h * 512 + 64 * wave + 16 * g;
              const f16x8 g0 = *(const f16x8*)(Pb + prow * ODD_IN + 4096 + col), g1 = *(const f16x8*)(Pb + prow * ODD_IN + 4096 + col + 8); f16x8 o0, o1;
#pragma unroll
              for (int vb = 0; vb < 4; ++vb)
#pragma unroll
                  for (int r = 0; r < 4; ++r) { const int e = 4 * (vb & 1) + r; const float gq = vb < 2 ? (float)g0[e] : (float)g1[e]; const f16 y = (f16)(acc[vb][tb][r] * rstd * silu_f(gq)); if (vb < 2) o0[e] = y; else o1[e] = y; }
              *(f16x8*)(MIX + prow * 2048 + col) = o0; *(f16x8*)(MIX + prow * 2048 + col + 8) = o1; } }
    }
    __syncthreads();
}

constexpr int HC = 32, HNSEG = 16, HP = 272;
__device__ __forceinline__ int hseg_c0(int s) { return (17 * s) >> 1; }
constexpr int H_QB = 0, H_KB = HC * HP, H_Q16 = 2 * HC * HP, H_KE = 3 * HC * HP, H_V = 4 * HC * HP, H_GC = 5 * HC * HP, H_TOT = H_GC + 512;
__device__ __forceinline__ int hchunk_row0(int b, int dir, int p) { return p < 8 ? TX + b * CL + HC * (dir ? 7 - p : p) : b * SEQ + HC * (dir ? 135 - p : p - 8); }

__device__ __forceinline__ void ph_hgrn_local(const Params& P, int j, LAS unsigned char* lds, int bid, int nblk) {
    const int tid = tid_fresh(); const int wave = __builtin_amdgcn_readfirstlane(tid >> 6), lane = tid & 63, li = lane & 15, g = lane >> 4;
    const f16* Pb = (const f16*)(P.ws + WS_P); f16* OD = (f16*)(P.ws + WS_OD); f16* QD = (f16*)(P.ws + WS_HQD);
    float* UT = (float*)(P.ws + WS_HUT); float* GT = (float*)(P.ws + WS_HGT);
    for (int item = bid; item < 32 * HNSEG; item += nblk) {
        const int sidx = (item + (item >> 8)) & 15, bhd = item >> 4, dir = bhd & 1, h = (bhd >> 1) & 3, b = bhd >> 3;
        const int p0 = hseg_c0(sidx), nch = hseg_c0(sidx + 1) - p0; const int it = bhd * HNSEG + sidx;
        float lbv[2];
#pragma unroll
        for (int e = 0; e < 2; ++e) { const int cidx = h * 128 + 2 * lane + e;
            if (j == 0) lbv[e] = 0.f; else { const float l0 = P.hg_lb[(dir * 2 + 0) * 512 + cidx], l1 = P.hg_lb[(dir * 2 + 1) * 512 + cidx]; lbv[e] = 1.0f / (1.0f + __expf(l0 - l1)); } }
        float eseg[2] = {1.f, 1.f};
        f32x4 S[8];
#pragma unroll
        for (int x = 0; x < 8; ++x) S[x] = (f32x4){0.f, 0.f, 0.f, 0.f};
        f16x2 zc[4], qc[4]; u32x4 vc;
        auto load_chunk = [&](int cc) {
            const int row0 = hchunk_row0(b, dir, p0 + cc);
#pragma unroll
            for (int xs = 0; xs < 4; ++xs) { const int x = dir ? 3 - xs : xs; const f16* pr = Pb + (size_t)(row0 + 4 * wave + x) * EVEN_IN + h * 128 + 2 * lane;
                zc[xs] = *(const f16x2*)(pr + 2048 + dir * 512); qc[xs] = *(const f16x2*)(pr + 1536); }
            vc = *(const u32x4*)(Pb + (size_t)(row0 + (tid >> 4)) * EVEN_IN + 3072 + h * 128 + (tid & 15) * 8);
        };
        load_chunk(0);
        for (int cc = 0; cc < nch; ++cc) {
            const int row0 = hchunk_row0(b, dir, p0 + cc);
            LDS_BARRIER();
            *(LAS u32x4*)(lds + H_V + (tid >> 4) * HP + (tid & 15) * 16) = vc;
            float lc[4][2], kv[4][2], qv[4][2]; float run[2] = {0.f, 0.f};
#pragma unroll
            for (int xs = 0; xs < 4; ++xs) { const f16x2 z2 = zc[xs], q2 = qc[xs];
#pragma unroll
                for (int e = 0; e < 2; ++e) { const float z = (float)z2[e]; const float sg = __builtin_amdgcn_rcpf(1.0f + __expf(-z)); const float f = lbv[e] + (1.0f - lbv[e]) * sg;
                    run[e] += __logf(f); lc[xs][e] = run[e]; kv[xs][e] = (1.0f - lbv[e]) * (1.0f - sg); qv[xs][e] = silu_f((float)q2[e]); } }
            *(LAS f32x2*)(lds + H_TOT + (wave * 128 + 2 * lane) * 4) = (f32x2){run[0], run[1]};
            if (cc + 1 < nch) load_chunk(cc + 1);
            LDS_BARRIER();
            float offs[2] = {0.f, 0.f}, cl[2] = {0.f, 0.f};
#pragma unroll
            for (int gq = 0; gq < 8; ++gq) { const f32x2 t2 = *(const LAS f32x2*)(lds + H_TOT + (gq * 128 + 2 * lane) * 4); const bool before = dir ? (gq > wave) : (gq < wave);
                cl[0] += t2[0]; cl[1] += t2[1]; if (before) { offs[0] += t2[0]; offs[1] += t2[1]; } }
            const float gc0 = __expf(cl[0]), gc1 = __expf(cl[1]);
#pragma unroll
            for (int xs = 0; xs < 4; ++xs) { const int x = dir ? 3 - xs : xs; const int i = 4 * wave + x;
                float qs[2], ks[2], ke[2], qd[2];
#pragma unroll
                for (int e = 0; e < 2; ++e) { const float cum = offs[e] + lc[xs][e]; const float cumc = fmaxf(cum, -80.0f); const float e1 = __expf(cumc);
                    qs[e] = qv[xs][e] * e1; ks[e] = kv[xs][e] * __expf(-cumc); ke[e] = kv[xs][e] * __expf(cl[e] - cum); qd[e] = qs[e] * eseg[e]; }
                bf16x2 qb, kb; qb[0] = (__bf16)qs[0]; qb[1] = (__bf16)qs[1]; kb[0] = (__bf16)ks[0]; kb[1] = (__bf16)ks[1];
                f16x2 q16, k16, qd16; q16[0] = (f16)qs[0]; q16[1] = (f16)qs[1]; k16[0] = (f16)ke[0]; k16[1] = (f16)ke[1]; qd16[0] = (f16)qd[0]; qd16[1] = (f16)qd[1];
                *(LAS bf16x2*)(lds + H_QB + i * HP + lane * 4) = qb; *(LAS bf16x2*)(lds + H_KB + i * HP + lane * 4) = kb;
                *(LAS f16x2*)(lds + H_Q16 + i * HP + lane * 4) = q16; *(LAS f16x2*)(lds + H_KE + i * HP + lane * 4) = k16;
                *(f16x2*)(QD + ((size_t)dir * M + row0 + i) * 512 + h * 128 + 2 * lane) = qd16; }
            if (wave == 0) *(LAS f32x2*)(lds + H_GC + lane * 8) = (f32x2){gc0, gc1};
            eseg[0] *= gc0; eseg[1] *= gc1;
            LDS_BARRIER();
            bf16x8 kf[2][4], qf[2][4];
#pragma unroll
            for (int kk = 0; kk < 4; ++kk)
#pragma unroll
                for (int x = 0; x < 2; ++x) { kf[x][kk] = *(const LAS bf16x8*)(lds + H_KB + (16 * x + li) * HP + (32 * kk + 8 * g) * 2); qf[x][kk] = *(const LAS bf16x8*)(lds + H_QB + (16 * x + li) * HP + (32 * kk + 8 * g) * 2); }
            __builtin_amdgcn_sched_barrier(0);
            f32x4 at[2][2];
#pragma unroll
            for (int sb = 0; sb < 2; ++sb)
#pragma unroll
                for (int tb = 0; tb < 2; ++tb) at[sb][tb] = (f32x4){0.f, 0.f, 0.f, 0.f};
#pragma unroll
            for (int kk = 0; kk < 4; ++kk)
#pragma unroll
                for (int sb = 0; sb < 2; ++sb)
#pragma unroll
                    for (int tb = 0; tb < 2; ++tb) at[sb][tb] = __builtin_amdgcn_mfma_f32_16x16x32_bf16(kf[sb][kk], qf[tb][kk], at[sb][tb], 0, 0, 0);
            f16x8 vfp, vfn, af[2][4], kef[8]; f32x4 gcv[8];
            { LAS unsigned char* vp = lds + H_V + (4 * g + (li >> 2)) * HP + (16 * wave + 4 * (li & 3)) * 2; vfp = cat8(tr_read(vp), tr_read(vp + 16 * HP));
              LAS unsigned char* vp2 = lds + H_V + (8 * g + (li >> 2)) * HP + (16 * wave + 4 * (li & 3)) * 2; vfn = cat8(tr_read(vp2), tr_read(vp2 + 4 * HP)); }
#pragma unroll
            for (int kk = 0; kk < 4; ++kk)
#pragma unroll
                for (int tb = 0; tb < 2; ++tb) af[tb][kk] = *(const LAS f16x8*)(lds + H_Q16 + (16 * tb + li) * HP + (32 * kk + 8 * g) * 2);
#pragma unroll
            for (int db = 0; db < 8; ++db) { LAS unsigned char* kp = lds + H_KE + (8 * g + (li >> 2)) * HP + (32 * (db >> 1) + 8 * (li & 3) + 4 * (db & 1)) * 2;
                kef[db] = cat8(tr_read(kp), tr_read(kp + 4 * HP)); gcv[db] = *(const LAS f32x4*)(lds + H_GC + (32 * (db >> 1) + 8 * g + 4 * (db & 1)) * 4); }
            __builtin_amdgcn_sched_barrier(0);
            f16x8 pa[2];
#pragma unroll
            for (int tb = 0; tb < 2; ++tb)
#pragma unroll
                for (int sb = 0; sb < 2; ++sb)
#pragma unroll
                    for (int r = 0; r < 4; ++r) { const int si = 16 * sb + 4 * g + r, ti = 16 * tb + li; const bool keep = dir ? (si >= ti) : (si <= ti);
                        pa[tb][4 * sb + r] = (f16)(keep ? at[sb][tb][r] : 0.f); }
            f32x4 o[2];
#pragma unroll
            for (int tb = 0; tb < 2; ++tb) o[tb] = __builtin_amdgcn_mfma_f32_16x16x32_f16(vfp, pa[tb], (f32x4){0.f, 0.f, 0.f, 0.f}, 0, 0, 0);
#pragma unroll
            for (int kk = 0; kk < 4; ++kk) {
                f16x8 sf;
#pragma unroll
                for (int r = 0; r < 4; ++r) { sf[r] = (f16)S[2 * kk][r]; sf[4 + r] = (f16)S[2 * kk + 1][r]; }
#pragma unroll
                for (int tb = 0; tb < 2; ++tb) o[tb] = __builtin_amdgcn_mfma_f32_16x16x32_f16(sf, af[tb][kk], o[tb], 0, 0, 0);
            }
#pragma unroll
            for (int tb = 0; tb < 2; ++tb) { f16x4 ov; ov[0] = (f16)o[tb][0]; ov[1] = (f16)o[tb][1]; ov[2] = (f16)o[tb][2]; ov[3] = (f16)o[tb][3];
                *(f16x4*)(OD + ((size_t)dir * M + row0 + 16 * tb + li) * 512 + h * 128 + 16 * wave + 4 * g) = ov; }
#pragma unroll
            for (int db = 0; db < 8; ++db) S[db] = __builtin_amdgcn_mfma_f32_16x16x32_f16(kef[db], vfn, S[db] * gcv[db], 0, 0, 0);
        }
#pragma unroll
        for (int db = 0; db < 8; ++db) *(f32x4*)(UT + ((size_t)it * 128 + 16 * wave + li) * 128 + 32 * (db >> 1) + 8 * g + 4 * (db & 1)) = S[db];
        if (wave == 0) *(f32x2*)(GT + (size_t)it * 128 + 2 * lane) = (f32x2){eseg[0], eseg[1]};
    }
    __syncthreads();
}
__device__ __forceinline__ void ph_hgrn_carry(const Params& P, int bid, int nblk) {
    const float* UT = (const float*)(P.ws + WS_HUT); const float* GT = (const float*)(P.ws + WS_HGT); f16* ST = (f16*)(P.ws + WS_HST);
    for (int idx = bid * NTHREADS + tid_fresh(); idx < 32 * 128 * 32; idx += nblk * NTHREADS) {
        const int d4 = idx & 31, v = (idx >> 5) & 127, bhd = idx >> 12;
        f32x4 Sv = *(const f32x4*)(UT + ((size_t)(bhd * HNSEG) * 128 + v) * 128 + 4 * d4);
#pragma unroll
        for (int s0 = 1; s0 < HNSEG; s0 += 8) {
            f32x4 Gs[8], Us[8];
#pragma unroll
            for (int x = 0; x < 8; ++x) if (s0 + x < HNSEG) { const size_t it = (size_t)bhd * HNSEG + s0 + x; Gs[x] = *(const f32x4*)(GT + it * 128 + 4 * d4); Us[x] = *(const f32x4*)(UT + (it * 128 + v) * 128 + 4 * d4); }
#pragma unroll
            for (int x = 0; x < 8; ++x) if (s0 + x < HNSEG) { const size_t it = (size_t)bhd * HNSEG + s0 + x;
                f16x4 hv; hv[0] = (f16)Sv[0]; hv[1] = (f16)Sv[1]; hv[2] = (f16)Sv[2]; hv[3] = (f16)Sv[3];
                *(f16x4*)(ST + (it * 128 + v) * 128 + 4 * d4) = hv;
                Sv = Gs[x] * Sv + Us[x]; }
        }
    }
}
constexpr int HF_P = 256;
__device__ __forceinline__ void ph_hgrn_final(const Params& P, int j, LAS unsigned char* lds, int bid, int nblk) {
    const int tid = tid_fresh(); const int wave = __builtin_amdgcn_readfirstlane(tid >> 6), lane = tid & 63, li = lane & 15, g = lane >> 4;
    const f16* Pb = (const f16*)(P.ws + WS_P); const f16* OD = (const f16*)(P.ws + WS_OD); const f16* QD = (const f16*)(P.ws + WS_HQD); const f16* ST = (const f16*)(P.ws + WS_HST);
    f16* MIX = (f16*)(P.ws + WS_MIX); const float* ng = P.hg_norm_g + j * 128;
    for (int item = bid; item < 16 * HNSEG; item += nblk) {
        const int k = item & 15, bh = item >> 4, b = bh >> 2, h = bh & 3;
        const int c0 = hseg_c0(k), ntok = (hseg_c0(k + 1) - c0) * HC;
        const int blockrow0 = k == 0 ? TX + b * CL : b * SEQ + HC * (c0 - 8);
        u32x4 st[2][4]; f16x8 bq[2][4];
        f16x4 oa[8], ob[8], gv[8];
        if (k > 0) {
#pragma unroll
            for (int dir = 0; dir < 2; ++dir) { const int sidx = dir ? 16 - k : k; const size_t it = (size_t)(bh * 2 + dir) * HNSEG + sidx;
#pragma unroll
                for (int x = 0; x < 4; ++x) { const int p = tid + 512 * x; st[dir][x] = *(const u32x4*)(ST + (it * 128 + (p >> 4)) * 128 + (p & 15) * 8); } }
        }
        auto req = [&](int t0) {
            const size_t row = (size_t)(blockrow0 + t0 + li);
            if (k > 0) {
#pragma unroll
                for (int dir = 0; dir < 2; ++dir)
#pragma unroll
                    for (int kk = 0; kk < 4; ++kk) bq[dir][kk] = *(const f16x8*)(QD + ((size_t)dir * M + row) * 512 + h * 128 + 32 * kk + 8 * g); }
#pragma unroll
            for (int vb = 0; vb < 8; ++vb) { oa[vb] = *(const f16x4*)(OD + row * 512 + h * 128 + 32 * g + 4 * vb); ob[vb] = *(const f16x4*)(OD + ((size_t)M + row) * 512 + h * 128 + 32 * g + 4 * vb);
                gv[vb] = *(const f16x4*)(Pb + row * EVEN_IN + 3584 + h * 128 + 32 * g + 4 * vb); }
        };
        int t0 = 16 * wave;
        req(t0);
        __syncthreads();
        if (k > 0) {
#pragma unroll
            for (int dir = 0; dir < 2; ++dir)
#pragma unroll
                for (int x = 0; x < 4; ++x) { const int p = tid + 512 * x, v = p >> 4; *(LAS u32x4*)(lds + (dir * 128 + v) * HF_P + (((p & 15) ^ (4 * ((v >> 5) & 3) + (v & 3))) * 16)) = st[dir][x]; }
        }
        LDS_BARRIER();
        for (;;) {
            const size_t row = (size_t)(blockrow0 + t0 + li);
            f32x4 acc[8];
#pragma unroll
            for (int vb = 0; vb < 8; ++vb) acc[vb] = (f32x4){0.f, 0.f, 0.f, 0.f};
            if (k > 0) {
#pragma unroll
                for (int dir = 0; dir < 2; ++dir)
#pragma unroll
                    for (int kk = 0; kk < 4; ++kk) {
                        f16x8 af[8];
#pragma unroll
                        for (int vb = 0; vb < 8; ++vb) af[vb] = *(LAS f16x8*)(lds + (dir * 128 + 32 * (li >> 2) + 4 * vb + (li & 3)) * HF_P + (((4 * kk + g) ^ li) * 16));
#pragma unroll
                        for (int vb = 0; vb < 8; ++vb) acc[vb] = __builtin_amdgcn_mfma_f32_16x16x32_f16(af[vb], bq[dir][kk], acc[vb], 0, 0, 0);
                    }
            }
            float ss = 0.f;
#pragma unroll
            for (int vb = 0; vb < 8; ++vb) { const f16x4 a = oa[vb], bb = ob[vb];
                acc[vb] = acc[vb] + (f32x4){(float)a[0] + (float)bb[0], (float)a[1] + (float)bb[1], (float)a[2] + (float)bb[2], (float)a[3] + (float)bb[3]};
#pragma unroll
                for (int r = 0; r < 4; ++r) ss += acc[vb][r] * acc[vb][r]; }
            ss += __shfl_xor(ss, 16); ss += __shfl_xor(ss, 32);
            const float rr = 1.0f / sqrtf(ss * (1.f / 128.f) + NORM_EPS);
#pragma unroll
            for (int vb = 0; vb < 8; ++vb) { const int vc = 32 * g + 4 * vb; const f32x4 nv = *(const f32x4*)(ng + vc); f16x4 ov;
#pragma unroll
                for (int r = 0; r < 4; ++r) ov[r] = (f16)(acc[vb][r] * rr * nv[r] * silu_f((float)gv[vb][r]));
                *(f16x4*)(MIX + row * D + 512 + h * 128 + vc) = ov; }
            t0 += 128; if (t0 >= ntok) break;
            req(t0);
        }
    }
    __syncthreads();
}

constexpr int NA_P = 144;
constexpr int NA_CK = 0, NA_CV = 256 * NA_P, NA_BK = 2 * 256 * NA_P, NA_BV = NA_BK + 2 * 64 * NA_P, NA_BT = NA_BV + 2 * 64 * NA_P;
__device__ __forceinline__ void ph_na(const Params& P, int j, LAS unsigned char* lds, int bid, int nblk) {
    const int tid = tid_fresh(); const int wave = __builtin_amdgcn_readfirstlane(tid >> 6), lane = tid & 63, li = lane & 15, g = lane >> 4;
    const int wq = wave & 3, half = wave >> 2;
    const f16* Pb = (const f16*)(P.ws + WS_P); f16* MIX = (f16*)(P.ws + WS_MIX);
    LAS float* btab = (LAS float*)(lds + NA_BT + wave * 1024);
    constexpr int NX = NB * 8 * GW, NITEMS = NX + NB * 8 * (CL / 64);
    const bool xmap = (nblk == 256);
    const int npairs = NITEMS / 2, pstart = xmap ? (bid >> 3) : bid, pstep = xmap ? 32 : nblk, pend = xmap ? 136 : npairs;
    for (int lp = pstart; lp < pend; lp += pstep) {
        const int bhq = xmap ? ((bid & 7) * 4 + lp / 34) : (lp / 34), t0 = 2 * (lp % 34), t = t0 + half;
        const bool isx = t0 < 64;
        const int b = bhq >> 3, h = bhq & 7;
        int qrow, r = 0;
        if (isx) { r = t; qrow = b * SEQ + r * GW + 16 * wq + li; }
        else { qrow = TX + b * CL + 64 * (t - 64) + 16 * wq + li; }
        const int c = 16 * wq + li, cs = min(max(c - 8, 0), 48), rs = min(max(r - 4, 0), 56);
        const int rsA = min(max(t0 - 4, 0), 56), rsB = min(max(t0 + 1 - 4, 0), 56), nrows = isx ? rsB + 8 - rsA : 0;
        const int kc0 = wq == 0 ? 0 : (wq == 1 ? 8 : (wq == 2 ? 24 : 32));
        const float* rpbh = P.na_rpb + ((size_t)j * 8 + h) * 15 * 31;
        u32x4 ck[4], cv[4], bk[9], bv[9];
        { const f16* cb = Pb + (size_t)(TX + b * CL) * EVEN_IN + h * 64;
#pragma unroll
          for (int x = 0; x < 4; ++x) { const int p = tid + 512 * x; const f16* src = cb + (size_t)(p >> 3) * EVEN_IN + (p & 7) * 8; ck[x] = *(const u32x4*)(src + 512); cv[x] = *(const u32x4*)(src + 1024); } }
#pragma unroll
        for (int i = 0; i < 9; ++i) if (i < nrows) { const f16* src = Pb + (size_t)(b * SEQ + (rsA + i) * GW + (tid >> 3)) * EVEN_IN + h * 64 + (tid & 7) * 8; bk[i] = *(const u32x4*)(src + 512); bv[i] = *(const u32x4*)(src + 1024); }
        if (isx) {
#pragma unroll
            for (int x = 0; x < 4; ++x) { const int e = lane + 64 * x, bi = e >> 5, cc = e & 31; btab[e] = cc < 31 ? rpbh[(rs + bi - r + 7) * 31 + cc] : 0.f; }
        }
        f16x8 qf[2];
#pragma unroll
        for (int kk = 0; kk < 2; ++kk) { const f16x8 tq = *(const f16x8*)(Pb + (size_t)qrow * EVEN_IN + h * 64 + 32 * kk + 8 * g);
#pragma unroll
            for (int e = 0; e < 8; ++e) qf[kk][e] = (f16)((float)tq[e] * 0.125f); }
        unsigned vmask = 0u;
        const int bix0 = kc0 + 4 * g - c + 15;
#pragma unroll
        for (int jj = 0; jj < 8; ++jj) { const int mcol = kc0 + (jj < 4 ? 4 * g + jj : 16 + 4 * g + jj - 4); vmask |= ((mcol >= cs) && (mcol < cs + 16)) ? (1u << jj) : 0u; }
        f32x4 O[4];
#pragma unroll
        for (int x = 0; x < 4; ++x) O[x] = (f32x4){0.f, 0.f, 0.f, 0.f};
        float mrun = -1.0e30f, lsum = 0.f;
        auto process = [&](LAS unsigned char* kt, LAS unsigned char* vtl, int krow, int bi) {
            f16x8 kf[2][2], vf[4];
#pragma unroll
            for (int db = 0; db < 2; ++db)
#pragma unroll
                for (int kk = 0; kk < 2; ++kk) kf[db][kk] = *(LAS f16x8*)(kt + (krow + 16 * db + li) * NA_P + (32 * kk + 8 * g) * 2);
#pragma unroll
            for (int dvb = 0; dvb < 4; ++dvb) { LAS unsigned char* vp = vtl + (krow + 4 * g + (li >> 2)) * NA_P + (16 * dvb + 4 * (li & 3)) * 2; vf[dvb] = cat8(tr_read(vp), tr_read(vp + 16 * NA_P)); }
            f32x4 d1 = (f32x4){0.f, 0.f, 0.f, 0.f}, d2 = (f32x4){0.f, 0.f, 0.f, 0.f};
#pragma unroll
            for (int kk = 0; kk < 2; ++kk) { d1 = __builtin_amdgcn_mfma_f32_16x16x32_f16(kf[0][kk], qf[kk], d1, 0, 0, 0); d2 = __builtin_amdgcn_mfma_f32_16x16x32_f16(kf[1][kk], qf[kk], d2, 0, 0, 0); }
            float sc[8];
#pragma unroll
            for (int rr = 0; rr < 4; ++rr) { sc[rr] = d1[rr]; sc[4 + rr] = d2[rr]; }
            if (bi >= 0) {
                const LAS float* brow = btab + bi * 32;
                float bvv[8];
#pragma unroll
                for (int jj = 0; jj < 8; ++jj) bvv[jj] = brow[min(max(bix0 + (jj < 4 ? jj : 12 + jj), 0), 30)];
#pragma unroll
                for (int jj = 0; jj < 8; ++jj) asm volatile("" : "+v"(bvv[jj]));
#pragma unroll
                for (int jj = 0; jj < 8; ++jj) sc[jj] = ((vmask >> jj) & 1) ? sc[jj] + bvv[jj] : -1.0e30f;
            }
            float bm = fmaxf(fmaxf(fmaxf(sc[0], sc[1]), fmaxf(sc[2], sc[3])), fmaxf(fmaxf(sc[4], sc[5]), fmaxf(sc[6], sc[7])));
            bm = fmaxf(bm, __shfl_xor(bm, 16)); bm = fmaxf(bm, __shfl_xor(bm, 32));
            const float mn = fmaxf(mrun, bm), alpha = __expf(mrun - mn);
            float ps = 0.f; f16x8 pf;
#pragma unroll
            for (int jj = 0; jj < 8; ++jj) { const float pv = __expf(sc[jj] - mn); ps += pv; pf[jj] = (f16)pv; }
            lsum = lsum * alpha + ps; mrun = mn;
#pragma unroll
            for (int x = 0; x < 4; ++x) O[x] = O[x] * alpha;
#pragma unroll
            for (int dvb = 0; dvb < 4; ++dvb) O[dvb] = __builtin_amdgcn_mfma_f32_16x16x32_f16(vf[dvb], pf, O[dvb], 0, 0, 0);
        };
        __syncthreads();
#pragma unroll
        for (int x = 0; x < 4; ++x) { const int p = tid + 512 * x; *(LAS u32x4*)(lds + NA_CK + (p >> 3) * NA_P + (p & 7) * 16) = ck[x]; *(LAS u32x4*)(lds + NA_CV + (p >> 3) * NA_P + (p & 7) * 16) = cv[x]; }
        if (nrows > 0) { *(LAS u32x4*)(lds + NA_BK + (tid >> 3) * NA_P + (tid & 7) * 16) = bk[0]; *(LAS u32x4*)(lds + NA_BV + (tid >> 3) * NA_P + (tid & 7) * 16) = bv[0]; }
        LDS_BARRIER();
#pragma unroll
        for (int i = 0; i < 9; ++i) {
            if (i < nrows) {
                const int R = rsA + i; const bool active = R >= rs && R < rs + 8;
                if (active) process(lds + NA_BK + (i & 1) * 64 * NA_P, lds + NA_BV + (i & 1) * 64 * NA_P, kc0, R - rs);
                if (i + 1 < 9 && i + 1 < nrows) { *(LAS u32x4*)(lds + NA_BK + ((i + 1) & 1) * 64 * NA_P + (tid >> 3) * NA_P + (tid & 7) * 16) = bk[i + 1 < 9 ? i + 1 : 8];
                    *(LAS u32x4*)(lds + NA_BV + ((i + 1) & 1) * 64 * NA_P + (tid >> 3) * NA_P + (tid & 7) * 16) = bv[i + 1 < 9 ? i + 1 : 8]; }
                LDS_BARRIER();
            }
        }
#pragma unroll 2
        for (int cbk = 0; cbk < 8; ++cbk) process(lds + NA_CK, lds + NA_CV, 32 * cbk, -1);
        lsum += __shfl_xor(lsum, 16); lsum += __shfl_xor(lsum, 32);
        const float inv = 1.0f / lsum;
#pragma unroll
        for (int dvb = 0; dvb < 4; ++dvb) { f16x4 ov;
#pragma unroll
            for (int rr = 0; rr < 4; ++rr) ov[rr] = (f16)(O[dvb][rr] * inv);
            *(f16x4*)(MIX + (size_t)qrow * D + h * 64 + 16 * dvb + 4 * g) = ov; }
    }
    __syncthreads();
}

#define XB_TMO      128
#define XB_XCNT(j)  (256  + 64 * (j))
#define XB_XSUB(j)  (1280 + 64 * (j))
#define XB_XGEN(j)  (2304 + 64 * (j))
#define XB_TOP      3328
#define XB_TOPGEN   3392
#define XCD_BAR_WORDS 3456
#define XB_SPIN_CAP (1u << 20)
__device__ __forceinline__ unsigned xb_ld(unsigned* p)              { return __hip_atomic_load(p, __ATOMIC_RELAXED, __HIP_MEMORY_SCOPE_AGENT); }
__device__ __forceinline__ unsigned xb_add(unsigned* p, unsigned v) { return __hip_atomic_fetch_add(p, v, __ATOMIC_RELAXED, __HIP_MEMORY_SCOPE_AGENT); }
__device__ __forceinline__ unsigned xb_xcc_id() { return (unsigned)__builtin_amdgcn_s_getreg((3 << 11) | 20) & 0xFu; }
#define XB_SPIN(cond, bar) do { unsigned _sp = 0; while (cond) { __builtin_amdgcn_s_sleep(1); \
    if ((++_sp & 255u) == 0u) { if (xb_ld(&(bar)[XB_TMO])) break; if (_sp > XB_SPIN_CAP) { atomicAdd(&(bar)[XB_TMO], 1u); break; } } } } while (0)
struct XcdBarrier { unsigned* bar; unsigned x; volatile LAS unsigned* st; };
__device__ __forceinline__ XcdBarrier xcd_barrier_post(unsigned* bar, volatile LAS unsigned* st) {
    XcdBarrier b; b.bar = bar; b.x = xb_xcc_id(); b.st = st;
    if (threadIdx.x == 0) (void)xb_add(&bar[XB_XCNT(b.x)], 1u);
    return b;
}
__device__ __forceinline__ void xcd_barrier_complete(unsigned* bar, unsigned x, unsigned& nloc, unsigned& nx) {
    const unsigned G = gridDim.x * gridDim.y * gridDim.z;
    unsigned sum, cnt, mine, sp = 0u;
    for (;;) {
        sum = 0u; cnt = 0u; mine = 0u;
#pragma unroll
        for (unsigned j = 0; j < 16; ++j) { const unsigned c = xb_ld(&bar[XB_XCNT(j)]); sum += c; cnt += (c > 0u) ? 1u : 0u; mine = (j == x) ? c : mine; }
        if (sum == G) break;
        __builtin_amdgcn_s_sleep(1);
        if ((++sp & 255u) == 0u) { if (xb_ld(&bar[XB_TMO])) break; if (sp > XB_SPIN_CAP) { atomicAdd(&bar[XB_TMO], 1u); break; } }
    }
    nloc = mine > 0u ? mine : 1u; nx = cnt > 0u ? cnt : 1u;
}
__device__ __forceinline__ void xcd_barrier(const XcdBarrier& b) {
    asm volatile("s_waitcnt vmcnt(0)" ::: "memory");
    __syncthreads();
    if (threadIdx.x == 0) {
        unsigned* bar = b.bar;
        __builtin_amdgcn_s_waitcnt(0);
        unsigned nloc = b.st[0], nx = b.st[1];
        if (nloc == 0u) { xcd_barrier_complete(bar, b.x, nloc, nx); b.st[0] = nloc; b.st[1] = nx; }
        const unsigned old = xb_add(&bar[XB_XSUB(b.x)], 1u);
        const unsigned gen = old / nloc;
        if (old + 1u == (gen + 1u) * nloc) {
            __builtin_amdgcn_fence(__ATOMIC_RELEASE, "agent");
            asm volatile("s_waitcnt vmcnt(0)" ::: "memory");
            const unsigned og = xb_add(&bar[XB_TOP], 1u);
            const unsigned tg = og / nx;
            if (og + 1u == (tg + 1u) * nx) xb_add(&bar[XB_TOPGEN], 1u);
            else XB_SPIN(xb_ld(&bar[XB_TOPGEN]) == tg, bar);
            __builtin_amdgcn_fence(__ATOMIC_ACQUIRE, "agent");
            xb_add(&bar[XB_XGEN(b.x)], 1u);
            asm volatile("s_waitcnt vmcnt(0)" ::: "memory");
        } else {
            XB_SPIN(xb_ld(&bar[XB_XGEN(b.x)]) == gen, bar);
            __builtin_amdgcn_fence(__ATOMIC_ACQUIRE, "agent");
            asm volatile("s_waitcnt vmcnt(0)" ::: "memory");
        }
    }
    __syncthreads();
}

constexpr int LDS_BYTES = 159744;
constexpr int LDS_MISC = 155648;

__global__ void __launch_bounds__(NTHREADS, 2) mega_fwd(Params P) {
    extern __shared__ __attribute__((aligned(16))) unsigned char lds_raw[];
    LAS unsigned char* lds = (LAS unsigned char*)lds_raw;
    const int bid0 = blockIdx.x, nblk0 = gridDim.x;
    if (threadIdx.x < 64) ((LAS unsigned*)(lds + LDS_MISC))[threadIdx.x] = 0u;
    __syncthreads();
    XcdBarrier bar = xcd_barrier_post((unsigned*)(P.ws + WS_CTL) + CW_BAR, (volatile LAS unsigned*)(lds + LDS_MISC));
#define GRID_BAR() xcd_barrier(bar)

    {
    const int bid = bid0, nblk = nblk0;
    ph_mod(P, lds, bid, nblk);
    ph_rope_table(P, bid, nblk);
    ph_convert_static(P, lds, bid, nblk);
    ph_convert_moe(P, 0, lds, bid, nblk, 1);
    GRID_BAR();
    ph_prep0(P, bid, nblk);
    GRID_BAR();
    }

    for (int jj = 0; jj < 2; ++jj) {
        int bid_l = bid0, nblk_l = nblk0; asm volatile("" : "+s"(bid_l), "+s"(nblk_l));
        const int bid = bid_l, nblk = nblk_l;
        {
            const int layer = 2 * jj, j = jj;
            const float* modl = (const float*)(P.ws + WS_MOD) + (size_t)layer * 5 * 6144;
            {
                pg8::Gemm g{(const f16*)(P.ws + WS_H), (const f16*)(P.ws + WS_EWIN) + (size_t)j * EVEN_IN * D, M, EVEN_IN, D}; pg8::StaticOrder S; S.init(M, EVEN_IN, nblk, bid);
                pg8::EpiF16 E{(f16*)(P.ws + WS_P), EVEN_IN, EVEN_IN / 256};
                pg8::gemm_phase<pg8::EpiF16, pg8::StaticOrder, true, true>(lds, g, S, E);
                bg_convert_w2(P, jj, 0, 3200, ((M / 256) * (EVEN_IN / 256)) % nblk, lds, bid, nblk);
            }
            GRID_BAR();
            ph_na(P, j, lds, bid, nblk);
            ph_hgrn_local(P, j, lds, bid, nblk);
            bg_convert_w13(P, 1, jj == 0 ? 0 : 3400, jj == 0 ? 1400 : 4700, nblk == 256 ? 64 : 0, (f16*)(P.ws + WS_MW13B), lds, bid, nblk);
            GRID_BAR();
            ph_hgrn_carry(P, bid, nblk);
            GRID_BAR();
            ph_hgrn_final(P, j, lds, bid, nblk);
            GRID_BAR();
            {
                pg8::Gemm g{(const f16*)(P.ws + WS_MIX), (const f16*)(P.ws + WS_EWOUT) + (size_t)j * D * D, TX, D, D}; pg8::StaticOrder S; S.init(TX, D, nblk, bid);
                pg8::EpiResid E{(const f16*)(P.ws + WS_X), (f16*)(P.ws + WS_V), modl, 2 * D};
                pg8::gemm_phase<pg8::EpiResid, pg8::StaticOrder, true, true>(lds, g, S, E);
                gemm_ctx64(lds, (const f16*)(P.ws + WS_MIX), (const f16*)(P.ws + WS_EWOUT) + (size_t)j * D * D, D, (const f16*)(P.ws + WS_X), (f16*)(P.ws + WS_V), modl + 4 * 6144 + 2 * D, bid, nblk);
            }
            GRID_BAR();
            ph_ln<0>(P, layer, 0, bid, nblk, false);
            GRID_BAR();
            {
                pg8::Gemm g{(const f16*)(P.ws + WS_H), (const f16*)(P.ws + WS_FW13) + (size_t)j * 2 * FFN * D, M, 2 * FFN, D}; pg8::StaticOrder S; S.init(M, 2 * FFN, nblk, bid);
                pg8::EpiSwiglu E{(f16*)(P.ws + WS_G), FFN, 2 * FFN / 256};
                pg8::gemm_phase<pg8::EpiSwiglu, pg8::StaticOrder, true, true>(lds, g, S, E);
                bg_convert_w2(P, jj, 3200, 3840, ((M / 256) * (2 * FFN / 256)) % nblk, lds, bid, nblk);
            }
            GRID_BAR();
            {
                pg8::Gemm g{(const f16*)(P.ws + WS_G), (const f16*)(P.ws + WS_FW2) + (size_t)j * D * FFN, TX, D, FFN}; pg8::StaticOrder S; S.init(TX, D, nblk, bid);
                pg8::EpiResid E{(const f16*)(P.ws + WS_X), (f16*)(P.ws + WS_V), modl, 5 * D};
                pg8::gemm_phase<pg8::EpiResid, pg8::StaticOrder, true, true>(lds, g, S, E);
                gemm_ctx64(lds, (const f16*)(P.ws + WS_G), (const f16*)(P.ws + WS_FW2) + (size_t)j * D * FFN, FFN, (const f16*)(P.ws + WS_X), (f16*)(P.ws + WS_V), modl + 4 * 6144 + 5 * D, bid, nblk);
            }
            GRID_BAR();
            ph_ln<0>(P, layer, 1, bid, nblk, false);
            GRID_BAR();
        }
        {
            const int layer = 2 * jj + 1, j = jj;
            const bool last = (layer == DEPTH - 1);
            const float* modl = (const float*)(P.ws + WS_MOD) + (size_t)layer * 5 * 6144;
            {
                pg8::Gemm g{(const f16*)(P.ws + WS_H), (const f16*)(P.ws + WS_OWIN) + (size_t)j * ODD_IN * D, M, ODD_IN, D}; pg8::StaticOrder S; S.init(M, ODD_IN, nblk, bid);
                pg8::EpiRope E{(f16*)(P.ws + WS_P), (const float*)(P.ws + WS_ROPET)};
                pg8::gemm_phase<pg8::EpiRope, pg8::StaticOrder, true, true>(lds, g, S, E);
                bg_convert_w2(P, jj, 3840, 6400, ((M / 256) * (ODD_IN / 256)) % nblk, lds, bid, nblk);
            }
            GRID_BAR();
            ph_ret_pm(P, j, bid, nblk);
            ph_ret_scan(P, j, lds, bid, nblk);
            GRID_BAR();
            ph_ret_final(P, lds, bid, nblk);
            bg_convert_w13(P, 1, jj == 0 ? 1400 : 4700, jj == 0 ? 3400 : W13_PRO, nblk == 256 ? 64 : 0, (f16*)(P.ws + WS_MW13B), lds, bid, nblk);
            GRID_BAR();
            {
                pg8::Gemm g{(const f16*)(P.ws + WS_MIX), (const f16*)(P.ws + WS_OWOUT) + (size_t)j * D * 2048, TX, D, 2048}; pg8::StaticOrder S; S.init(TX, D, nblk, bid);
                pg8::EpiResid E{(const f16*)(P.ws + WS_X), (f16*)(P.ws + WS_V), modl, 2 * D};
                pg8::gemm_phase<pg8::EpiResid, pg8::StaticOrder, true, true>(lds, g, S, E);
                if (!last)
                    gemm_ctx64(lds, (const f16*)(P.ws + WS_MIX), (const f16*)(P.ws + WS_OWOUT) + (size_t)j * D * 2048, 2048, (const f16*)(P.ws + WS_X), (f16*)(P.ws + WS_V), modl + 4 * 6144 + 2 * D, bid, nblk);
            }
            GRID_BAR();
            ph_ln<1>(P, layer, 0, bid, nblk, false, lds, last ? TX : M);
            GRID_BAR();
            ph_moe_gather(P, j, bid, nblk, last ? TX : M);
            GRID_BAR();
            {
                const int* tilex = (const int*)(P.ws + WS_TILEX);
                const int ntiles = __builtin_amdgcn_readfirstlane(__hip_atomic_load(tilex + 255, __ATOMIC_RELAXED, __HIP_MEMORY_SCOPE_AGENT));
                pg8::Gemm g{(const f16*)(P.ws + WS_XP), (const f16*)(P.ws + (jj == 0 ? WS_MW13 : WS_MW13B)), MOE_ROWS, NE * 2 * EDIM, D};
                pg8::GroupedOrder S{tilex, ntiles, 2 * EDIM / 256, nblk, bid};
                pg8::EpiSwiglu E{(f16*)(P.ws + WS_GP), EDIM, 2 * EDIM / 256};
                pg8::gemm_phase<pg8::EpiSwiglu, pg8::GroupedOrder, true, true>(lds, g, S, E);
                bg_convert_w2(P, jj, 6400, NE * W2_TILES, (ntiles * (2 * EDIM / 256)) % nblk, lds, bid, nblk);
            }
            GRID_BAR();
            {
                const int* tilex = (const int*)(P.ws + WS_TILEX);
                const int ntiles = __builtin_amdgcn_readfirstlane(__hip_atomic_load(tilex + 255, __ATOMIC_RELAXED, __HIP_MEMORY_SCOPE_AGENT));
                pg8::Gemm g{(const f16*)(P.ws + WS_GP), (const f16*)(P.ws + WS_MW2), MOE_ROWS, NE * D, EDIM};
                pg8::GroupedOrder S{tilex, ntiles, D / 256, nblk, bid};
                pg8::EpiF16 E{(f16*)(P.ws + WS_Y2P), D, D / 256};
                pg8::gemm_phase<pg8::EpiF16, pg8::GroupedOrder, true, true>(lds, g, S, E);
                if (jj == 0) {
                    const int U = ntiles * (D / 256), heavy = U % nblk;
                    const int w0 = heavy, nw = nblk - heavy;
                    __syncthreads();
                    bg_convert_w13(P, 1, W13_PRO, NE * 2 * W13_TILES, w0, (f16*)(P.ws + WS_MW13B), lds, bid, nblk); (void)nw;
                }
            }
            GRID_BAR();
            ph_ln<2>(P, layer, 1, bid, nblk, last, nullptr, last ? TX : M);
            if (!last) GRID_BAR();
        }
    }
}

extern "C" void kernel_launch(void* const* d_in, const int* in_sizes, int n_in, void* d_out, int out_size, void* d_ws, size_t ws_size, hipStream_t stream) {
    static int grid = 0;
    if (grid == 0) {
        if (n_in != 24 || ws_size < WS_END) { fprintf(stderr, "kernel_launch: unexpected n_in %d or ws_size %zu (need %zu)\n", n_in, ws_size, (size_t)WS_END); grid = -1; return; }
        int dev = 0, cus = 0;
        if (hipGetDevice(&dev) != hipSuccess || hipDeviceGetAttribute(&cus, hipDeviceAttributeMultiprocessorCount, dev) != hipSuccess) { grid = -1; return; }
        if (hipFuncSetAttribute((const void*)mega_fwd, hipFuncAttributeMaxDynamicSharedMemorySize, LDS_BYTES) != hipSuccess) { grid = -1; return; }
        int per_cu = 0;
        (void)hipOccupancyMaxActiveBlocksPerMultiprocessor(&per_cu, (const void*)mega_fwd, NTHREADS, LDS_BYTES);
        (void)hipGetLastError();
        grid = cus;
    }
    if (grid < 0) return;
    Params p{};
    const float** pp = (const float**)&p;
    for (int i = 0; i < 24; ++i) pp[i] = (const float*)d_in[i];
    p.out = (float*)d_out; p.ws = (unsigned char*)d_ws;
    (void)hipMemsetAsync((char*)d_ws + WS_CTL, 0, CTL_BYTES, stream);
    hipLaunchKernelGGL(mega_fwd, dim3(grid), dim3(NTHREADS), LDS_BYTES, stream, p);
}
```
